# Optimizing an MI355X kernel written in HIP

```python
import math
import jax, jax.numpy as jnp
from jax import lax
import numpy as np

D_MODEL = 1024
BATCH = 8
SEQ = 4096
DEPTH = 2

N_A_LAYERS = DEPTH // 2
N_B_LAYERS = DEPTH - N_A_LAYERS
N_DENSE = (DEPTH + 1) // 2
N_MOE = DEPTH // 2
MLA_HEADS = 8
QK_NOPE = 128
QK_ROPE = 64
V_DIM = 128
Q_LORA = 384
KV_LORA = 256
ROPE_THETA = 10000.0
SB_HEADS = 8
SB_HEAD_DIM = 128
D_FF = 3584
N_EXPERTS = 8
TOP_K = 2
Q_BLOCK = 128
EPS = 1e-6
COND_MULT = 6

kernel_name = "yoco_mla_stickbreaking_moe_adaln"


def rms_norm(x, g):
    xf = x.astype(jnp.float32)
    y = xf * lax.rsqrt(jnp.mean(xf * xf, axis=-1, keepdims=True) + EPS)
    return (y * g.astype(jnp.float32)).astype(x.dtype)


def modulate(h, shift, scale):
    return h * (1 + scale[:, None, :]) + shift[:, None, :]


def rope(x, pos):
    half = x.shape[-1] // 2
    inv = ROPE_THETA ** (-jnp.arange(half, dtype=jnp.float32) / half)
    ang = pos.astype(jnp.float32)[..., None] * inv
    cos = jnp.cos(ang)[:, :, None, :]
    sin = jnp.sin(ang)[:, :, None, :]
    xf = x.astype(jnp.float32)
    x1, x2 = xf[..., :half], xf[..., half:]
    return jnp.concatenate([x1 * cos - x2 * sin, x1 * sin + x2 * cos], axis=-1).astype(x.dtype)


def _split_query_blocks(q):
    b, s, h, d = q.shape
    nb = s // Q_BLOCK
    return q.reshape(b, nb, Q_BLOCK, h, d).swapaxes(0, 1), nb


def _merge_query_blocks(o):
    nb, b, qb, h, d = o.shape
    return o.swapaxes(0, 1).reshape(b, nb * qb, h, d)


def causal_softmax_attention(q, k, v):
    scale = 1.0 / math.sqrt(q.shape[-1])
    qb_all, nb = _split_query_blocks(q)
    kpos = jnp.arange(k.shape[1])

    def block(args):
        qb, bi = args
        s = jnp.einsum('bqhd,bkhd->bhqk', qb, k).astype(jnp.float32) * scale
        qpos = bi * Q_BLOCK + jnp.arange(Q_BLOCK)
        mask = kpos[None, :] <= qpos[:, None]
        p = jax.nn.softmax(jnp.where(mask, s, -jnp.inf), axis=-1)
        return jnp.einsum('bhqk,bkhd->bqhd', p.astype(v.dtype), v)

    return _merge_query_blocks(lax.map(block, (qb_all, jnp.arange(nb))))


def stick_breaking_attention(q, k, v):
    scale = 1.0 / math.sqrt(q.shape[-1])
    qb_all, nb = _split_query_blocks(q)
    kpos = jnp.arange(k.shape[1])

    def block(args):
        qb, bi = args
        z = jnp.einsum('bqhd,bkhd->bhqk', qb, k).astype(jnp.float32) * scale
        qpos = bi * Q_BLOCK + jnp.arange(Q_BLOCK)
        mask = kpos[None, :] < qpos[:, None]
        log_beta = jax.nn.log_sigmoid(z)
        log_1m = jnp.where(mask, log_beta - z, 0.0)
        suffix = lax.cumsum(log_1m, axis=3, reverse=True) - log_1m
        a = jnp.where(mask, jnp.exp(log_beta + suffix), 0.0)
        return jnp.einsum('bhqk,bkhd->bqhd', a.astype(v.dtype), v)

    return _merge_query_blocks(lax.map(block, (qb_all, jnp.arange(nb))))


def mla_mixer(h, positions, w_a_down, g_q_lat, g_kv_lat, w_uq, w_ukv, w_oa):
    b, s, _ = h.shape
    lat = h @ w_a_down
    c_q = rms_norm(lat[..., :Q_LORA], g_q_lat)
    c_kv = rms_norm(lat[..., Q_LORA:Q_LORA + KV_LORA], g_kv_lat)
    k_rot = lat[..., Q_LORA + KV_LORA:][:, :, None, :]
    q = (c_q @ w_uq).reshape(b, s, MLA_HEADS, QK_NOPE + QK_ROPE)
    q = jnp.concatenate([q[..., :QK_NOPE], rope(q[..., QK_NOPE:], positions)], axis=-1)
    kv = (c_kv @ w_ukv).reshape(b, s, MLA_HEADS, QK_NOPE + V_DIM)
    k_rot = jnp.broadcast_to(rope(k_rot, positions), (b, s, MLA_HEADS, QK_ROPE))
    k = jnp.concatenate([kv[..., :QK_NOPE], k_rot], axis=-1)
    v = kv[..., QK_NOPE:]
    o = causal_softmax_attention(q, k, v)
    return o.reshape(b, s, MLA_HEADS * V_DIM) @ w_oa


def shared_kv(x, silu_c, w_mod_kv, b_mod_kv, g_kv, w_kv_sb):
    b, s, _ = x.shape
    shift, scale = jnp.split(silu_c @ w_mod_kv + b_mod_kv, 2, axis=-1)
    hk = modulate(rms_norm(x, g_kv), shift, scale)
    kv = (hk @ w_kv_sb).reshape(b, s, 2, SB_HEADS, SB_HEAD_DIM)
    return kv[:, :, 0], kv[:, :, 1]


def stick_breaking_mixer(h, k_sh, v_sh, w_q_sb, w_o_sb):
    b, s, _ = h.shape
    q = (h @ w_q_sb).reshape(b, s, SB_HEADS, SB_HEAD_DIM)
    o = stick_breaking_attention(q, k_sh, v_sh)
    return o.reshape(b, s, SB_HEADS * SB_HEAD_DIM) @ w_o_sb


def swiglu(h, w_gu, w_down):
    gu = h @ w_gu
    return (jax.nn.silu(gu[..., :D_FF]) * gu[..., D_FF:]) @ w_down


def moe_swiglu(h, w_router, b_router, w_exp_gu, w_exp_down):
    b, s, d = h.shape
    hf = h.reshape(b * s, d)
    logits = (hf @ w_router).astype(jnp.float32) + b_router.astype(jnp.float32)
    top_val, top_idx = lax.top_k(logits, TOP_K)
    wts = jax.nn.softmax(top_val, axis=-1)
    comb = jnp.sum(jax.nn.one_hot(top_idx, N_EXPERTS, dtype=h.dtype)
                   * wts[..., None].astype(h.dtype), axis=1)
    y = jnp.zeros_like(hf)
    for e in range(N_EXPERTS):
        y = y + comb[:, e:e + 1] * swiglu(hf, w_exp_gu[e], w_exp_down[e])
    return y.reshape(b, s, d)


def setup_inputs(seed: int = 0) -> dict:
    key = jax.random.key(seed)
    ks = jax.random.split(key, 32)
    D = D_MODEL

    def nrm(k, shape, fan_in, mult=1.0):
        return jax.random.normal(k, shape, jnp.float32) * (mult * fan_in ** -0.5)

    def gain(k, shape):
        return 1.0 + 0.02 * jax.random.normal(k, shape, jnp.float32)

    offsets = jax.random.randint(ks[2], (BATCH, 1), 0, 1024)
    positions = (jnp.arange(SEQ, dtype=jnp.int32)[None, :] + offsets).astype(jnp.int32)
    return {
        "x": jax.random.normal(ks[0], (BATCH, SEQ, D), jnp.float32),
        "c": jax.random.normal(ks[1], (BATCH, D), jnp.float32),
        "positions": positions,
        "w_mod": nrm(ks[3], (DEPTH, D, COND_MULT * D), D, 0.5),
        "b_mod": 0.02 * jax.random.normal(ks[4], (DEPTH, COND_MULT * D), jnp.float32),
        "g_mix": gain(ks[5], (DEPTH, D)),
        "g_ffn": gain(ks[6], (DEPTH, D)),
        "w_a_down": nrm(ks[7], (N_A_LAYERS, D, Q_LORA + KV_LORA + QK_ROPE), D),
        "g_q_lat": gain(ks[8], (N_A_LAYERS, Q_LORA)),
        "g_kv_lat": gain(ks[9], (N_A_LAYERS, KV_LORA)),
        "w_uq": nrm(ks[10], (N_A_LAYERS, Q_LORA, MLA_HEADS * (QK_NOPE + QK_ROPE)), Q_LORA),
        "w_ukv": nrm(ks[11], (N_A_LAYERS, KV_LORA, MLA_HEADS * (QK_NOPE + V_DIM)), KV_LORA),
        "w_oa": nrm(ks[12], (N_A_LAYERS, MLA_HEADS * V_DIM, D), MLA_HEADS * V_DIM),
        "w_mod_kv": nrm(ks[13], (D, 2 * D), D, 0.5),
        "b_mod_kv": 0.02 * jax.random.normal(ks[14], (2 * D,), jnp.float32),
        "g_kv": gain(ks[15], (D,)),
        "w_kv_sb": nrm(ks[16], (D, 2 * SB_HEADS * SB_HEAD_DIM), D),
        "w_q_sb": nrm(ks[17], (N_B_LAYERS, D, SB_HEADS * SB_HEAD_DIM), D),
        "w_o_sb": nrm(ks[18], (N_B_LAYERS, SB_HEADS * SB_HEAD_DIM, D), SB_HEADS * SB_HEAD_DIM),
        "w_ffn_gu": nrm(ks[19], (N_DENSE, D, 2 * D_FF), D),
        "w_ffn_down": nrm(ks[20], (N_DENSE, D_FF, D), D_FF),
        "w_router": nrm(ks[21], (N_MOE, D, N_EXPERTS), D),
        "b_router": 0.01 * jax.random.normal(ks[22], (N_MOE, N_EXPERTS), jnp.float32),
        "w_exp_gu": nrm(ks[23], (N_MOE, N_EXPERTS, D, 2 * D_FF), D),
        "w_exp_down": nrm(ks[24], (N_MOE, N_EXPERTS, D_FF, D), D_FF),
        "g_final": gain(ks[25], (D,)),
    }


def reference(x, c, positions, w_mod, b_mod, g_mix, g_ffn, w_a_down, g_q_lat, g_kv_lat,
              w_uq, w_ukv, w_oa, w_mod_kv, b_mod_kv, g_kv, w_kv_sb, w_q_sb, w_o_sb,
              w_ffn_gu, w_ffn_down, w_router, b_router, w_exp_gu, w_exp_down, g_final):
    silu_c = jax.nn.silu(c)
    k_sh = None
    v_sh = None
    for i in range(DEPTH):
        mod = silu_c @ w_mod[i] + b_mod[i]
        sh1, sc1, gt1, sh2, sc2, gt2 = jnp.split(mod, COND_MULT, axis=-1)
        h = modulate(rms_norm(x, g_mix[i]), sh1, sc1)
        if i < N_A_LAYERS:
            mix = mla_mixer(h, positions, w_a_down[i], g_q_lat[i], g_kv_lat[i],
                            w_uq[i], w_ukv[i], w_oa[i])
        else:
            j = i - N_A_LAYERS
            mix = stick_breaking_mixer(h, k_sh, v_sh, w_q_sb[j], w_o_sb[j])
        x = x + gt1[:, None, :] * mix
        h = modulate(rms_norm(x, g_ffn[i]), sh2, sc2)
        if i % 2 == 0:
            f = swiglu(h, w_ffn_gu[i // 2], w_ffn_down[i // 2])
        else:
            f = moe_swiglu(h, w_router[i // 2], b_router[i // 2],
                           w_exp_gu[i // 2], w_exp_down[i // 2])
        x = x + gt2[:, None, :] * f
        if i == N_A_LAYERS - 1:
            k_sh, v_sh = shared_kv(x, silu_c, w_mod_kv, b_mod_kv, g_kv, w_kv_sb)
    return rms_norm(x, g_final)
```

```cpp
#include <hip/hip_runtime.h>
#include <cstdio>
#include <cstdint>
#include <cmath>

namespace pg8 {
#define PG8_LAS __attribute__((address_space(3)))
typedef unsigned short bf16_t;
typedef short bf16x8 __attribute__((ext_vector_type(8)));
typedef float f32x4 __attribute__((ext_vector_type(4)));
typedef unsigned u32x4 __attribute__((ext_vector_type(4)));
constexpr int BM = 256, BK = 64, HALF = 128, HTB = HALF * BK * 2  , STAGE_BYTES = 8 * HTB, NXCD = 8, WGM = 8;

__host__ __device__ __forceinline__ int lds_byte(int r, int c) { const int st = (r >> 4) * 2 + (c >> 5), rr = r & 15, cc = c & 31, ob = rr * 64 + cc * 2; return st * 1024 + (ob ^ (((ob >> 9) & 1) << 5)); }
__host__ __device__ __forceinline__ void stage_rc(int b, int& R, int& C) { const int st = b / 1024, sb = b % 1024, swz = sb ^ (((sb >> 9) & 1) << 5); R = (st >> 1) * 16 + swz / 64; C = (st & 1) * 32 + (swz % 64) / 2; }
__host__ __device__ __forceinline__ int perm32(int rho) { const int n = rho >> 4, i = rho & 15; return 8 * (i >> 2) + 4 * n + (i & 3); }

struct Unit { int pm, pn, eb; };
struct Gemm { const bf16_t* A; const bf16_t* Bt; int M, N, K; size_t bstride; };

struct StaticOrder {
    int nM, nN, nwg, G, c;
    __host__ __device__ void init(int M, int N, int G_, int c_) { nM = M / BM; nN = N / BM; nwg = nM * nN; G = G_; c = c_; }
    __host__ __device__ bool next(int i, Unit& u) const {
        const long L = (long)i * G + c; if (L >= nwg) return false;
        int wgid = (int)L; { const int q = nwg / NXCD, r = nwg % NXCD, xcd = wgid % NXCD, off = wgid / NXCD; wgid = (xcd < r ? xcd * (q + 1) : r * (q + 1) + (xcd - r) * q) + off; }
        const int nig = WGM * nN, gid = wgid / nig, fm = gid * WGM, gsz = (nM - fm) < WGM ? (nM - fm) : WGM;
        u.pm = fm + ((wgid % nig) % gsz); u.pn = (wgid % nig) / gsz; u.eb = 0; return true;
    }
    __device__ __forceinline__ void a_ready(const Unit&) const {}
    __device__ __forceinline__ void done(const Unit&) const {}
};
struct MoeOrder {
    int nM, nN, nwg, G, c; int t1, t2, t3, t4, t5, t6, t7;
    __device__ __forceinline__ void init(const unsigned* cnt, int N, int G_, int c_) {
        int t = 0;
        t += (int)((cnt[0] + 255u) >> 8); t1 = t; t += (int)((cnt[1] + 255u) >> 8); t2 = t; t += (int)((cnt[2] + 255u) >> 8); t3 = t; t += (int)((cnt[3] + 255u) >> 8); t4 = t;
        t += (int)((cnt[4] + 255u) >> 8); t5 = t; t += (int)((cnt[5] + 255u) >> 8); t6 = t; t += (int)((cnt[6] + 255u) >> 8); t7 = t; t += (int)((cnt[7] + 255u) >> 8);
        nM = t; nN = N / BM; nwg = nM * nN; G = G_; c = c_; }
    __device__ __forceinline__ bool next(int i, Unit& u) const {
        const long L = (long)i * G + c; if (L >= nwg) return false;
        int wgid = (int)L; { const int q = nwg / NXCD, r = nwg % NXCD, xcd = wgid % NXCD, off = wgid / NXCD; wgid = (xcd < r ? xcd * (q + 1) : r * (q + 1) + (xcd - r) * q) + off; }
        const int nig = WGM * nN, gid = wgid / nig, fm = gid * WGM, gsz = (nM - fm) < WGM ? (nM - fm) : WGM;
        u.pm = fm + ((wgid % nig) % gsz); u.pn = (wgid % nig) / gsz;
        u.eb = (u.pm >= t1) + (u.pm >= t2) + (u.pm >= t3) + (u.pm >= t4) + (u.pm >= t5) + (u.pm >= t6) + (u.pm >= t7); return true;
    }
    __device__ __forceinline__ void a_ready(const Unit&) const {}
    __device__ __forceinline__ void done(const Unit&) const {}
};

__device__ __forceinline__ unsigned cvt_pk_bf16(float lo, float hi) { unsigned r; asm volatile("v_cvt_pk_bf16_f32 %0, %1, %2" : "=v"(r) : "v"(lo), "v"(hi)); return r; }

struct EpiF32 {
    static constexpr bool PERM = false, AFTER_DRAIN = false;
    float* C; int ldc;
    __device__ __forceinline__ void operator()(const f32x4 (&acc)[2][2][4][2], const Unit& u, int wr, int wc, int fr, int fq) const {
        asm volatile("" : "+v"(fr), "+v"(fq));
        const int row0 = u.pm * BM + wr * 64 + fr, col0 = u.pn * BM + wc * 32 + 4 * fq;
#pragma unroll
        for (int ai = 0; ai < 2; ++ai)
#pragma unroll
            for (int m = 0; m < 4; ++m) { float* rowp = C + (size_t)(row0 + ai * HALF + m * 16) * ldc + col0;
#pragma unroll
                for (int bj = 0; bj < 2; ++bj)
#pragma unroll
                    for (int n = 0; n < 2; ++n) *(f32x4*)(rowp + bj * HALF + n * 16) = acc[ai][bj][m][n]; }
    }
};
struct EpiBf16 {
    static constexpr bool PERM = true, AFTER_DRAIN = false;
    bf16_t* O; int ldc; float scale;
    __device__ __forceinline__ void operator()(const f32x4 (&acc)[2][2][4][2], const Unit& u, int wr, int wc, int fr, int fq) const {
        asm volatile("" : "+v"(fr), "+v"(fq));
        const int row0 = u.pm * BM + wr * 64 + fr; const int col0 = u.pn * BM + wc * 32 + 8 * fq; const float sc = scale;
#pragma unroll
        for (int ai = 0; ai < 2; ++ai)
#pragma unroll
            for (int m = 0; m < 4; ++m) { bf16_t* rowp = O + (size_t)(row0 + ai * HALF + m * 16) * ldc + col0;
#pragma unroll
                for (int bj = 0; bj < 2; ++bj) { f32x4 v0 = acc[ai][bj][m][0] * sc, v1 = acc[ai][bj][m][1] * sc;
                    u32x4 w; w.x = cvt_pk_bf16(v0[0], v0[1]); w.y = cvt_pk_bf16(v0[2], v0[3]); w.z = cvt_pk_bf16(v1[0], v1[1]); w.w = cvt_pk_bf16(v1[2], v1[3]);
                    *(u32x4*)(rowp + bj * HALF) = w; } }
    }
};
struct EpiRope {
    static constexpr bool PERM = true, AFTER_DRAIN = false;
    bf16_t* O; int ldc; float scale; const float* CS;
    __device__ __forceinline__ void operator()(const f32x4 (&acc)[2][2][4][2], const Unit& u, int wr, int wc, int fr, int fq) const {
        asm volatile("" : "+v"(fr), "+v"(fq));
        const int row0 = u.pm * BM + wr * 64 + fr; const int col0 = u.pn * BM + wc * 32 + 8 * fq; const float sc = scale;
        const int g4 = ((wc & 1) * 4 + fq) * 4;
#pragma unroll
        for (int ai = 0; ai < 2; ++ai)
#pragma unroll
            for (int m = 0; m < 4; ++m) { int ro = ai * HALF + m * 16; asm volatile("" : "+s"(ro)); const int row = row0 + ro; bf16_t* rowp = O + (size_t)row * ldc + col0;
                const f32x4 cs = *(const f32x4*)(CS + (size_t)row * 64 + g4) * sc, sn = *(const f32x4*)(CS + (size_t)row * 64 + 32 + g4) * sc;
#pragma unroll
                for (int bj = 0; bj < 2; ++bj) { const f32x4 x1 = acc[ai][bj][m][0], x2 = acc[ai][bj][m][1];
                    const f32x4 v0 = x1 * cs - x2 * sn, v1 = x1 * sn + x2 * cs;
                    u32x4 w; w.x = cvt_pk_bf16(v0[0], v0[1]); w.y = cvt_pk_bf16(v0[2], v0[3]); w.z = cvt_pk_bf16(v1[0], v1[1]); w.w = cvt_pk_bf16(v1[2], v1[3]);
                    *(u32x4*)(rowp + bj * HALF) = w; }
                asm volatile("" ::: "memory"); }
    }
};
struct EpiResid {
    static constexpr bool PERM = false, AFTER_DRAIN = false;
    const float* base; float* out; const float* gate; int gstride;
    __device__ __forceinline__ void operator()(const f32x4 (&acc)[2][2][4][2], const Unit& u, int wr, int wc, int fr, int fq) const {
        asm volatile("" : "+v"(fr), "+v"(fq));
        const int row0 = u.pm * BM + wr * 64 + fr, col0 = u.pn * BM + wc * 32 + 4 * fq; const int b = u.pm >> 4;
        f32x4 gv[2][2];
#pragma unroll
        for (int bj = 0; bj < 2; ++bj)
#pragma unroll
            for (int n = 0; n < 2; ++n) gv[bj][n] = *(const f32x4*)(gate + (size_t)b * gstride + col0 + bj * HALF + n * 16);
#pragma unroll
        for (int ai = 0; ai < 2; ++ai)
#pragma unroll
            for (int m = 0; m < 4; ++m) { const size_t off = (size_t)(row0 + ai * HALF + m * 16) * 1024 + col0;
#pragma unroll
                for (int bj = 0; bj < 2; ++bj)
#pragma unroll
                    for (int n = 0; n < 2; ++n) { const f32x4 bs = *(const f32x4*)(base + off + bj * HALF + n * 16); *(f32x4*)(out + off + bj * HALF + n * 16) = bs + gv[bj][n] * acc[ai][bj][m][n]; }
                if (m & 1) asm volatile("" ::: "memory"); }
    }
};
struct EpiSwiglu {
    static constexpr bool PERM = true, AFTER_DRAIN = false;
    bf16_t* O; int ldc;
    __device__ __forceinline__ static float act(float g, float up) { const float e = __builtin_amdgcn_exp2f(g * -1.4426950408889634f); return g * __builtin_amdgcn_rcpf(1.0f + e) * up; }
    __device__ __forceinline__ void operator()(const f32x4 (&acc)[2][2][4][2], const Unit& u, int wr, int wc, int fr, int fq) const {
        asm volatile("" : "+v"(fr), "+v"(fq));
        const int row0 = u.pm * BM + wr * 64 + fr; const int col0 = u.pn * HALF + wc * 32 + 8 * fq;
#pragma unroll
        for (int ai = 0; ai < 2; ++ai)
#pragma unroll
            for (int m = 0; m < 4; ++m) { bf16_t* rowp = O + (size_t)(row0 + ai * HALF + m * 16) * ldc + col0;
                const f32x4 g0 = acc[ai][0][m][0], g1 = acc[ai][0][m][1], u0 = acc[ai][1][m][0], u1 = acc[ai][1][m][1];
                u32x4 w; w.x = cvt_pk_bf16(act(g0[0], u0[0]), act(g0[1], u0[1])); w.y = cvt_pk_bf16(act(g0[2], u0[2]), act(g0[3], u0[3]));
                w.z = cvt_pk_bf16(act(g1[0], u1[0]), act(g1[1], u1[1])); w.w = cvt_pk_bf16(act(g1[2], u1[2]), act(g1[3], u1[3]));
                *(u32x4*)rowp = w; }
    }
};

template <class Epi, class Sched, bool ALIGN_EPI = false, bool SP2 = false>
__device__ __forceinline__ void gemm_phase(PG8_LAS unsigned char* lds, const Gemm g, const Sched& S, const Epi& E) {
    int tid_ = threadIdx.x; asm volatile("" : "+v"(tid_));
    const int tid = tid_, wid = __builtin_amdgcn_readfirstlane(tid >> 6), lane = tid & 63, wr = wid >> 2, wc = wid & 3, fr = lane & 15, fq = lane >> 4;
    const int K = g.K, nt = K / BK;
    unsigned voffA[2], voffB[2];
#pragma unroll
    for (int i = 0; i < 2; ++i) { int R, C; stage_rc(tid * 16 + i * 8192, R, C); const int Rb = Epi::PERM ? ((R & ~31) + perm32(R & 31)) : R;
        voffA[i] = (unsigned)(R * K + C) * 2u; voffB[i] = (unsigned)(Rb * K + C) * 2u; }
    const size_t kstep = (size_t)(BK * 2);
    const size_t hstep = (size_t)HALF * K * 2;
    const size_t tstep = 2 * hstep;
    const unsigned ldsw = (unsigned)wid * 1024u;
    const int aoff = lds_byte(wr * 64 + fr, fq * 8), boff = lds_byte(wc * 32 + fr, fq * 8);
#define PG8_SA(b, h) (((b) * 2 + (h)) * HTB)
#define PG8_SB(b, h) ((4 + (b) * 2 + (h)) * HTB)
#define PG8_STAGE(bufoff, gbase, voff) do { _Pragma("unroll") for (int _i = 0; _i < 2; ++_i) \
        __builtin_amdgcn_global_load_lds((const unsigned*)((const char*)(gbase) + (voff)[_i]), (PG8_LAS unsigned*)(lds + (bufoff) + ldsw + _i * 8192), 16, 0, 0); } while (0)
#define PG8_LDA(dst, b, h) do { _Pragma("unroll") for (int m = 0; m < 4; ++m) _Pragma("unroll") for (int k = 0; k < 2; ++k) dst[m][k] = *(const PG8_LAS bf16x8*)(lds + PG8_SA(b, h) + aoff + m * 2048 + k * 1024); } while (0)
#define PG8_LDB(dst, b, h) do { _Pragma("unroll") for (int n = 0; n < 2; ++n) _Pragma("unroll") for (int k = 0; k < 2; ++k) dst[n][k] = *(const PG8_LAS bf16x8*)(lds + PG8_SB(b, h) + boff + n * 2048 + k * 1024); } while (0)
#define PG8_MMA(ai, bj, At, Bt) do { __builtin_amdgcn_s_setprio(1); _Pragma("unroll") for (int m = 0; m < 4; ++m) _Pragma("unroll") for (int n = 0; n < 2; ++n) _Pragma("unroll") for (int k = 0; k < 2; ++k) \
        acc[ai][bj][m][n] = __builtin_amdgcn_mfma_f32_16x16x32_bf16(Bt[n][k], At[m][k], acc[ai][bj][m][n], 0, 0, 0); __builtin_amdgcn_s_setprio(0); } while (0)
#define PG8_WAIT_V(n) asm volatile("s_waitcnt vmcnt(" #n ")" ::: "memory")
#define PG8_WAIT_L(n) asm volatile("s_waitcnt lgkmcnt(" #n ")" ::: "memory")
#define PG8_BAR __builtin_amdgcn_s_barrier()
#define PG8_SCHED __builtin_amdgcn_sched_barrier(0)
    Unit cur, nxt; int ui = 0;
    if (!S.next(0, cur)) return;
    f32x4 acc[2][2][4][2];
#pragma unroll
    for (int a = 0; a < 2; ++a)
#pragma unroll
        for (int b = 0; b < 2; ++b)
#pragma unroll
            for (int m = 0; m < 4; ++m)
#pragma unroll
                for (int n = 0; n < 2; ++n) acc[a][b][m][n] = (f32x4){0.f, 0.f, 0.f, 0.f};
    bf16x8 At[4][2], B0[2][2], B1[2][2];
    const char* cA = (const char*)g.A + (size_t)cur.pm * tstep; const char* cB = (const char*)g.Bt + (size_t)cur.pn * tstep + (size_t)cur.eb * g.bstride;
    S.a_ready(cur);
    if constexpr (SP2) {
        PG8_STAGE(PG8_SB(0, 0), cB, voffB); PG8_STAGE(PG8_SB(0, 1), cB + hstep, voffB); PG8_STAGE(PG8_SA(0, 0), cA, voffA); PG8_STAGE(PG8_SA(0, 1), cA + hstep, voffA);
        if (wr == 1) PG8_BAR;
        PG8_WAIT_V(2); PG8_BAR;
        PG8_STAGE(PG8_SB(1, 0), cB + kstep, voffB); PG8_STAGE(PG8_SA(1, 0), cA + kstep, voffA); PG8_STAGE(PG8_SB(1, 1), cB + hstep + kstep, voffB);
        PG8_WAIT_V(6); PG8_BAR;
    } else {
        PG8_STAGE(PG8_SB(0, 0), cB, voffB); PG8_STAGE(PG8_SA(0, 0), cA, voffA); PG8_STAGE(PG8_SB(0, 1), cB + hstep, voffB); PG8_STAGE(PG8_SA(0, 1), cA + hstep, voffA);
        if (wr == 1) PG8_BAR;
        PG8_WAIT_V(4); PG8_BAR;
        PG8_STAGE(PG8_SB(1, 0), cB + kstep, voffB); PG8_STAGE(PG8_SA(1, 0), cA + kstep, voffA); PG8_STAGE(PG8_SB(1, 1), cB + hstep + kstep, voffB);
        PG8_WAIT_V(6); PG8_BAR;
    }
    for (;;) {
        const bool has_next = S.next(ui + 1, nxt);
        const char* nA = has_next ? (const char*)g.A + (size_t)nxt.pm * tstep : cA; const char* nB = has_next ? (const char*)g.Bt + (size_t)nxt.pn * tstep + (size_t)nxt.eb * g.bstride : cB;
        for (int t = 0; t < nt; t += 2) {
            const bool last = (t == nt - 2);
            const char* a1 = cA + (size_t)(t + 1) * kstep;
            const char* a2 = last ? nA : cA + (size_t)(t + 2) * kstep; const char* b2 = last ? nB : cB + (size_t)(t + 2) * kstep;
            const char* a3 = a2 + kstep; const char* b3 = b2 + kstep;
            if (last && has_next) S.a_ready(nxt);
            if constexpr (SP2) {
            PG8_LDB(B0, 0, 0); PG8_LDB(B1, 0, 1); PG8_SCHED; PG8_LDA(At, 0, 0); PG8_STAGE(PG8_SA(1, 1), a1 + hstep, voffA);
            PG8_WAIT_V(8); PG8_WAIT_L(0); PG8_BAR; PG8_MMA(0, 0, At, B0); PG8_MMA(0, 1, At, B1); PG8_BAR; PG8_SCHED;
            PG8_LDA(At, 0, 1); PG8_STAGE(PG8_SB(0, 0), b2, voffB); PG8_STAGE(PG8_SB(0, 1), b2 + hstep, voffB); PG8_STAGE(PG8_SA(0, 0), a2, voffA);
            PG8_WAIT_V(8); PG8_WAIT_L(0); PG8_BAR; PG8_MMA(1, 0, At, B0); PG8_MMA(1, 1, At, B1); PG8_BAR; PG8_SCHED;
            PG8_LDB(B0, 1, 0); PG8_LDB(B1, 1, 1); PG8_SCHED; PG8_LDA(At, 1, 0); PG8_STAGE(PG8_SA(0, 1), a2 + hstep, voffA);
            PG8_WAIT_V(8); PG8_WAIT_L(0); PG8_BAR; PG8_MMA(0, 0, At, B0); PG8_MMA(0, 1, At, B1); PG8_BAR; PG8_SCHED;
            PG8_LDA(At, 1, 1); PG8_STAGE(PG8_SB(1, 0), b3, voffB); PG8_STAGE(PG8_SB(1, 1), b3 + hstep, voffB); PG8_STAGE(PG8_SA(1, 0), a3, voffA);
            PG8_WAIT_V(8); PG8_WAIT_L(0); PG8_BAR; PG8_MMA(1, 0, At, B0); PG8_MMA(1, 1, At, B1); PG8_BAR; PG8_SCHED;
            } else {
            PG8_LDB(B0, 0, 0); PG8_SCHED; PG8_LDA(At, 0, 0); PG8_STAGE(PG8_SA(1, 1), a1 + hstep, voffA);
            PG8_WAIT_L(8); PG8_BAR; PG8_WAIT_L(0); PG8_MMA(0, 0, At, B0); PG8_BAR; PG8_SCHED;
            PG8_LDB(B1, 0, 1); PG8_STAGE(PG8_SB(0, 0), b2, voffB);
            PG8_BAR; PG8_WAIT_L(0); PG8_MMA(0, 1, At, B1); PG8_BAR;
            PG8_LDA(At, 0, 1); PG8_STAGE(PG8_SA(0, 0), a2, voffA);
            PG8_BAR; PG8_WAIT_L(0); PG8_MMA(1, 0, At, B0); PG8_BAR; PG8_SCHED;
            PG8_STAGE(PG8_SB(0, 1), b2 + hstep, voffB);
            PG8_WAIT_V(6); PG8_BAR; PG8_MMA(1, 1, At, B1); PG8_BAR;
            PG8_LDB(B0, 1, 0); PG8_SCHED; PG8_LDA(At, 1, 0); PG8_STAGE(PG8_SA(0, 1), a2 + hstep, voffA);
            PG8_WAIT_L(8); PG8_BAR; PG8_WAIT_L(0); PG8_MMA(0, 0, At, B0); PG8_BAR; PG8_SCHED;
            PG8_LDB(B1, 1, 1); PG8_STAGE(PG8_SB(1, 0), b3, voffB);
            PG8_BAR; PG8_WAIT_L(0); PG8_MMA(0, 1, At, B1); PG8_BAR;
            PG8_LDA(At, 1, 1); PG8_STAGE(PG8_SA(1, 0), a3, voffA);
            PG8_BAR; PG8_WAIT_L(0); PG8_MMA(1, 0, At, B0); PG8_BAR; PG8_SCHED;
            PG8_STAGE(PG8_SB(1, 1), b3 + hstep, voffB);
            PG8_WAIT_V(6); PG8_BAR; PG8_MMA(1, 1, At, B1); PG8_BAR;
            }
        }
        if constexpr (ALIGN_EPI) { if (wr == 0) PG8_BAR; }
        if constexpr (!Epi::AFTER_DRAIN) { E(acc, cur, wr, wc, fr, fq); S.done(cur); }
        if (!has_next) break;
#pragma unroll
        for (int a = 0; a < 2; ++a)
#pragma unroll
            for (int b = 0; b < 2; ++b)
#pragma unroll
                for (int m = 0; m < 4; ++m)
#pragma unroll
                    for (int n = 0; n < 2; ++n) acc[a][b][m][n] = (f32x4){0.f, 0.f, 0.f, 0.f};
        cur = nxt; cA = nA; cB = nB; ++ui;
        if constexpr (ALIGN_EPI) { if (wr == 1) PG8_BAR; }
    }
    PG8_WAIT_V(0);
    if constexpr (!ALIGN_EPI) { if (wr == 0) PG8_BAR; }
    PG8_BAR;
    if constexpr (Epi::AFTER_DRAIN) { E.fused(acc, cur, wr, wc, fr, fq, lds, wid, lane); S.done(cur); }
#undef PG8_SA
#undef PG8_SB
#undef PG8_STAGE
#undef PG8_LDA
#undef PG8_LDB
#undef PG8_MMA
#undef PG8_WAIT_V
#undef PG8_WAIT_L
#undef PG8_BAR
#undef PG8_SCHED
}
}

namespace att {
typedef unsigned short bf16_t;
typedef short bf16x8 __attribute__((ext_vector_type(8)));
typedef short s16x4 __attribute__((ext_vector_type(4)));
typedef float f32x16 __attribute__((ext_vector_type(16)));
typedef unsigned u32x4 __attribute__((ext_vector_type(4)));
#define ALDS __attribute__((address_space(3)))
#define ASBAR() __builtin_amdgcn_sched_barrier(0)
constexpr int SEQ = 4096, KVBLK = 64, QBLK = 32, NW = 8, QB = NW * QBLK;
constexpr int KROW = 512, SHM_K = KVBLK * KROW, SHM_V = KVBLK * 128 * 2;
constexpr int OFF_V = 0, OFF_K = 2 * SHM_V, OFF_S = OFF_K + 2 * SHM_K, LDS_BYTES = OFF_S + NW * 64 * 4;
__device__ __forceinline__ int v_st(int k, int c) { const int kk = (k & ~0xC) | ((k & 4) << 1) | ((k & 8) >> 1); return ((kk >> 3) * 4 + (c >> 5)) * 512 + ((kk & 7) * 32 + (c & 31)) * 2; }
__device__ __forceinline__ int v_rd_base(int lane) { return ((lane & 3) << 3) | (((lane >> 2) & 3) << 6) | (((lane >> 4) & 1) << 5) | (((lane >> 5) & 1) << 8); }
constexpr int v_rd_off(int d0, int ks, int half) { return d0 * 512 + ks * 4096 + half * 2048; }
__device__ __forceinline__ int crow(int r, int hi) { return (r & 3) + 8 * (r >> 2) + 4 * hi; }
__device__ __forceinline__ unsigned cvtpk(float lo, float hi) { unsigned r; asm volatile("v_cvt_pk_bf16_f32 %0, %1, %2" : "=v"(r) : "v"(lo), "v"(hi)); return r; }

__device__ __forceinline__ void pv_tile(f32x16* o, int vb, bf16x8 pa0, bf16x8 pa1, bf16x8 pa2, bf16x8 pa3) {
#define TRRD(dst, off) asm volatile("ds_read_b64_tr_b16 %0, %1 offset:%2" : "=&v"(dst) : "v"(vb), "i"(off) : "memory")
#define PV_D0(d0) do { s16x4 l0, l1, l2, l3, h0, h1, h2, h3; constexpr int b_ = v_rd_off(d0, 0, 0);   \
        TRRD(l0, b_); TRRD(h0, b_ + 2048); TRRD(l1, b_ + 4096); TRRD(h1, b_ + 6144); TRRD(l2, b_ + 8192); TRRD(h2, b_ + 10240); TRRD(l3, b_ + 12288); TRRD(h3, b_ + 14336); \
        asm volatile("s_waitcnt lgkmcnt(0)" ::: "memory"); ASBAR();   \
        o[d0] = __builtin_amdgcn_mfma_f32_32x32x16_bf16(pa0, (bf16x8){l0[0], l0[1], l0[2], l0[3], h0[0], h0[1], h0[2], h0[3]}, o[d0], 0, 0, 0);   \
        o[d0] = __builtin_amdgcn_mfma_f32_32x32x16_bf16(pa1, (bf16x8){l1[0], l1[1], l1[2], l1[3], h1[0], h1[1], h1[2], h1[3]}, o[d0], 0, 0, 0);   \
        o[d0] = __builtin_amdgcn_mfma_f32_32x32x16_bf16(pa2, (bf16x8){l2[0], l2[1], l2[2], l2[3], h2[0], h2[1], h2[2], h2[3]}, o[d0], 0, 0, 0);   \
        o[d0] = __builtin_amdgcn_mfma_f32_32x32x16_bf16(pa3, (bf16x8){l3[0], l3[1], l3[2], l3[3], h3[0], h3[1], h3[2], h3[3]}, o[d0], 0, 0, 0); } while (0)
    PV_D0(0); PV_D0(1); PV_D0(2); PV_D0(3);
#undef PV_D0
#undef TRRD
}
__device__ __forceinline__ void pack_p(const f32x16& p0, const f32x16& p1, bf16x8& pa0, bf16x8& pa1, bf16x8& pa2, bf16x8& pa3) {
#define PK4(P, B_, OUT) do { unsigned a0 = cvtpk(P[B_+0], P[B_+1]), a1 = cvtpk(P[B_+2], P[B_+3]);                          \
        unsigned b0 = cvtpk(P[B_+4], P[B_+5]), b1 = cvtpk(P[B_+6], P[B_+7]);                                             \
        auto r0 = __builtin_amdgcn_permlane32_swap(a0, b0, false, false); auto r1 = __builtin_amdgcn_permlane32_swap(a1, b1, false, false); \
        u32x4 w = {r0[0], r1[0], r0[1], r1[1]}; OUT = __builtin_bit_cast(bf16x8, w); } while (0)
    PK4(p0, 0, pa0); PK4(p0, 8, pa1); PK4(p1, 0, pa2); PK4(p1, 8, pa3);
#undef PK4
}
__device__ __forceinline__ float swap_max(float v) { auto rr = __builtin_amdgcn_permlane32_swap(__float_as_uint(v), __float_as_uint(v), false, false); return fmaxf(__uint_as_float(rr[0]), __uint_as_float(rr[1])); }
__device__ __forceinline__ float swap_sum(float v) { auto rr = __builtin_amdgcn_permlane32_swap(__float_as_uint(v), __float_as_uint(v), false, false); return __uint_as_float(rr[0]) + __uint_as_float(rr[1]); }

template <int MODE>
__device__ __forceinline__ void attn_unit(int b, int h, int qb, const bf16_t* __restrict__ Qp, const bf16_t* __restrict__ KVp, const bf16_t* __restrict__ KRp, bf16_t* __restrict__ Op, ALDS char* lds) {
    constexpr int DK = MODE == 0 ? 192 : 128, NQ = DK / 16, KI = DK / 64;
    int tid_ = threadIdx.x; asm volatile("" : "+v"(tid_));
    const int tid = tid_, wid = __builtin_amdgcn_readfirstlane(tid >> 6), lane = tid & 63, r32 = lane & 31, hi = lane >> 5;
    const size_t tok0 = (size_t)b * SEQ;
    const int q0 = qb * QB, qlo = q0 + wid * QBLK;
    bf16x8 qr[NQ];
    { const size_t row = tok0 + qlo + r32;
#pragma unroll
      for (int d0 = 0; d0 < NQ; ++d0) {
          const bf16_t* p;
          if (MODE == 0) p = (d0 < 8) ? Qp + row * 1536 + h * 128 + d0 * 16 + hi * 8 : Qp + row * 1536 + 1024 + h * 64 + (d0 - 8) * 16 + hi * 8;
          else p = Qp + row * 1024 + h * 128 + d0 * 16 + hi * 8;
          qr[d0] = *(const bf16x8*)p; } }
    const int krow = tid >> 3, kcg = tid & 7;
    const int kws = krow * KROW + ((kcg ^ (krow & 7)) << 4);
    const int sr = tid >> 4, sc = (tid & 15) * 8;
    const int vst0 = v_st(sr, sc), vst1 = v_st(32 + sr, sc);
    const bf16_t* ksrc = (MODE == 0) ? KVp + (tok0 + krow) * 2048 + h * 256 + kcg * 8 : KVp + (tok0 + krow) * 2048 + h * 128 + kcg * 8;
    const bf16_t* krsrc = (MODE == 0) ? KRp + (tok0 + krow) * 64 + kcg * 8 : nullptr;
    const bf16_t* vsrc = (MODE == 0) ? KVp + (tok0 + sr) * 2048 + h * 256 + 128 + sc : KVp + (tok0 + sr) * 2048 + 1024 + h * 128 + sc;
    bf16x8 stk[KI], stv0, stv1;
#define ST_LOAD(j) do { const size_t k0_ = (size_t)(j) * KVBLK; \
        stk[0] = *(const bf16x8*)(ksrc + k0_ * 2048); stk[1] = *(const bf16x8*)(ksrc + k0_ * 2048 + 64); \
        if (MODE == 0) stk[KI - 1] = *(const bf16x8*)(krsrc + k0_ * 64); \
        stv0 = *(const bf16x8*)(vsrc + k0_ * 2048); stv1 = *(const bf16x8*)(vsrc + (k0_ + 32) * 2048); } while (0)
#define ST_WRITE(buf) do { ALDS char* kb_ = lds + OFF_K + (buf) * SHM_K + kws; \
        _Pragma("unroll") for (int i_ = 0; i_ < KI; ++i_) *(ALDS bf16x8*)(kb_ + i_ * 128) = stk[i_]; \
        *(ALDS bf16x8*)(lds + OFF_V + (buf) * SHM_V + vst0) = stv0; *(ALDS bf16x8*)(lds + OFF_V + (buf) * SHM_V + vst1) = stv1; } while (0)
    int kb[4];
#pragma unroll
    for (int dd = 0; dd < 4; ++dd) kb[dd] = OFF_K + r32 * KROW + (((dd * 2 + hi) ^ (r32 & 7)) << 4);
    const int vb0 = (int)(unsigned)(uintptr_t)(lds + OFF_V) + v_rd_base(lane);
    ALDS float* wsf = (ALDS float*)(lds + OFF_S) + wid * 64;
    const int NT = 4 * qb + 4;
    f32x16 o[4] = {};
    float m_reg = -1e30f, l_reg = 0.f, carry = 0.f;
    const float NEG = -__builtin_inff();
#define TILE_OF(s) (MODE == 0 ? (s) : NT - 1 - (s))
    ST_LOAD(TILE_OF(0)); ST_WRITE(0);
    __syncthreads();
    for (int s = 0; s < NT; ++s) {
        const int j = TILE_OF(s), buf = s & 1;
        if (s + 1 < NT) ST_LOAD(TILE_OF(s + 1));
        const int kb0 = j * KVBLK;
        const bool active = (MODE == 0) ? (kb0 <= qlo + QBLK - 1) : (kb0 < qlo + QBLK - 1);
        if (active) {
            f32x16 p0 = {}, p1 = {};
            { const ALDS char* kbase = lds + buf * SHM_K;
#pragma unroll
              for (int d0 = 0; d0 < NQ; ++d0) { const ALDS char* a = kbase + kb[d0 & 3] + (d0 >> 2) * 128;
                  const bf16x8 b0 = *(const ALDS bf16x8*)a; const bf16x8 b1 = *(const ALDS bf16x8*)(a + 32 * KROW);
                  p0 = __builtin_amdgcn_mfma_f32_32x32x16_bf16(b0, qr[d0], p0, 0, 0, 0);
                  p1 = __builtin_amdgcn_mfma_f32_32x32x16_bf16(b1, qr[d0], p1, 0, 0, 0); } }
            const bool needmask = (MODE == 0) ? (kb0 + KVBLK - 1 > qlo) : (kb0 + KVBLK - 1 >= qlo);
            if (needmask) { const int dq = qlo + r32 - kb0 - 4 * hi;
#pragma unroll
                for (int r = 0; r < 16; ++r) { const int c = (r & 3) + 8 * (r >> 2);
                    if (MODE == 0) { if (c > dq) p0[r] = NEG; if (c + 32 > dq) p1[r] = NEG; }
                    else { if (c >= dq) p0[r] = NEG; if (c + 32 >= dq) p1[r] = NEG; } } }
            bf16x8 pa0, pa1, pa2, pa3;
            if (MODE == 0) {
                float pmax = p0[0];
#pragma unroll
                for (int r = 1; r < 16; ++r) pmax = fmaxf(pmax, p0[r]);
#pragma unroll
                for (int r = 0; r < 16; ++r) pmax = fmaxf(pmax, p1[r]);
                pmax = swap_max(pmax);
                float alpha = 1.f;
                if (!__all(pmax - m_reg <= 8.0f)) { const float mn = fmaxf(m_reg, pmax); alpha = __builtin_amdgcn_exp2f(m_reg - mn); m_reg = mn; }
                float ps = 0.f;
#pragma unroll
                for (int r = 0; r < 16; ++r) { p0[r] = __builtin_amdgcn_exp2f(p0[r] - m_reg); ps += p0[r]; }
#pragma unroll
                for (int r = 0; r < 16; ++r) { p1[r] = __builtin_amdgcn_exp2f(p1[r] - m_reg); ps += p1[r]; }
                ps = swap_sum(ps);
                l_reg = l_reg * alpha + ps;
                if (__any(alpha < 1.f)) { if (hi == 0) wsf[r32] = alpha; asm volatile("s_waitcnt lgkmcnt(0)" ::: "memory");
#pragma unroll
                    for (int r = 0; r < 16; ++r) { const float f = wsf[crow(r, hi)];
#pragma unroll
                        for (int d_ = 0; d_ < 4; ++d_) o[d_][r] *= f; }
                    asm volatile("s_waitcnt lgkmcnt(0)" ::: "memory"); }
            } else {
                float si[9];
#define SB_GRP(P, B_, k) do { const float za = P[B_], zb = P[B_ + 1], zc = P[B_ + 2], zd = P[B_ + 3]; \
                    const float sa = fmaxf(za, 0.f) + __builtin_amdgcn_logf(1.0f + __builtin_amdgcn_exp2f(-fabsf(za))), sb = fmaxf(zb, 0.f) + __builtin_amdgcn_logf(1.0f + __builtin_amdgcn_exp2f(-fabsf(zb))); \
                    const float sc_ = fmaxf(zc, 0.f) + __builtin_amdgcn_logf(1.0f + __builtin_amdgcn_exp2f(-fabsf(zc))), sd = fmaxf(zd, 0.f) + __builtin_amdgcn_logf(1.0f + __builtin_amdgcn_exp2f(-fabsf(zd))); \
                    const float u1 = -sd, u2 = u1 - sc_, u3 = u2 - sb; si[k] = u3 - sa; \
                    P[B_ + 3] = zd - sd; P[B_ + 2] = (zc - sc_) + u1; P[B_ + 1] = (zb - sb) + u2; P[B_] = (za - sa) + u3; } while (0)
                SB_GRP(p0, 0, 0); SB_GRP(p0, 4, 1); SB_GRP(p0, 8, 2); SB_GRP(p0, 12, 3); SB_GRP(p1, 0, 4); SB_GRP(p1, 4, 5); SB_GRP(p1, 8, 6); SB_GRP(p1, 12, 7);
#undef SB_GRP
                si[8] = 0.f;
#pragma unroll
                for (int k = 6; k >= 0; --k) si[k] += si[k + 1];
#pragma unroll
                for (int k = 0; k < 8; ++k) {
                    auto rr = __builtin_amdgcn_permlane32_swap(__float_as_uint(si[k]), __float_as_uint(si[k + 1]), false, false);
                    const float other = hi ? __uint_as_float(rr[0]) : __uint_as_float(rr[1]);
                    const float X = carry + si[k + 1] + other;
                    if (k < 4) {
#pragma unroll
                        for (int i = 0; i < 4; ++i) p0[4 * k + i] = __builtin_amdgcn_exp2f(p0[4 * k + i] + X); }
                    else {
#pragma unroll
                        for (int i = 0; i < 4; ++i) p1[4 * (k - 4) + i] = __builtin_amdgcn_exp2f(p1[4 * (k - 4) + i] + X); }
                }
                carry += swap_sum(si[0]);
            }
            pack_p(p0, p1, pa0, pa1, pa2, pa3);
            pv_tile(o, vb0 + buf * SHM_V, pa0, pa1, pa2, pa3);
        }
        if (s + 1 < NT) ST_WRITE((s + 1) & 1);
        __syncthreads();
    }
    float rli[16];
    if (MODE == 0) { if (hi == 0) wsf[32 + r32] = l_reg; asm volatile("s_waitcnt lgkmcnt(0)" ::: "memory");
#pragma unroll
        for (int r = 0; r < 16; ++r) rli[r] = __builtin_amdgcn_rcpf(wsf[32 + crow(r, hi)]);
    } else {
#pragma unroll
        for (int r = 0; r < 16; ++r) rli[r] = 1.f; }
    bf16_t* Ow = Op + (tok0 + qlo) * 1024 + h * 128;
#pragma unroll
    for (int r = 0; r < 16; ++r) { const int orow = crow(r, hi);
#pragma unroll
        for (int d0 = 0; d0 < 4; ++d0) { const float v = o[d0][r] * rli[r]; const float vn = __shfl_xor(v, 1);
            if ((r32 & 1) == 0) *(unsigned*)(Ow + (size_t)orow * 1024 + d0 * 32 + r32) = cvtpk(v, vn); } }
    asm volatile("s_waitcnt lgkmcnt(0)" ::: "memory");
    __syncthreads();
#undef ST_LOAD
#undef ST_WRITE
#undef TILE_OF
}
#undef ASBAR
}

constexpr int NWAVES = 8;
#ifndef MK_PER_PHASE
#define MK_PER_PHASE 1
#endif
constexpr int BATCH = 8, SEQ = 4096, DM = 1024, NTOK = BATCH * SEQ;
constexpr int QLORA = 384, QLP = 512  , KVLORA = 256, ROPE = 64, NLAT = 704, NLATP = 768, NHEAD = 8;
constexpr int NQ = NHEAD * 192, NKV = NHEAD * 256, DFF = 3584, NGU = 2 * DFF, NEXP = 8;
constexpr int MOE_ROWS = 2 * NTOK + NEXP * 256;
constexpr float EPSN = 1e-6f;
constexpr float C2_MLA = 1.4426950408889634f * 0.07216878364870322f;
constexpr float C2_SB = 1.4426950408889634f * 0.08838834764831845f;
constexpr size_t MiB = 1u << 20;
constexpr size_t WS_CTL = 0, CTL_ZERO_BYTES = 1 * MiB;
constexpr size_t WS_MOD = 1 * MiB;
constexpr size_t WS_MODKV = WS_MOD + (size_t)2 * 8 * 6144 * 4;
constexpr size_t WS_RT_E = 2 * MiB, WS_RT_POS = WS_RT_E + 256 * 1024, WS_RT_W = WS_RT_POS + 256 * 1024;
constexpr size_t WS_COS = 4 * MiB;
constexpr size_t WS_WAD = 12 * MiB, WS_WUQ = 14 * MiB, WS_WUKV = 16 * MiB, WS_WOA = 18 * MiB, WS_WKVSB = 20 * MiB, WS_WQSB = 24 * MiB, WS_WOSB = 26 * MiB;
constexpr size_t WS_WDN = 28 * MiB, WS_WGU = 36 * MiB, WS_WEGU = 50 * MiB, WS_WEDN = 162 * MiB;
constexpr size_t WS_HB0 = 224 * MiB, WS_LAT = 288 * MiB, WS_CQ = 384 * MiB, WS_CKV = 416 * MiB, WS_KROT = 720 * MiB, WS_Q = 432 * MiB, WS_KV = 528 * MiB, WS_AO = 656 * MiB;
constexpr size_t WS_ACT = 288 * MiB;
constexpr size_t WS_HB1 = 288 * MiB, WS_KVSB = 352 * MiB, WS_QSB = 480 * MiB;
constexpr size_t WS_HS = 224 * MiB, WS_ACT2 = 356 * MiB, WS_Y = 224 * MiB;
constexpr size_t WS_END = 818 * MiB;
static_assert(WS_ACT2 + (size_t)MOE_ROWS * DFF * 2 <= WS_END && WS_HS + (size_t)MOE_ROWS * DM * 2 <= WS_ACT2 && WS_WEDN + (size_t)NEXP * DM * DFF * 2 <= WS_HB0, "d_ws map");
constexpr int CW_TMO = 0, CW_CODE = 1;
constexpr int CW_BAR = 4096;
constexpr int CW_CNT = 16384;
constexpr int CW_CHK = 20480;
constexpr int RING_OFF = 0, RING_BYTES = 131072;
constexpr int LDSCTL_OFF = RING_BYTES, MISC_OFF = LDSCTL_OFF + 320;
constexpr int LDS_BYTES = 147456;
static_assert(MISC_OFF + 128 <= LDS_BYTES && att::LDS_BYTES <= RING_BYTES, "LDS map");

#define GAS __attribute__((address_space(1)))
#define LAS __attribute__((address_space(3)))
typedef unsigned short bf16;
typedef unsigned v4u __attribute__((ext_vector_type(4)));
typedef unsigned v2u __attribute__((ext_vector_type(2)));
typedef float f32x4 __attribute__((ext_vector_type(4)));
typedef float f32x2 __attribute__((ext_vector_type(2)));
typedef GAS unsigned gu32;
#define RLX_AGENT __ATOMIC_RELAXED, __HIP_MEMORY_SCOPE_AGENT
#define LDS_WAIT() asm volatile("s_waitcnt lgkmcnt(0)" ::: "memory")
#define VM_WAIT() asm volatile("s_waitcnt vmcnt(0)" ::: "memory")
__device__ __forceinline__ unsigned f2bf(float f) { unsigned u = __builtin_bit_cast(unsigned, f); return (u + 0x7fffu + ((u >> 16) & 1u)) >> 16; }
__device__ __forceinline__ unsigned pk2(float lo, float hi) { return f2bf(lo) | (f2bf(hi) << 16); }
__device__ __forceinline__ float bf2f(unsigned short h) { return __builtin_bit_cast(float, (unsigned)h << 16); }


#define XB_TMO      128
#define XB_XCNT(j)  (256  + 64 * (j))
#define XB_XSUB(j)  (1280 + 64 * (j))
#define XB_XGEN(j)  (2304 + 64 * (j))
#define XB_TOP      3328
#define XB_TOPGEN   3392
#define XCD_BAR_WORDS 3456
#define XB_SPIN_CAP (1u << 18)

__device__ __forceinline__ unsigned xb_ld(unsigned* p)              { return __hip_atomic_load(p, __ATOMIC_RELAXED, __HIP_MEMORY_SCOPE_AGENT); }
__device__ __forceinline__ unsigned xb_add(unsigned* p, unsigned v) { return __hip_atomic_fetch_add(p, v, __ATOMIC_RELAXED, __HIP_MEMORY_SCOPE_AGENT); }
__device__ __forceinline__ unsigned xb_xcc_id() { return (unsigned)__builtin_amdgcn_s_getreg((3 << 11) | 20) & 0xFu; }
#define XB_SPIN(cond, bar) do { unsigned _sp = 0; while (cond) { __builtin_amdgcn_s_sleep(1); \
    if ((++_sp & 255u) == 0u) { if (xb_ld(&(bar)[XB_TMO])) break; if (_sp > XB_SPIN_CAP) { atomicAdd(&(bar)[XB_TMO], 1u); break; } } } } while (0)

struct XcdBarrier {
    unsigned* bar; unsigned x;
    volatile LAS unsigned* st;
};

__device__ __forceinline__ XcdBarrier xcd_barrier_post(unsigned* bar, volatile LAS unsigned* st) {
    XcdBarrier b; b.bar = bar; b.x = xb_xcc_id(); b.st = st;
    if (threadIdx.x == 0) (void)xb_add(&bar[XB_XCNT(b.x)], 1u);
    return b;
}
__device__ __forceinline__ void xcd_barrier_complete(unsigned* bar, unsigned x, unsigned& nloc, unsigned& nx) {
    const unsigned G = gridDim.x * gridDim.y * gridDim.z;
    unsigned sum, cnt, mine, sp = 0u;
    for (;;) {
        sum = 0u; cnt = 0u; mine = 0u;
#pragma unroll
        for (unsigned j = 0; j < 16; ++j) { const unsigned c = xb_ld(&bar[XB_XCNT(j)]); sum += c; cnt += (c > 0u) ? 1u : 0u; mine = (j == x) ? c : mine; }
        if (sum == G) break;
        __builtin_amdgcn_s_sleep(1);
        if ((++sp & 255u) == 0u) { if (xb_ld(&bar[XB_TMO])) break; if (sp > XB_SPIN_CAP) { atomicAdd(&bar[XB_TMO], 1u); break; } }
    }
    nloc = mine > 0u ? mine : 1u; nx = cnt > 0u ? cnt : 1u;
}

__device__ __forceinline__ void xcd_barrier(const XcdBarrier& b) {
    asm volatile("s_waitcnt vmcnt(0)" ::: "memory");
    __syncthreads();
    if (threadIdx.x == 0) {
        unsigned* bar = b.bar;
        __builtin_amdgcn_s_waitcnt(0);
        unsigned nloc = b.st[0], nx = b.st[1];
        if (nloc == 0u) { xcd_barrier_complete(bar, b.x, nloc, nx); b.st[0] = nloc; b.st[1] = nx; }
        const unsigned old = xb_add(&bar[XB_XSUB(b.x)], 1u);
        const unsigned gen = old / nloc;
        if (old + 1u == (gen + 1u) * nloc) {
            __builtin_amdgcn_fence(__ATOMIC_RELEASE, "agent");
            asm volatile("s_waitcnt vmcnt(0)" ::: "memory");
            const unsigned og = xb_add(&bar[XB_TOP], 1u);
            const unsigned tg = og / nx;
            if (og + 1u == (tg + 1u) * nx) xb_add(&bar[XB_TOPGEN], 1u);
            else XB_SPIN(xb_ld(&bar[XB_TOPGEN]) == tg, bar);
            __builtin_amdgcn_fence(__ATOMIC_ACQUIRE, "agent");
            xb_add(&bar[XB_XGEN(b.x)], 1u);
            asm volatile("s_waitcnt vmcnt(0)" ::: "memory");
        } else {
            XB_SPIN(xb_ld(&bar[XB_XGEN(b.x)]) == gen, bar);
            __builtin_amdgcn_fence(__ATOMIC_ACQUIRE, "agent");
            asm volatile("s_waitcnt vmcnt(0)" ::: "memory");
        }
    }
    __syncthreads();
}


struct Frame {
    LAS unsigned char* lds;
    volatile LAS unsigned* MISC;
    gu32* ctl;
    int tid, lane, wave;
    int vcu, G;
    unsigned char* ws;
};
struct Args { const float* in[26]; float* out; unsigned char* ws; float inv[32]; int ph_lo, ph_hi, li, pad; };

__device__ __forceinline__ float wave_sum(float v) {
#pragma unroll
    for (int o = 1; o < 64; o <<= 1) v += __shfl_xor(v, o);
    return v;
}
__device__ __forceinline__ int rope_src(int p) { const int g = p >> 3, jj = p & 7; return jj < 4 ? 4 * g + jj : 32 + 4 * g + (jj - 4); }
__device__ __forceinline__ int src_col(int kind, int rho) {
    if (kind == 1) return rho < 640 ? rho : (rho < 704 ? 640 + rope_src(rho - 640) : -1);
    if (kind == 2) { if (rho < 1024) return (rho >> 7) * 192 + (rho & 127); const int r = rho - 1024; return (r >> 6) * 192 + 128 + rope_src(r & 63); }
    if (kind == 3) { const int t = rho >> 8, r = rho & 255; return r < 128 ? t * 128 + r : DFF + t * 128 + (r - 128); }
    return rho;
}
__device__ __forceinline__ void p0_transpose_item(const float* W, int K, int N, bf16* WT, int kind, LAS float* scr, int item, int nblk, int lane, int Kd = 0) {
    if (Kd == 0) Kd = K;
    const int kb = item / nblk, nb = item % nblk, k0 = 64 * kb, n0 = 32 * nb;
    const int sc = src_col(kind, n0 + (lane & 31));
#pragma unroll 8
    for (int i = 0; i < 32; ++i) { const int kk = 2 * i + (lane >> 5); scr[kk * 33 + (lane & 31)] = (sc >= 0 && k0 + kk < K) ? W[(size_t)(k0 + kk) * N + sc] : 0.f; }
    LDS_WAIT(); asm volatile("" ::: "memory");
    const int c = lane & 7;
#pragma unroll
    for (int j = 0; j < 4; ++j) { const int n = (lane >> 3) + 8 * j; const LAS float* s = scr + (8 * c) * 33 + n;
        v4u o; o.x = pk2(s[0 * 33], s[1 * 33]); o.y = pk2(s[2 * 33], s[3 * 33]); o.z = pk2(s[4 * 33], s[5 * 33]); o.w = pk2(s[6 * 33], s[7 * 33]);
        *(GAS v4u*)(WT + (size_t)(n0 + n) * Kd + k0 + 8 * c) = o; }
    LDS_WAIT(); asm volatile("" ::: "memory");
}

__device__ __forceinline__ void p0_prologue(Frame& F, const Args& a) {
    {
        LAS float* sl = (LAS float*)(F.lds + RING_OFF);
        LAS float* red = (LAS float*)(F.lds + RING_OFF + 32768);
        float* MOD = (float*)(F.ws + WS_MOD); float* MODKV = (float*)(F.ws + WS_MODKV);
        if (F.vcu < 112) {
            for (int i = F.tid; i < 8192; i += NWAVES * 64) { const float c = a.in[1][i]; sl[i] = c / (1.0f + __expf(-c)); }
            __syncthreads();
        }
        for (int cg = F.vcu; cg < 112; cg += F.G) {
            const float* W; const float* bias; float* out; int ldw, ldo, col0;
            if (cg < 48) { W = a.in[3]; bias = a.in[4]; out = MOD; ldw = 6144; ldo = 6144; col0 = cg * 128; }
            else if (cg < 96) { W = a.in[3] + (size_t)DM * 6144; bias = a.in[4] + 6144; out = MOD + 8 * 6144; ldw = 6144; ldo = 6144; col0 = (cg - 48) * 128; }
            else { W = a.in[13]; bias = a.in[14]; out = MODKV; ldw = 2048; ldo = 2048; col0 = (cg - 96) * 128; }
            f32x2 acc[8];
#pragma unroll
            for (int b = 0; b < 8; ++b) acc[b] = (f32x2){0.f, 0.f};
            const float* wp = W + (size_t)(F.wave * 128) * ldw + col0 + 2 * F.lane;
#pragma unroll 4
            for (int k = 0; k < 128; ++k) { const f32x2 w2 = *(const f32x2*)(wp + (size_t)k * ldw);
#pragma unroll
                for (int b = 0; b < 8; ++b) { const float s = sl[b * 1024 + F.wave * 128 + k]; acc[b] += w2 * s; } }
#pragma unroll
            for (int b = 0; b < 8; ++b) *(LAS f32x2*)(red + (F.wave * 8 + b) * 128 + 2 * F.lane) = acc[b];
            __syncthreads();
            for (int idx = F.tid; idx < 1024; idx += NWAVES * 64) { const int b = idx >> 7, col = idx & 127; float s = bias[col0 + col];
#pragma unroll
                for (int w = 0; w < 8; ++w) s += red[(w * 8 + b) * 128 + col];
                out[(size_t)b * ldo + col0 + col] = s; }
            __syncthreads();
        }
        __syncthreads();
    }
    {
        float* CS = (float*)(F.ws + WS_COS); const int* pos = (const int*)a.in[2];
        for (int idx = (F.vcu * NWAVES * 64) + F.tid; idx < NTOK * 32; idx += F.G * NWAVES * 64) {
            const int t = idx >> 5, i = idx & 31;
            const double rev = (double)pos[t] * (double)a.inv[i] * 0.15915494309189535;
            const float fr = (float)(rev - __builtin_rint(rev));
            CS[t * 64 + i] = __builtin_amdgcn_cosf(fr); CS[t * 64 + 32 + i] = __builtin_amdgcn_sinf(fr);
        }
    }
    {
        LAS float* scr = (LAS float*)(F.lds + RING_OFF + F.wave * 16384);
        const int gw = F.vcu * NWAVES + F.wave, NGW = F.G * NWAVES;
        constexpr int I_EGU = (DM / 64) * (NGU / 32), I_EDN = (DFF / 64) * (DM / 32);
        constexpr int I_GU = I_EGU, I_DN = I_EDN, I_AD = (DM / 64) * (NLATP / 32), I_UQ = (QLP / 64) * (NQ / 32), I_UKV = (KVLORA / 64) * (NKV / 32);
        constexpr int I_SQ = (DM / 64) * (DM / 32), I_KVSB = (DM / 64) * (2048 / 32);
        constexpr int NITEMS = NEXP * I_EGU + NEXP * I_EDN + I_GU + I_DN + I_AD + I_UQ + I_UKV + 3 * I_SQ + I_KVSB;
        for (int it = gw; it < NITEMS; it += NGW) {
            int r = it;
            if (r < NEXP * I_EGU) { const int e = r / I_EGU; r -= e * I_EGU; p0_transpose_item(a.in[23] + (size_t)e * DM * NGU, DM, NGU, (bf16*)(F.ws + WS_WEGU) + (size_t)e * NGU * DM, 3, scr, r, NGU / 32, F.lane); continue; } r -= NEXP * I_EGU;
            if (r < NEXP * I_EDN) { const int e = r / I_EDN; r -= e * I_EDN; p0_transpose_item(a.in[24] + (size_t)e * DFF * DM, DFF, DM, (bf16*)(F.ws + WS_WEDN) + (size_t)e * DM * DFF, 0, scr, r, DM / 32, F.lane); continue; } r -= NEXP * I_EDN;
            if (r < I_GU) { p0_transpose_item(a.in[19], DM, NGU, (bf16*)(F.ws + WS_WGU), 3, scr, r, NGU / 32, F.lane); continue; } r -= I_GU;
            if (r < I_DN) { p0_transpose_item(a.in[20], DFF, DM, (bf16*)(F.ws + WS_WDN), 0, scr, r, DM / 32, F.lane); continue; } r -= I_DN;
            if (r < I_AD) { p0_transpose_item(a.in[7], DM, NLAT, (bf16*)(F.ws + WS_WAD), 1, scr, r, NLATP / 32, F.lane); continue; } r -= I_AD;
            if (r < I_UQ) { p0_transpose_item(a.in[10], QLORA, NQ, (bf16*)(F.ws + WS_WUQ), 2, scr, r, NQ / 32, F.lane, QLP); continue; } r -= I_UQ;
            if (r < I_UKV) { p0_transpose_item(a.in[11], KVLORA, NKV, (bf16*)(F.ws + WS_WUKV), 0, scr, r, NKV / 32, F.lane); continue; } r -= I_UKV;
            if (r < I_SQ) { p0_transpose_item(a.in[12], DM, DM, (bf16*)(F.ws + WS_WOA), 0, scr, r, DM / 32, F.lane); continue; } r -= I_SQ;
            if (r < I_SQ) { p0_transpose_item(a.in[17], DM, DM, (bf16*)(F.ws + WS_WQSB), 0, scr, r, DM / 32, F.lane); continue; } r -= I_SQ;
            if (r < I_SQ) { p0_transpose_item(a.in[18], DM, DM, (bf16*)(F.ws + WS_WOSB), 0, scr, r, DM / 32, F.lane); continue; } r -= I_SQ;
            p0_transpose_item(a.in[16], DM, 2048, (bf16*)(F.ws + WS_WKVSB), 0, scr, r, 2048 / 32, F.lane);
        }
    }
}

template <bool TWO>
__device__ __forceinline__ void norm_phase(Frame& F, const float* X, const float* g0, const float* sc0, const float* sh0, int st0, bf16* H0,
                                           const float* g1, const float* sc1, const float* sh1, int st1, bf16* H1) {
    const int gw = F.vcu * NWAVES + F.wave, NGW = F.G * NWAVES;
    for (int c = gw; c < NTOK / 16; c += NGW) {
        const int row0 = c * 16, b = row0 / SEQ;
        f32x4 A0[4], B0[4], A1[4], B1[4];
#pragma unroll
        for (int j = 0; j < 4; ++j) { const int col = 4 * F.lane + 256 * j;
            A0[j] = *(const f32x4*)(g0 + col) * (*(const f32x4*)(sc0 + (size_t)b * st0 + col) + 1.0f); B0[j] = *(const f32x4*)(sh0 + (size_t)b * st0 + col);
            if (TWO) { A1[j] = *(const f32x4*)(g1 + col) * (*(const f32x4*)(sc1 + (size_t)b * st1 + col) + 1.0f); B1[j] = *(const f32x4*)(sh1 + (size_t)b * st1 + col); } }
#pragma unroll 2
        for (int r = 0; r < 16; ++r) {
            const GAS f32x4* xr = (const GAS f32x4*)(X + (size_t)(row0 + r) * DM) + F.lane;
            f32x4 v[4]; float s2 = 0.f;
#pragma unroll
            for (int j = 0; j < 4; ++j) { v[j] = xr[64 * j]; s2 += (v[j].x * v[j].x + v[j].y * v[j].y) + (v[j].z * v[j].z + v[j].w * v[j].w); }
            const float rstd = 1.0f / sqrtf(wave_sum(s2) * (1.0f / DM) + EPSN);
            GAS unsigned long long* o0 = (GAS unsigned long long*)(H0 + (size_t)(row0 + r) * DM) + F.lane;
#pragma unroll
            for (int j = 0; j < 4; ++j) { const f32x4 y = v[j] * rstd * A0[j] + B0[j]; o0[64 * j] = (unsigned long long)pk2(y.x, y.y) | ((unsigned long long)pk2(y.z, y.w) << 32); }
            if (TWO) { GAS unsigned long long* o1 = (GAS unsigned long long*)(H1 + (size_t)(row0 + r) * DM) + F.lane;
#pragma unroll
                for (int j = 0; j < 4; ++j) { const f32x4 y = v[j] * rstd * A1[j] + B1[j]; o1[64 * j] = (unsigned long long)pk2(y.x, y.y) | ((unsigned long long)pk2(y.z, y.w) << 32); } }
        }
    }
}

__device__ __forceinline__ void lat_phase(Frame& F, const Args& a) {
    const int gw = F.vcu * NWAVES + F.wave, NGW = F.G * NWAVES, l = F.lane;
    const float* LAT = (const float*)(F.ws + WS_LAT); const float* CS = (const float*)(F.ws + WS_COS);
    bf16* CQ = (bf16*)(F.ws + WS_CQ); bf16* CKV = (bf16*)(F.ws + WS_CKV); bf16* KR = (bf16*)(F.ws + WS_KROT);
    const f32x4 G0 = *(const f32x4*)(a.in[8] + 4 * l);
    const f32x4 G1 = l < 32 ? *(const f32x4*)(a.in[8] + 256 + 4 * l) : *(const f32x4*)(a.in[9] + 4 * (l - 32));
    const f32x4 G2 = l < 32 ? *(const f32x4*)(a.in[9] + 128 + 4 * l) : (f32x4){0.f, 0.f, 0.f, 0.f};
    for (int row = gw; row < NTOK; row += NGW) {
        const GAS f32x4* xr = (const GAS f32x4*)(LAT + (size_t)row * NLATP) + l;
        const f32x4 v0 = xr[0], v1 = xr[64], v2 = xr[128];
        const float q0 = (v0.x * v0.x + v0.y * v0.y) + (v0.z * v0.z + v0.w * v0.w), q1 = (v1.x * v1.x + v1.y * v1.y) + (v1.z * v1.z + v1.w * v1.w), q2 = (v2.x * v2.x + v2.y * v2.y) + (v2.z * v2.z + v2.w * v2.w);
        const float sq = wave_sum(q0 + (l < 32 ? q1 : 0.f)), skv = wave_sum((l < 32 ? q2 : q1));
        const float rq = 1.0f / sqrtf(sq * (1.0f / QLORA) + EPSN), rkv = 1.0f / sqrtf(skv * (1.0f / KVLORA) + EPSN);
        { const f32x4 y = v0 * rq * G0; *(GAS unsigned long long*)(CQ + (size_t)row * QLP + 4 * l) = (unsigned long long)pk2(y.x, y.y) | ((unsigned long long)pk2(y.z, y.w) << 32); }
        { const f32x4 y = v1 * (l < 32 ? rq : rkv) * G1; bf16* dst = l < 32 ? CQ + (size_t)row * QLP + 256 + 4 * l : CKV + (size_t)row * KVLORA + 4 * (l - 32);
          *(GAS unsigned long long*)dst = (unsigned long long)pk2(y.x, y.y) | ((unsigned long long)pk2(y.z, y.w) << 32); }
        const int u = l - 32, g = (u >> 1) & 7;
        f32x4 pr; pr.x = __shfl_xor(v2.x, 1); pr.y = __shfl_xor(v2.y, 1); pr.z = __shfl_xor(v2.z, 1); pr.w = __shfl_xor(v2.w, 1);
        if (l < 32) { const f32x4 y = v2 * rkv * G2; *(GAS unsigned long long*)(CKV + (size_t)row * KVLORA + 128 + 4 * l) = (unsigned long long)pk2(y.x, y.y) | ((unsigned long long)pk2(y.z, y.w) << 32); }
        else { *(GAS unsigned long long*)(CQ + (size_t)row * QLP + QLORA + 4 * (l - 32)) = 0ull; }
        if (l >= 32 && l < 48) { const f32x4 cs = *(const f32x4*)(CS + (size_t)row * 64 + 4 * g), sn = *(const f32x4*)(CS + (size_t)row * 64 + 32 + 4 * g);
            const f32x4 y = (u & 1) ? (pr * sn + v2 * cs) : (v2 * cs - pr * sn);
            *(GAS unsigned long long*)(KR + (size_t)row * ROPE + 4 * u) = (unsigned long long)pk2(y.x, y.y) | ((unsigned long long)pk2(y.z, y.w) << 32); }
    }
}


__device__ __forceinline__ void router_phase(Frame& F, const Args& a) {
    const int gw = F.vcu * NWAVES + F.wave, NGW = F.G * NWAVES, l = F.lane;
    const float* X = a.out; const float* MOD1 = (const float*)(F.ws + WS_MOD) + 8 * 6144;
    int* RT_E = (int*)(F.ws + WS_RT_E); int* RT_POS = (int*)(F.ws + WS_RT_POS); float* RT_W = (float*)(F.ws + WS_RT_W);
    f32x4 wr[4][4][2];
#pragma unroll
    for (int j = 0; j < 4; ++j)
#pragma unroll
        for (int i = 0; i < 4; ++i) { const float* p = a.in[21] + (size_t)(4 * l + 256 * j + i) * 8; wr[j][i][0] = *(const f32x4*)p; wr[j][i][1] = *(const f32x4*)(p + 4); }
    float br[8];
#pragma unroll
    for (int e = 0; e < 8; ++e) br[e] = a.in[22][e];
    for (int c = gw; c < NTOK / 16; c += NGW) {
        const int row0 = c * 16, b = row0 / SEQ;
        f32x4 A0[4], B0[4];
#pragma unroll
        for (int j = 0; j < 4; ++j) { const int col = 4 * l + 256 * j;
            A0[j] = *(const f32x4*)(a.in[6] + DM + col) * (*(const f32x4*)(MOD1 + (size_t)b * 6144 + 4096 + col) + 1.0f); B0[j] = *(const f32x4*)(MOD1 + (size_t)b * 6144 + 3072 + col); }
        int my_e1 = 0, my_e2 = 0; float my_w1 = 0.f, my_w2 = 0.f;
        for (int r = 0; r < 16; ++r) {
            const GAS f32x4* xr = (const GAS f32x4*)(X + (size_t)(row0 + r) * DM) + l;
            f32x4 v[4]; float s2 = 0.f;
#pragma unroll
            for (int j = 0; j < 4; ++j) { v[j] = xr[64 * j]; s2 += (v[j].x * v[j].x + v[j].y * v[j].y) + (v[j].z * v[j].z + v[j].w * v[j].w); }
            const float rstd = 1.0f / sqrtf(wave_sum(s2) * (1.0f / DM) + EPSN);
            f32x4 lo = (f32x4){0.f, 0.f, 0.f, 0.f}, hi = (f32x4){0.f, 0.f, 0.f, 0.f};
#pragma unroll
            for (int j = 0; j < 4; ++j) { const f32x4 y = v[j] * rstd * A0[j] + B0[j];
                lo += wr[j][0][0] * y.x + wr[j][1][0] * y.y + wr[j][2][0] * y.z + wr[j][3][0] * y.w;
                hi += wr[j][0][1] * y.x + wr[j][1][1] * y.y + wr[j][2][1] * y.z + wr[j][3][1] * y.w; }
            float lg[8];
            lg[0] = wave_sum(lo.x) + br[0]; lg[1] = wave_sum(lo.y) + br[1]; lg[2] = wave_sum(lo.z) + br[2]; lg[3] = wave_sum(lo.w) + br[3];
            lg[4] = wave_sum(hi.x) + br[4]; lg[5] = wave_sum(hi.y) + br[5]; lg[6] = wave_sum(hi.z) + br[6]; lg[7] = wave_sum(hi.w) + br[7];
            int e1 = 0; float v1 = lg[0];
#pragma unroll
            for (int e = 1; e < 8; ++e) if (lg[e] > v1) { v1 = lg[e]; e1 = e; }
            int e2 = -1; float v2 = -__builtin_inff();
#pragma unroll
            for (int e = 0; e < 8; ++e) if (e != e1 && lg[e] > v2) { v2 = lg[e]; e2 = e; }
            const float t = __expf(v2 - v1), w1 = 1.0f / (1.0f + t), w2 = t * w1;
            if (l == r) { my_e1 = e1; my_e2 = e2; my_w1 = w1; my_w2 = w2; }
        }
        const int E1 = __shfl(my_e1, l & 15), E2 = __shfl(my_e2, l & 15); const float W1 = __shfl(my_w1, l & 15), W2 = __shfl(my_w2, l & 15);
        const int myE = l < 16 ? E1 : (l < 32 ? E2 : -1); const float myW = l < 16 ? W1 : W2;
        int mypos = 0;
#pragma unroll
        for (int e = 0; e < 8; ++e) {
            const unsigned long long m = __ballot(myE == e); const int n = __popcll(m);
            unsigned base = 0;
            if (n > 0 && l == 0) base = __hip_atomic_fetch_add((unsigned*)(F.ctl + CW_CNT + 16 * e), (unsigned)n, RLX_AGENT);
            base = (unsigned)__builtin_amdgcn_readfirstlane((int)base);
            if (myE == e) mypos = (int)base + __popcll(m & ((1ull << l) - 1ull));
        }
        if (l < 32) { const int idx = (row0 + (l & 15)) * 2 + (l >> 4); RT_E[idx] = myE; RT_POS[idx] = mypos; RT_W[idx] = myW; }
    }
}
__device__ __forceinline__ void moe_offsets(Frame& F, unsigned (&cnt)[8], int (&off)[8]) {
    int t = 0;
#pragma unroll
    for (int e = 0; e < 8; ++e) { cnt[e] = __hip_atomic_load((unsigned*)(F.ctl + CW_CNT + 16 * e), RLX_AGENT); off[e] = t; t += (int)((cnt[e] + 255u) & ~255u); }
}
__device__ __forceinline__ void scatter_phase(Frame& F, const Args& a) {
    const int gw = F.vcu * NWAVES + F.wave, NGW = F.G * NWAVES, l = F.lane;
    const float* X = a.out; const float* MOD1 = (const float*)(F.ws + WS_MOD) + 8 * 6144;
    const int* RT_E = (const int*)(F.ws + WS_RT_E); const int* RT_POS = (const int*)(F.ws + WS_RT_POS);
    bf16* HS = (bf16*)(F.ws + WS_HS);
    unsigned cnt[8]; int off[8]; moe_offsets(F, cnt, off);
    for (int c = gw; c < NTOK / 16; c += NGW) {
        const int row0 = c * 16, b = row0 / SEQ;
        f32x4 A0[4], B0[4];
#pragma unroll
        for (int j = 0; j < 4; ++j) { const int col = 4 * l + 256 * j;
            A0[j] = *(const f32x4*)(a.in[6] + DM + col) * (*(const f32x4*)(MOD1 + (size_t)b * 6144 + 4096 + col) + 1.0f); B0[j] = *(const f32x4*)(MOD1 + (size_t)b * 6144 + 3072 + col); }
#pragma unroll 2
        for (int r = 0; r < 16; ++r) {
            const int row = row0 + r;
            const GAS f32x4* xr = (const GAS f32x4*)(X + (size_t)row * DM) + l;
            f32x4 v[4]; float s2 = 0.f;
#pragma unroll
            for (int j = 0; j < 4; ++j) { v[j] = xr[64 * j]; s2 += (v[j].x * v[j].x + v[j].y * v[j].y) + (v[j].z * v[j].z + v[j].w * v[j].w); }
            const float rstd = 1.0f / sqrtf(wave_sum(s2) * (1.0f / DM) + EPSN);
            const int e1 = RT_E[row * 2], e2 = RT_E[row * 2 + 1], p1 = RT_POS[row * 2], p2 = RT_POS[row * 2 + 1];
            int o1 = 0, o2 = 0;
#pragma unroll
            for (int e = 0; e < 8; ++e) { o1 = (e1 == e) ? off[e] : o1; o2 = (e2 == e) ? off[e] : o2; }
            GAS unsigned long long* d1 = (GAS unsigned long long*)(HS + (size_t)(o1 + p1) * DM) + l; GAS unsigned long long* d2 = (GAS unsigned long long*)(HS + (size_t)(o2 + p2) * DM) + l;
#pragma unroll
            for (int j = 0; j < 4; ++j) { const f32x4 y = v[j] * rstd * A0[j] + B0[j]; const unsigned long long w = (unsigned long long)pk2(y.x, y.y) | ((unsigned long long)pk2(y.z, y.w) << 32); d1[64 * j] = w; d2[64 * j] = w; }
        }
    }
    for (int i = gw; i < 8 * 256; i += NGW) { const int e = i >> 8, r = i & 255; int oe = 0; unsigned ce = 0;
#pragma unroll
        for (int q = 0; q < 8; ++q) { oe = (e == q) ? off[q] : oe; ce = (e == q) ? cnt[q] : ce; }
        if (ce + (unsigned)r < ((ce + 255u) & ~255u)) { GAS unsigned long long* d = (GAS unsigned long long*)(HS + (size_t)(oe + (int)ce + r) * DM) + l;
#pragma unroll
            for (int j = 0; j < 4; ++j) d[64 * j] = 0ull; } }
}
__device__ __forceinline__ void final_phase(Frame& F, const Args& a) {
    const int gw = F.vcu * NWAVES + F.wave, NGW = F.G * NWAVES, l = F.lane;
    float* X = a.out; const float* MOD1 = (const float*)(F.ws + WS_MOD) + 8 * 6144;
    const int* RT_E = (const int*)(F.ws + WS_RT_E); const int* RT_POS = (const int*)(F.ws + WS_RT_POS); const float* RT_W = (const float*)(F.ws + WS_RT_W);
    const bf16* Y = (const bf16*)(F.ws + WS_Y);
    unsigned cnt[8]; int off[8]; moe_offsets(F, cnt, off);
    for (int c = gw; c < NTOK / 16; c += NGW) {
        const int row0 = c * 16, b = row0 / SEQ;
        f32x4 GT[4], GF[4];
#pragma unroll
        for (int j = 0; j < 4; ++j) { const int col = 4 * l + 256 * j; GT[j] = *(const f32x4*)(MOD1 + (size_t)b * 6144 + 5120 + col); GF[j] = *(const f32x4*)(a.in[25] + col); }
#pragma unroll 2
        for (int r = 0; r < 16; ++r) {
            const int row = row0 + r;
            GAS f32x4* xr = (GAS f32x4*)(X + (size_t)row * DM) + l;
            const int e1 = RT_E[row * 2], e2 = RT_E[row * 2 + 1], p1 = RT_POS[row * 2], p2 = RT_POS[row * 2 + 1]; const float w1 = RT_W[row * 2], w2 = RT_W[row * 2 + 1];
            int o1 = 0, o2 = 0;
#pragma unroll
            for (int e = 0; e < 8; ++e) { o1 = (e1 == e) ? off[e] : o1; o2 = (e2 == e) ? off[e] : o2; }
            const GAS v2u* y1 = (const GAS v2u*)(Y + (size_t)(o1 + p1) * DM) + l; const GAS v2u* y2 = (const GAS v2u*)(Y + (size_t)(o2 + p2) * DM) + l;
            f32x4 v[4]; float s2 = 0.f;
#pragma unroll
            for (int j = 0; j < 4; ++j) { const v2u a1 = y1[64 * j], a2 = y2[64 * j];
                f32x4 f; f.x = w1 * __uint_as_float(a1.x << 16) + w2 * __uint_as_float(a2.x << 16); f.y = w1 * __uint_as_float(a1.x & 0xffff0000u) + w2 * __uint_as_float(a2.x & 0xffff0000u);
                f.z = w1 * __uint_as_float(a1.y << 16) + w2 * __uint_as_float(a2.y << 16); f.w = w1 * __uint_as_float(a1.y & 0xffff0000u) + w2 * __uint_as_float(a2.y & 0xffff0000u);
                v[j] = xr[64 * j] + GT[j] * f; s2 += (v[j].x * v[j].x + v[j].y * v[j].y) + (v[j].z * v[j].z + v[j].w * v[j].w); }
            const float rstd = 1.0f / sqrtf(wave_sum(s2) * (1.0f / DM) + EPSN);
#pragma unroll
            for (int j = 0; j < 4; ++j) xr[64 * j] = v[j] * rstd * GF[j];
        }
    }
}
template <int MODE>
__device__ __forceinline__ void attn_phase(Frame& F, const bf16* Q, const bf16* KV, const bf16* KR, bf16* O) {
    for (int w = 0; ; ++w) {
        const int it = F.vcu + (w >> 1) * F.G; if (it >= BATCH * NHEAD * 8) break;
        const int bh = it >> 3, s = it & 7, b = bh >> 3, h = bh & 7;
        att::attn_unit<MODE>(b, h, (w & 1) ? s : 15 - s, Q, KV, KR, O, (LAS char*)(F.lds + RING_OFF));
    }
}


constexpr int NPH = 19;
#ifndef MK_PHMASK
#define MK_PHMASK 0x7ffff
#endif
__global__ void __launch_bounds__(NWAVES * 64, 2) yoco_fwd(Args args) {
    extern __shared__ __attribute__((aligned(16))) unsigned char lds[];
    Frame F;
    F.lds = (LAS unsigned char*)lds;
    F.MISC = (volatile LAS unsigned*)(F.lds + MISC_OFF);
    F.tid = threadIdx.x; F.lane = F.tid & 63; F.wave = __builtin_amdgcn_readfirstlane(F.tid >> 6);
    F.G = gridDim.x; { const int bx = blockIdx.x; F.vcu = (F.G % 8 == 0) ? (bx % 8) * (F.G / 8) + bx / 8 : bx; }
    F.ws = args.ws; F.ctl = (gu32*)(args.ws + WS_CTL);
    for (int u = F.tid; u < (LDS_BYTES - LDSCTL_OFF) / 4; u += NWAVES * 64) ((LAS unsigned*)(F.lds + LDSCTL_OFF))[u] = 0u;
    __syncthreads();
    XcdBarrier bar; bar.bar = (unsigned*)(F.ctl + CW_BAR); bar.x = 0; bar.st = nullptr;
    if (!MK_PER_PHASE) bar = xcd_barrier_post((unsigned*)(F.ctl + CW_BAR), F.MISC + 8);
#define GRID_BAR(seam) do { if (MK_PER_PHASE) { if (F.tid == 0) __hip_atomic_store(F.ctl + CW_TMO, 0xBADBA0u | (unsigned)(seam), RLX_AGENT); } else { xcd_barrier(bar); } } while (0)
    const int lo = args.ph_lo, hi = args.ph_hi;
#define IN(k) ((((unsigned)MK_PHMASK >> (k)) & 1u) && lo <= (k) && (k) < hi)
#define REFRESH() do { int t_ = threadIdx.x; asm volatile("" : "+v"(t_)); F.tid = t_; F.lane = t_ & 63; F.wave = __builtin_amdgcn_readfirstlane(t_ >> 6); } while (0)
#define SEAM(k) do { if (IN(k) && IN((k) + 1)) GRID_BAR(k); } while (0)
    unsigned char* ws = args.ws;
    float* XS = args.out;
    const float* MOD0 = (const float*)(ws + WS_MOD); const float* MOD1 = MOD0 + 8 * 6144; const float* MODKV = (const float*)(ws + WS_MODKV);
    bf16* HB0 = (bf16*)(ws + WS_HB0); bf16* HB1 = (bf16*)(ws + WS_HB1); bf16* AO = (bf16*)(ws + WS_AO);
    LAS unsigned char* ring = F.lds + RING_OFF;

    if (IN(0)) { REFRESH(); p0_prologue(F, args); } SEAM(0);
    if (IN(1)) { REFRESH(); norm_phase<false>(F, args.in[0], args.in[5], MOD0 + 1024, MOD0, 6144, HB0, nullptr, nullptr, nullptr, 0, nullptr); } SEAM(1);
    if (IN(2)) { REFRESH(); pg8::Gemm g{HB0, (const bf16*)(ws + WS_WAD), NTOK, NLATP, DM, 0}; pg8::StaticOrder S; S.init(NTOK, NLATP, F.G, (int)blockIdx.x);
        pg8::EpiF32 E{(float*)(ws + WS_LAT), NLATP}; pg8::gemm_phase<pg8::EpiF32, pg8::StaticOrder, true, true>(ring, g, S, E); } SEAM(2);
    if (IN(3)) { REFRESH(); lat_phase(F, args); } SEAM(3);
    if (IN(4)) { REFRESH();
        { pg8::Gemm g{(const bf16*)(ws + WS_CQ), (const bf16*)(ws + WS_WUQ), NTOK, 1024, QLP, 0}; pg8::StaticOrder S; S.init(NTOK, 1024, F.G, (int)blockIdx.x);
          pg8::EpiBf16 E{(bf16*)(ws + WS_Q), NQ, C2_MLA}; pg8::gemm_phase<pg8::EpiBf16, pg8::StaticOrder, true, true>(ring, g, S, E); }
        { pg8::Gemm g{(const bf16*)(ws + WS_CQ), (const bf16*)(ws + WS_WUQ) + (size_t)1024 * QLP, NTOK, 512, QLP, 0}; pg8::StaticOrder S; S.init(NTOK, 512, F.G, (int)blockIdx.x);
          pg8::EpiRope E{(bf16*)(ws + WS_Q) + 1024, NQ, C2_MLA, (const float*)(ws + WS_COS)}; pg8::gemm_phase<pg8::EpiRope, pg8::StaticOrder, true, true>(ring, g, S, E); }
        { pg8::Gemm g{(const bf16*)(ws + WS_CKV), (const bf16*)(ws + WS_WUKV), NTOK, NKV, KVLORA, 0}; pg8::StaticOrder S; S.init(NTOK, NKV, F.G, (int)blockIdx.x);
          pg8::EpiBf16 E{(bf16*)(ws + WS_KV), NKV, 1.0f}; pg8::gemm_phase<pg8::EpiBf16, pg8::StaticOrder, true, true>(ring, g, S, E); }
    } SEAM(4);
    if (IN(5)) { REFRESH(); attn_phase<0>(F, (const bf16*)(ws + WS_Q), (const bf16*)(ws + WS_KV), (const bf16*)(ws + WS_KROT), AO); } SEAM(5);
    if (IN(6)) { REFRESH(); pg8::Gemm g{AO, (const bf16*)(ws + WS_WOA), NTOK, DM, DM, 0}; pg8::StaticOrder S; S.init(NTOK, DM, F.G, (int)blockIdx.x);
        pg8::EpiResid E{args.in[0], XS, MOD0 + 2048, 6144}; pg8::gemm_phase<pg8::EpiResid, pg8::StaticOrder, true, true>(ring, g, S, E); } SEAM(6);
    if (IN(7)) { REFRESH(); norm_phase<false>(F, XS, args.in[6], MOD0 + 4096, MOD0 + 3072, 6144, HB0, nullptr, nullptr, nullptr, 0, nullptr); } SEAM(7);
    if (IN(8)) { REFRESH(); pg8::Gemm g{HB0, (const bf16*)(ws + WS_WGU), NTOK, NGU, DM, 0}; pg8::StaticOrder S; S.init(NTOK, NGU, F.G, (int)blockIdx.x);
        pg8::EpiSwiglu E{(bf16*)(ws + WS_ACT), DFF}; pg8::gemm_phase<pg8::EpiSwiglu, pg8::StaticOrder, true, true>(ring, g, S, E); } SEAM(8);
    if (IN(9)) { REFRESH(); pg8::Gemm g{(const bf16*)(ws + WS_ACT), (const bf16*)(ws + WS_WDN), NTOK, DM, DFF, 0}; pg8::StaticOrder S; S.init(NTOK, DM, F.G, (int)blockIdx.x);
        pg8::EpiResid E{XS, XS, MOD0 + 5120, 6144}; pg8::gemm_phase<pg8::EpiResid, pg8::StaticOrder, true, true>(ring, g, S, E); } SEAM(9);
    if (IN(10)) { REFRESH(); norm_phase<true>(F, XS, args.in[15], MODKV + 1024, MODKV, 2048, HB0, args.in[5] + DM, MOD1 + 1024, MOD1, 6144, HB1); } SEAM(10);
    if (IN(11)) { REFRESH();
        { pg8::Gemm g{HB0, (const bf16*)(ws + WS_WKVSB), NTOK, 2048, DM, 0}; pg8::StaticOrder S; S.init(NTOK, 2048, F.G, (int)blockIdx.x);
          pg8::EpiBf16 E{(bf16*)(ws + WS_KVSB), 2048, 1.0f}; pg8::gemm_phase<pg8::EpiBf16, pg8::StaticOrder, true, true>(ring, g, S, E); }
        { pg8::Gemm g{HB1, (const bf16*)(ws + WS_WQSB), NTOK, DM, DM, 0}; pg8::StaticOrder S; S.init(NTOK, DM, F.G, (int)blockIdx.x);
          pg8::EpiBf16 E{(bf16*)(ws + WS_QSB), DM, C2_SB}; pg8::gemm_phase<pg8::EpiBf16, pg8::StaticOrder, true, true>(ring, g, S, E); }
    } SEAM(11);
    if (IN(12)) { REFRESH(); attn_phase<1>(F, (const bf16*)(ws + WS_QSB), (const bf16*)(ws + WS_KVSB), nullptr, AO); } SEAM(12);
    if (IN(13)) { REFRESH(); pg8::Gemm g{AO, (const bf16*)(ws + WS_WOSB), NTOK, DM, DM, 0}; pg8::StaticOrder S; S.init(NTOK, DM, F.G, (int)blockIdx.x);
        pg8::EpiResid E{XS, XS, MOD1 + 2048, 6144}; pg8::gemm_phase<pg8::EpiResid, pg8::StaticOrder, true, true>(ring, g, S, E); } SEAM(13);
    if (IN(14)) { REFRESH(); router_phase(F, args); } SEAM(14);
    if (IN(15)) { REFRESH(); scatter_phase(F, args); } SEAM(15);
    if (IN(16)) { REFRESH(); unsigned cnt[8]; int off[8]; moe_offsets(F, cnt, off);
        pg8::Gemm g{(const bf16*)(ws + WS_HS), (const bf16*)(ws + WS_WEGU), 0, NGU, DM, (size_t)NGU * DM * 2}; pg8::MoeOrder S; S.init(cnt, NGU, F.G, (int)blockIdx.x);
        pg8::EpiSwiglu E{(bf16*)(ws + WS_ACT2), DFF}; pg8::gemm_phase<pg8::EpiSwiglu, pg8::MoeOrder, true, true>(ring, g, S, E); } SEAM(16);
    if (IN(17)) { REFRESH(); unsigned cnt[8]; int off[8]; moe_offsets(F, cnt, off);
        pg8::Gemm g{(const bf16*)(ws + WS_ACT2), (const bf16*)(ws + WS_WEDN), 0, DM, DFF, (size_t)DM * DFF * 2}; pg8::MoeOrder S; S.init(cnt, DM, F.G, (int)blockIdx.x);
        pg8::EpiBf16 E{(bf16*)(ws + WS_Y), DM, 1.0f}; pg8::gemm_phase<pg8::EpiBf16, pg8::MoeOrder, true, true>(ring, g, S, E); } SEAM(17);
    if (IN(18)) { REFRESH(); final_phase(F, args); }
#undef IN
#undef SEAM
#undef REFRESH
#undef GRID_BAR
}

extern "C" void kernel_launch(void* const* d_in, const int* in_sizes, int n_in, void* d_out, int out_size, void* d_ws, size_t ws_size, hipStream_t stream) {
    static int grid = 0;
    if (grid == 0) {
        if (n_in != 26 || in_sizes[0] != NTOK * DM || out_size != NTOK * DM || ws_size < WS_END) { fprintf(stderr, "kernel_launch: shape/workspace mismatch (n_in %d, in0 %d, out %d, ws %zu, need %zu)\n", n_in, n_in > 0 ? in_sizes[0] : -1, out_size, ws_size, (size_t)WS_END); grid = -1; return; }
        int dev = 0, cus = 0, per_cu = 0;
        if (hipGetDevice(&dev) != hipSuccess || hipDeviceGetAttribute(&cus, hipDeviceAttributeMultiprocessorCount, dev) != hipSuccess) { grid = -1; return; }
        if (hipFuncSetAttribute((const void*)yoco_fwd, hipFuncAttributeMaxDynamicSharedMemorySize, LDS_BYTES) != hipSuccess) { fprintf(stderr, "kernel_launch: hipFuncSetAttribute failed\n"); grid = -1; return; }
        if (hipOccupancyMaxActiveBlocksPerMultiprocessor(&per_cu, (const void*)yoco_fwd, NWAVES * 64, LDS_BYTES) != hipSuccess || per_cu < 1) { fprintf(stderr, "kernel_launch: occupancy query reports %d\n", per_cu); }
        (void)hipGetLastError();
        grid = cus;
    }
    if (grid < 0) return;
    if (hipMemsetAsync((char*)d_ws + WS_CTL, 0, CTL_ZERO_BYTES, stream) != hipSuccess) return;
    Args a{};
    for (int i = 0; i < 26; ++i) a.in[i] = (const float*)d_in[i];
    a.out = (float*)d_out; a.ws = (unsigned char*)d_ws;
    for (int i = 0; i < 32; ++i) a.inv[i] = (float)pow(10000.0, -(double)i / 32.0);
#if MK_PER_PHASE
    for (int p = 0; p < NPH; ++p) { a.ph_lo = p; a.ph_hi = p + 1; a.li = p; hipLaunchKernelGGL(yoco_fwd, dim3(grid), dim3(NWAVES * 64), LDS_BYTES, stream, a); }
#else
    a.ph_lo = 0; a.ph_hi = NPH; a.li = 0;
    hipLaunchKernelGGL(yoco_fwd, dim3(grid), dim3(NWAVES * 64), LDS_BYTES, stream, a);
#endif
    const hipError_t le = hipPeekAtLastError();
    if (le != hipSuccess) fprintf(stderr, "kernel_launch: launch failed: %s\n", hipGetErrorName(le));
}
```

```cpp
#include <hip/hip_runtime.h>
#include <cstdio>
#include <cstdint>
#include <cmath>

namespace pg8 {
#define PG8_LAS __attribute__((address_space(3)))
typedef unsigned short bf16_t;
typedef short bf16x8 __attribute__((ext_vector_type(8)));
typedef float f32x4 __attribute__((ext_vector_type(4)));
typedef unsigned u32x4 __attribute__((ext_vector_type(4)));
constexpr int BM = 256, BK = 64, HALF = 128, HTB = HALF * BK * 2  , STAGE_BYTES = 8 * HTB, NXCD = 8, WGM = 8;

__host__ __device__ __forceinline__ int lds_byte(int r, int c) { const int st = (r >> 4) * 2 + (c >> 5), rr = r & 15, cc = c & 31, ob = rr * 64 + cc * 2; return st * 1024 + (ob ^ (((ob >> 9) & 1) << 5)); }
__host__ __device__ __forceinline__ void stage_rc(int b, int& R, int& C) { const int st = b / 1024, sb = b % 1024, swz = sb ^ (((sb >> 9) & 1) << 5); R = (st >> 1) * 16 + swz / 64; C = (st & 1) * 32 + (swz % 64) / 2; }
__host__ __device__ __forceinline__ int perm32(int rho) { const int n = rho >> 4, i = rho & 15; return 8 * (i >> 2) + 4 * n + (i & 3); }

struct Unit { int pm, pn, eb; };
struct Gemm { const bf16_t* A; const bf16_t* Bt; int M, N, K; size_t bstride; };

struct StaticOrder {
    int nM, nN, nwg, G, c;
    __host__ __device__ void init(int M, int N, int G_, int c_) { nM = M / BM; nN = N / BM; nwg = nM * nN; G = G_; c = c_; }
    __host__ __device__ bool next(int i, Unit& u) const {
        const long L = (long)i * G + c; if (L >= nwg) return false;
        int wgid = (int)L; { const int q = nwg / NXCD, r = nwg % NXCD, xcd = wgid % NXCD, off = wgid / NXCD; wgid = (xcd < r ? xcd * (q + 1) : r * (q + 1) + (xcd - r) * q) + off; }
        const int nig = WGM * nN, gid = wgid / nig, fm = gid * WGM, gsz = (nM - fm) < WGM ? (nM - fm) : WGM;
        u.pm = fm + ((wgid % nig) % gsz); u.pn = (wgid % nig) / gsz; u.eb = 0; return true;
    }
    __device__ __forceinline__ void a_ready(const Unit&) const {}
    __device__ __forceinline__ void done(const Unit&) const {}
};
struct MoeOrder {
    int nM, nN, nwg, G, c; int t1, t2, t3, t4, t5, t6, t7;
    __device__ __forceinline__ void init(const unsigned* cnt, int N, int G_, int c_) {
        int t = 0;
        t += (int)((cnt[0] + 255u) >> 8); t1 = t; t += (int)((cnt[1] + 255u) >> 8); t2 = t; t += (int)((cnt[2] + 255u) >> 8); t3 = t; t += (int)((cnt[3] + 255u) >> 8); t4 = t;
        t += (int)((cnt[4] + 255u) >> 8); t5 = t; t += (int)((cnt[5] + 255u) >> 8); t6 = t; t += (int)((cnt[6] + 255u) >> 8); t7 = t; t += (int)((cnt[7] + 255u) >> 8);
        nM = t; nN = N / BM; nwg = nM * nN; G = G_; c = c_; }
    __device__ __forceinline__ bool next(int i, Unit& u) const {
        const long L = (long)i * G + c; if (L >= nwg) return false;
        int wgid = (int)L; { const int q = nwg / NXCD, r = nwg % NXCD, xcd = wgid % NXCD, off = wgid / NXCD; wgid = (xcd < r ? xcd * (q + 1) : r * (q + 1) + (xcd - r) * q) + off; }
        const int nig = WGM * nN, gid = wgid / nig, fm = gid * WGM, gsz = (nM - fm) < WGM ? (nM - fm) : WGM;
        u.pm = fm + ((wgid % nig) % gsz); u.pn = (wgid % nig) / gsz;
        u.eb = (u.pm >= t1) + (u.pm >= t2) + (u.pm >= t3) + (u.pm >= t4) + (u.pm >= t5) + (u.pm >= t6) + (u.pm >= t7); return true;
    }
    __device__ __forceinline__ void a_ready(const Unit&) const {}
    __device__ __forceinline__ void done(const Unit&) const {}
};

__device__ __forceinline__ unsigned cvt_pk_bf16(float lo, float hi) { unsigned r; asm volatile("v_cvt_pk_bf16_f32 %0, %1, %2" : "=v"(r) : "v"(lo), "v"(hi)); return r; }

struct EpiF32 {
    static constexpr bool PERM = false, AFTER_DRAIN = false;
    float* C; int ldc;
    __device__ __forceinline__ void operator()(const f32x4 (&acc)[2][2][4][2], const Unit& u, int wr, int wc, int fr, int fq) const {
        asm volatile("" : "+v"(fr), "+v"(fq));
        const int row0 = u.pm * BM + wr * 64 + fr, col0 = u.pn * BM + wc * 32 + 4 * fq;
#pragma unroll
        for (int ai = 0; ai < 2; ++ai)
#pragma unroll
            for (int m = 0; m < 4; ++m) { float* rowp = C + (size_t)(row0 + ai * HALF + m * 16) * ldc + col0;
#pragma unroll
                for (int bj = 0; bj < 2; ++bj)
#pragma unroll
                    for (int n = 0; n < 2; ++n) *(f32x4*)(rowp + bj * HALF + n * 16) = acc[ai][bj][m][n]; }
    }
};
struct EpiBf16 {
    static constexpr bool PERM = true, AFTER_DRAIN = false;
    bf16_t* O; int ldc; float scale;
    __device__ __forceinline__ void operator()(const f32x4 (&acc)[2][2][4][2], const Unit& u, int wr, int wc, int fr, int fq) const {
        asm volatile("" : "+v"(fr), "+v"(fq));
        const int row0 = u.pm * BM + wr * 64 + fr; const int col0 = u.pn * BM + wc * 32 + 8 * fq; const float sc = scale;
#pragma unroll
        for (int ai = 0; ai < 2; ++ai)
#pragma unroll
            for (int m = 0; m < 4; ++m) { bf16_t* rowp = O + (size_t)(row0 + ai * HALF + m * 16) * ldc + col0;
#pragma unroll
                for (int bj = 0; bj < 2; ++bj) { f32x4 v0 = acc[ai][bj][m][0] * sc, v1 = acc[ai][bj][m][1] * sc;
                    u32x4 w; w.x = cvt_pk_bf16(v0[0], v0[1]); w.y = cvt_pk_bf16(v0[2], v0[3]); w.z = cvt_pk_bf16(v1[0], v1[1]); w.w = cvt_pk_bf16(v1[2], v1[3]);
                    *(u32x4*)(rowp + bj * HALF) = w; } }
    }
};
struct EpiRope {
    static constexpr bool PERM = true, AFTER_DRAIN = false;
    bf16_t* O; int ldc; float scale; const float* CS;
    __device__ __forceinline__ void operator()(const f32x4 (&acc)[2][2][4][2], const Unit& u, int wr, int wc, int fr, int fq) const {
        asm volatile("" : "+v"(fr), "+v"(fq));
        const int row0 = u.pm * BM + wr * 64 + fr; const int col0 = u.pn * BM + wc * 32 + 8 * fq; const float sc = scale;
        const int g4 = ((wc & 1) * 4 + fq) * 4;
#pragma unroll
        for (int ai = 0; ai < 2; ++ai)
#pragma unroll
            for (int m = 0; m < 4; ++m) { int ro = ai * HALF + m * 16; asm volatile("" : "+s"(ro)); const int row = row0 + ro; bf16_t* rowp = O + (size_t)row * ldc + col0;
                const f32x4 cs = *(const f32x4*)(CS + (size_t)row * 64 + g4) * sc, sn = *(const f32x4*)(CS + (size_t)row * 64 + 32 + g4) * sc;
#pragma unroll
                for (int bj = 0; bj < 2; ++bj) { const f32x4 x1 = acc[ai][bj][m][0], x2 = acc[ai][bj][m][1];
                    const f32x4 v0 = x1 * cs - x2 * sn, v1 = x1 * sn + x2 * cs;
                    u32x4 w; w.x = cvt_pk_bf16(v0[0], v0[1]); w.y = cvt_pk_bf16(v0[2], v0[3]); w.z = cvt_pk_bf16(v1[0], v1[1]); w.w = cvt_pk_bf16(v1[2], v1[3]);
                    *(u32x4*)(rowp + bj * HALF) = w; }
                asm volatile("" ::: "memory"); }
    }
};
struct EpiResid {
    static constexpr bool PERM = false, AFTER_DRAIN = false;
    const float* base; float* out; const float* gate; int gstride;
    __device__ __forceinline__ void operator()(const f32x4 (&acc)[2][2][4][2], const Unit& u, int wr, int wc, int fr, int fq) const {
        asm volatile("" : "+v"(fr), "+v"(fq));
        const int row0 = u.pm * BM + wr * 64 + fr, col0 = u.pn * BM + wc * 32 + 4 * fq; const int b = u.pm >> 4;
        f32x4 gv[2][2];
#pragma unroll
        for (int bj = 0; bj < 2; ++bj)
#pragma unroll
            for (int n = 0; n < 2; ++n) gv[bj][n] = *(const f32x4*)(gate + (size_t)b * gstride + col0 + bj * HALF + n * 16);
#pragma unroll
        for (int ai = 0; ai < 2; ++ai)
#pragma unroll
            for (int m = 0; m < 4; ++m) { const size_t off = (size_t)(row0 + ai * HALF + m * 16) * 1024 + col0;
#pragma unroll
                for (int bj = 0; bj < 2; ++bj)
#pragma unroll
                    for (int n = 0; n < 2; ++n) { const f32x4 bs = *(const f32x4*)(base + off + bj * HALF + n * 16); *(f32x4*)(out + off + bj * HALF + n * 16) = bs + gv[bj][n] * acc[ai][bj][m][n]; }
                if (m & 1) asm volatile("" ::: "memory"); }
    }
};
struct EpiSwiglu {
    static constexpr bool PERM = true, AFTER_DRAIN = false;
    bf16_t* O; int ldc;
    __device__ __forceinline__ static float act(float g, float up) { const float e = __builtin_amdgcn_exp2f(g * -1.4426950408889634f); return g * __builtin_amdgcn_rcpf(1.0f + e) * up; }
    __device__ __forceinline__ void operator()(const f32x4 (&acc)[2][2][4][2], const Unit& u, int wr, int wc, int fr, int fq) const {
        asm volatile("" : "+v"(fr), "+v"(fq));
        const int row0 = u.pm * BM + wr * 64 + fr; const int col0 = u.pn * HALF + wc * 32 + 8 * fq;
#pragma unroll
        for (int ai = 0; ai < 2; ++ai)
#pragma unroll
            for (int m = 0; m < 4; ++m) { bf16_t* rowp = O + (size_t)(row0 + ai * HALF + m * 16) * ldc + col0;
                const f32x4 g0 = acc[ai][0][m][0], g1 = acc[ai][0][m][1], u0 = acc[ai][1][m][0], u1 = acc[ai][1][m][1];
                u32x4 w; w.x = cvt_pk_bf16(act(g0[0], u0[0]), act(g0[1], u0[1])); w.y = cvt_pk_bf16(act(g0[2], u0[2]), act(g0[3], u0[3]));
                w.z = cvt_pk_bf16(act(g1[0], u1[0]), act(g1[1], u1[1])); w.w = cvt_pk_bf16(act(g1[2], u1[2]), act(g1[3], u1[3]));
                *(u32x4*)rowp = w; }
    }
};

template <class Epi, class Sched, bool ALIGN_EPI = false, bool SP2 = false>
__device__ __forceinline__ void gemm_phase(PG8_LAS unsigned char* lds, const Gemm g, const Sched& S, const Epi& E) {
    int tid_ = threadIdx.x; asm volatile("" : "+v"(tid_));
    const int tid = tid_, wid = __builtin_amdgcn_readfirstlane(tid >> 6), lane = tid & 63, wr = wid >> 2, wc = wid & 3, fr = lane & 15, fq = lane >> 4;
    const int K = g.K, nt = K / BK;
    unsigned voffA[2], voffB[2];
#pragma unroll
    for (int i = 0; i < 2; ++i) { int R, C; stage_rc(tid * 16 + i * 8192, R, C); const int Rb = Epi::PERM ? ((R & ~31) + perm32(R & 31)) : R;
        voffA[i] = (unsigned)(R * K + C) * 2u; voffB[i] = (unsigned)(Rb * K + C) * 2u; }
    const size_t kstep = (size_t)(BK * 2);
    const size_t hstep = (size_t)HALF * K * 2;
    const size_t tstep = 2 * hstep;
    const unsigned ldsw = (unsigned)wid * 1024u;
    const int aoff = lds_byte(wr * 64 + fr, fq * 8), boff = lds_byte(wc * 32 + fr, fq * 8);
#define PG8_SA(b, h) (((b) * 2 + (h)) * HTB)
#define PG8_SB(b, h) ((4 + (b) * 2 + (h)) * HTB)
#define PG8_STAGE(bufoff, gbase, voff) do { _Pragma("unroll") for (int _i = 0; _i < 2; ++_i) \
        __builtin_amdgcn_global_load_lds((const unsigned*)((const char*)(gbase) + (voff)[_i]), (PG8_LAS unsigned*)(lds + (bufoff) + ldsw + _i * 8192), 16, 0, 0); } while (0)
#define PG8_LDA(dst, b, h) do { _Pragma("unroll") for (int m = 0; m < 4; ++m) _Pragma("unroll") for (int k = 0; k < 2; ++k) dst[m][k] = *(const PG8_LAS bf16x8*)(lds + PG8_SA(b, h) + aoff + m * 2048 + k * 1024); } while (0)
#define PG8_LDB(dst, b, h) do { _Pragma("unroll") for (int n = 0; n < 2; ++n) _Pragma("unroll") for (int k = 0; k < 2; ++k) dst[n][k] = *(const PG8_LAS bf16x8*)(lds + PG8_SB(b, h) + boff + n * 2048 + k * 1024); } while (0)
#define PG8_MMA(ai, bj, At, Bt) do { __builtin_amdgcn_s_setprio(1); _Pragma("unroll") for (int m = 0; m < 4; ++m) _Pragma("unroll") for (int n = 0; n < 2; ++n) _Pragma("unroll") for (int k = 0; k < 2; ++k) \
        acc[ai][bj][m][n] = __builtin_amdgcn_mfma_f32_16x16x32_bf16(Bt[n][k], At[m][k], acc[ai][bj][m][n], 0, 0, 0); __builtin_amdgcn_s_setprio(0); } while (0)
#define PG8_WAIT_V(n) asm volatile("s_waitcnt vmcnt(" #n ")" ::: "memory")
#define PG8_WAIT_L(n) asm volatile("s_waitcnt lgkmcnt(" #n ")" ::: "memory")
#define PG8_BAR __builtin_amdgcn_s_barrier()
#define PG8_SCHED __builtin_amdgcn_sched_barrier(0)
    Unit cur, nxt; int ui = 0;
    if (!S.next(0, cur)) return;
    f32x4 acc[2][2][4][2];
#pragma unroll
    for (int a = 0; a < 2; ++a)
#pragma unroll
        for (int b = 0; b < 2; ++b)
#pragma unroll
            for (int m = 0; m < 4; ++m)
#pragma unroll
                for (int n = 0; n < 2; ++n) acc[a][b][m][n] = (f32x4){0.f, 0.f, 0.f, 0.f};
    bf16x8 At[4][2], B0[2][2], B1[2][2];
    const char* cA = (const char*)g.A + (size_t)cur.pm * tstep; const char* cB = (const char*)g.Bt + (size_t)cur.pn * tstep + (size_t)cur.eb * g.bstride;
    S.a_ready(cur);
    if constexpr (SP2) {
        PG8_STAGE(PG8_SB(0, 0), cB, voffB); PG8_STAGE(PG8_SB(0, 1), cB + hstep, voffB); PG8_STAGE(PG8_SA(0, 0), cA, voffA); PG8_STAGE(PG8_SA(0, 1), cA + hstep, voffA);
        if (wr == 1) PG8_BAR;
        PG8_WAIT_V(2); PG8_BAR;
        PG8_STAGE(PG8_SB(1, 0), cB + kstep, voffB); PG8_STAGE(PG8_SA(1, 0), cA + kstep, voffA); PG8_STAGE(PG8_SB(1, 1), cB + hstep + kstep, voffB);
        PG8_WAIT_V(6); PG8_BAR;
    } else {
        PG8_STAGE(PG8_SB(0, 0), cB, voffB); PG8_STAGE(PG8_SA(0, 0), cA, voffA); PG8_STAGE(PG8_SB(0, 1), cB + hstep, voffB); PG8_STAGE(PG8_SA(0, 1), cA + hstep, voffA);
        if (wr == 1) PG8_BAR;
        PG8_WAIT_V(4); PG8_BAR;
        PG8_STAGE(PG8_SB(1, 0), cB + kstep, voffB); PG8_STAGE(PG8_SA(1, 0), cA + kstep, voffA); PG8_STAGE(PG8_SB(1, 1), cB + hstep + kstep, voffB);
        PG8_WAIT_V(6); PG8_BAR;
    }
    for (;;) {
        const bool has_next = S.next(ui + 1, nxt);
        const char* nA = has_next ? (const char*)g.A + (size_t)nxt.pm * tstep : cA; const char* nB = has_next ? (const char*)g.Bt + (size_t)nxt.pn * tstep + (size_t)nxt.eb * g.bstride : cB;
        for (int t = 0; t < nt; t += 2) {
            const bool last = (t == nt - 2);
            const char* a1 = cA + (size_t)(t + 1) * kstep;
            const char* a2 = last ? nA : cA + (size_t)(t + 2) * kstep; const char* b2 = last ? nB : cB + (size_t)(t + 2) * kstep;
            const char* a3 = a2 + kstep; const char* b3 = b2 + kstep;
            if (last && has_next) S.a_ready(nxt);
            if constexpr (SP2) {
            PG8_LDB(B0, 0, 0); PG8_LDB(B1, 0, 1); PG8_SCHED; PG8_LDA(At, 0, 0); PG8_STAGE(PG8_SA(1, 1), a1 + hstep, voffA);
            PG8_WAIT_V(8); PG8_WAIT_L(0); PG8_BAR; PG8_MMA(0, 0, At, B0); PG8_MMA(0, 1, At, B1); PG8_BAR; PG8_SCHED;
            PG8_LDA(At, 0, 1); PG8_STAGE(PG8_SB(0, 0), b2, voffB); PG8_STAGE(PG8_SB(0, 1), b2 + hstep, voffB); PG8_STAGE(PG8_SA(0, 0), a2, voffA);
            PG8_WAIT_V(8); PG8_WAIT_L(0); PG8_BAR; PG8_MMA(1, 0, At, B0); PG8_MMA(1, 1, At, B1); PG8_BAR; PG8_SCHED;
            PG8_LDB(B0, 1, 0); PG8_LDB(B1, 1, 1); PG8_SCHED; PG8_LDA(At, 1, 0); PG8_STAGE(PG8_SA(0, 1), a2 + hstep, voffA);
            PG8_WAIT_V(8); PG8_WAIT_L(0); PG8_BAR; PG8_MMA(0, 0, At, B0); PG8_MMA(0, 1, At, B1); PG8_BAR; PG8_SCHED;
            PG8_LDA(At, 1, 1); PG8_STAGE(PG8_SB(1, 0), b3, voffB); PG8_STAGE(PG8_SB(1, 1), b3 + hstep, voffB); PG8_STAGE(PG8_SA(1, 0), a3, voffA);
            PG8_WAIT_V(8); PG8_WAIT_L(0); PG8_BAR; PG8_MMA(1, 0, At, B0); PG8_MMA(1, 1, At, B1); PG8_BAR; PG8_SCHED;
            } else {
            PG8_LDB(B0, 0, 0); PG8_SCHED; PG8_LDA(At, 0, 0); PG8_STAGE(PG8_SA(1, 1), a1 + hstep, voffA);
            PG8_WAIT_L(8); PG8_BAR; PG8_WAIT_L(0); PG8_MMA(0, 0, At, B0); PG8_BAR; PG8_SCHED;
            PG8_LDB(B1, 0, 1); PG8_STAGE(PG8_SB(0, 0), b2, voffB);
            PG8_BAR; PG8_WAIT_L(0); PG8_MMA(0, 1, At, B1); PG8_BAR;
            PG8_LDA(At, 0, 1); PG8_STAGE(PG8_SA(0, 0), a2, voffA);
            PG8_BAR; PG8_WAIT_L(0); PG8_MMA(1, 0, At, B0); PG8_BAR; PG8_SCHED;
            PG8_STAGE(PG8_SB(0, 1), b2 + hstep, voffB);
            PG8_WAIT_V(6); PG8_BAR; PG8_MMA(1, 1, At, B1); PG8_BAR;
            PG8_LDB(B0, 1, 0); PG8_SCHED; PG8_LDA(At, 1, 0); PG8_STAGE(PG8_SA(0, 1), a2 + hstep, voffA);
            PG8_WAIT_L(8); PG8_BAR; PG8_WAIT_L(0); PG8_MMA(0, 0, At, B0); PG8_BAR; PG8_SCHED;
            PG8_LDB(B1, 1, 1); PG8_STAGE(PG8_SB(1, 0), b3, voffB);
            PG8_BAR; PG8_WAIT_L(0); PG8_MMA(0, 1, At, B1); PG8_BAR;
            PG8_LDA(At, 1, 1); PG8_STAGE(PG8_SA(1, 0), a3, voffA);
            PG8_BAR; PG8_WAIT_L(0); PG8_MMA(1, 0, At, B0); PG8_BAR; PG8_SCHED;
            PG8_STAGE(PG8_SB(1, 1), b3 + hstep, voffB);
            PG8_WAIT_V(6); PG8_BAR; PG8_MMA(1, 1, At, B1); PG8_BAR;
            }
        }
        if constexpr (ALIGN_EPI) { if (wr == 0) PG8_BAR; }
        if constexpr (!Epi::AFTER_DRAIN) { E(acc, cur, wr, wc, fr, fq); S.done(cur); }
        if (!has_next) break;
#pragma unroll
        for (int a = 0; a < 2; ++a)
#pragma unroll
            for (int b = 0; b < 2; ++b)
#pragma unroll
                for (int m = 0; m < 4; ++m)
#pragma unroll
                    for (int n = 0; n < 2; ++n) acc[a][b][m][n] = (f32x4){0.f, 0.f, 0.f, 0.f};
        cur = nxt; cA = nA; cB = nB; ++ui;
        if constexpr (ALIGN_EPI) { if (wr == 1) PG8_BAR; }
    }
    PG8_WAIT_V(0);
    if constexpr (!ALIGN_EPI) { if (wr == 0) PG8_BAR; }
    PG8_BAR;
    if constexpr (Epi::AFTER_DRAIN) { E.fused(acc, cur, wr, wc, fr, fq, lds, wid, lane); S.done(cur); }
#undef PG8_SA
#undef PG8_SB
#undef PG8_STAGE
#undef PG8_LDA
#undef PG8_LDB
#undef PG8_MMA
#undef PG8_WAIT_V
#undef PG8_WAIT_L
#undef PG8_BAR
#undef PG8_SCHED
}
}

namespace att {
typedef unsigned short bf16_t;
typedef short bf16x8 __attribute__((ext_vector_type(8)));
typedef short s16x4 __attribute__((ext_vector_type(4)));
typedef float f32x16 __attribute__((ext_vector_type(16)));
typedef unsigned u32x4 __attribute__((ext_vector_type(4)));
#define ALDS __attribute__((address_space(3)))
#define ASBAR() __builtin_amdgcn_sched_barrier(0)
constexpr int SEQ = 4096, KVBLK = 64, QBLK = 32, NW = 8, QB = NW * QBLK;
constexpr int KROW = 512, SHM_K = KVBLK * KROW, SHM_V = KVBLK * 128 * 2;
constexpr int OFF_V = 0, OFF_K = 2 * SHM_V, OFF_S = OFF_K + 2 * SHM_K, LDS_BYTES = OFF_S + NW * 64 * 4;
__device__ __forceinline__ int v_st(int k, int c) { const int kk = (k & ~0xC) | ((k & 4) << 1) | ((k & 8) >> 1); return ((kk >> 3) * 4 + (c >> 5)) * 512 + ((kk & 7) * 32 + (c & 31)) * 2; }
__device__ __forceinline__ int v_rd_base(int lane) { return ((lane & 3) << 3) | (((lane >> 2) & 3) << 6) | (((lane >> 4) & 1) << 5) | (((lane >> 5) & 1) << 8); }
constexpr int v_rd_off(int d0, int ks, int half) { return d0 * 512 + ks * 4096 + half * 2048; }
__device__ __forceinline__ int crow(int r, int hi) { return (r & 3) + 8 * (r >> 2) + 4 * hi; }
__device__ __forceinline__ unsigned cvtpk(float lo, float hi) { unsigned r; asm volatile("v_cvt_pk_bf16_f32 %0, %1, %2" : "=v"(r) : "v"(lo), "v"(hi)); return r; }

__device__ __forceinline__ void pv_tile(f32x16* o, int vb, bf16x8 pa0, bf16x8 pa1, bf16x8 pa2, bf16x8 pa3) {
#define TRRD(dst, off) asm volatile("ds_read_b64_tr_b16 %0, %1 offset:%2" : "=&v"(dst) : "v"(vb), "i"(off) : "memory")
#define PV_D0(d0) do { s16x4 l0, l1, l2, l3, h0, h1, h2, h3; constexpr int b_ = v_rd_off(d0, 0, 0);   \
        TRRD(l0, b_); TRRD(h0, b_ + 2048); TRRD(l1, b_ + 4096); TRRD(h1, b_ + 6144); TRRD(l2, b_ + 8192); TRRD(h2, b_ + 10240); TRRD(l3, b_ + 12288); TRRD(h3, b_ + 14336); \
        asm volatile("s_waitcnt lgkmcnt(0)" ::: "memory"); ASBAR();   \
        o[d0] = __builtin_amdgcn_mfma_f32_32x32x16_bf16(pa0, (bf16x8){l0[0], l0[1], l0[2], l0[3], h0[0], h0[1], h0[2], h0[3]}, o[d0], 0, 0, 0);   \
        o[d0] = __builtin_amdgcn_mfma_f32_32x32x16_bf16(pa1, (bf16x8){l1[0], l1[1], l1[2], l1[3], h1[0], h1[1], h1[2], h1[3]}, o[d0], 0, 0, 0);   \
        o[d0] = __builtin_amdgcn_mfma_f32_32x32x16_bf16(pa2, (bf16x8){l2[0], l2[1], l2[2], l2[3], h2[0], h2[1], h2[2], h2[3]}, o[d0], 0, 0, 0);   \
        o[d0] = __builtin_amdgcn_mfma_f32_32x32x16_bf16(pa3, (bf16x8){l3[0], l3[1], l3[2], l3[3], h3[0], h3[1], h3[2], h3[3]}, o[d0], 0, 0, 0); } while (0)
    PV_D0(0); PV_D0(1); PV_D0(2); PV_D0(3);
#undef PV_D0
#undef TRRD
}
__device__ __forceinline__ void pack_p(const f32x16& p0, const f32x16& p1, bf16x8& pa0, bf16x8& pa1, bf16x8& pa2, bf16x8& pa3) {
#define PK4(P, B_, OUT) do { unsigned a0 = cvtpk(P[B_+0], P[B_+1]), a1 = cvtpk(P[B_+2], P[B_+3]);                          \
        unsigned b0 = cvtpk(P[B_+4], P[B_+5]), b1 = cvtpk(P[B_+6], P[B_+7]);                                             \
        auto r0 = __builtin_amdgcn_permlane32_swap(a0, b0, false, false); auto r1 = __builtin_amdgcn_permlane32_swap(a1, b1, false, false); \
        u32x4 w = {r0[0], r1[0], r0[1], r1[1]}; OUT = __builtin_bit_cast(bf16x8, w); } while (0)
    PK4(p0, 0, pa0); PK4(p0, 8, pa1); PK4(p1, 0, pa2); PK4(p1, 8, pa3);
#undef PK4
}
__device__ __forceinline__ float swap_max(float v) { auto rr = __builtin_amdgcn_permlane32_swap(__float_as_uint(v), __float_as_uint(v), false, false); return fmaxf(__uint_as_float(rr[0]), __uint_as_float(rr[1])); }
__device__ __forceinline__ float swap_sum(float v) { auto rr = __builtin_amdgcn_permlane32_swap(__float_as_uint(v), __float_as_uint(v), false, false); return __uint_as_float(rr[0]) + __uint_as_float(rr[1]); }

template <int MODE>
__device__ __forceinline__ void attn_unit(int b, int h, int qb, const bf16_t* __restrict__ Qp, const bf16_t* __restrict__ KVp, const bf16_t* __restrict__ KRp, bf16_t* __restrict__ Op, ALDS char* lds) {
    constexpr int DK = MODE == 0 ? 192 : 128, NQ = DK / 16, KI = DK / 64;
    int tid_ = threadIdx.x; asm volatile("" : "+v"(tid_));
    const int tid = tid_, wid = __builtin_amdgcn_readfirstlane(tid >> 6), lane = tid & 63, r32 = lane & 31, hi = lane >> 5;
    const size_t tok0 = (size_t)b * SEQ;
    const int q0 = qb * QB, qlo = q0 + wid * QBLK;
    bf16x8 qr[NQ];
    { const size_t row = tok0 + qlo + r32;
#pragma unroll
      for (int d0 = 0; d0 < NQ; ++d0) {
          const bf16_t* p;
          if (MODE == 0) p = (d0 < 8) ? Qp + row * 1536 + h * 128 + d0 * 16 + hi * 8 : Qp + row * 1536 + 1024 + h * 64 + (d0 - 8) * 16 + hi * 8;
          else p = Qp + row * 1024 + h * 128 + d0 * 16 + hi * 8;
          qr[d0] = *(const bf16x8*)p; } }
    const int krow = tid >> 3, kcg = tid & 7;
    const int kws = krow * KROW + ((kcg ^ (krow & 7)) << 4);
    const int sr = tid >> 4, sc = (tid & 15) * 8;
    const int vst0 = v_st(sr, sc), vst1 = v_st(32 + sr, sc);
    const bf16_t* ksrc = (MODE == 0) ? KVp + (tok0 + krow) * 2048 + h * 256 + kcg * 8 : KVp + (tok0 + krow) * 2048 + h * 128 + kcg * 8;
    const bf16_t* krsrc = (MODE == 0) ? KRp + (tok0 + krow) * 64 + kcg * 8 : nullptr;
    const bf16_t* vsrc = (MODE == 0) ? KVp + (tok0 + sr) * 2048 + h * 256 + 128 + sc : KVp + (tok0 + sr) * 2048 + 1024 + h * 128 + sc;
    bf16x8 stk[KI], stv0, stv1;
#define ST_LOAD(j) do { const size_t k0_ = (size_t)(j) * KVBLK; \
        stk[0] = *(const bf16x8*)(ksrc + k0_ * 2048); stk[1] = *(const bf16x8*)(ksrc + k0_ * 2048 + 64); \
        if (MODE == 0) stk[KI - 1] = *(const bf16x8*)(krsrc + k0_ * 64); \
        stv0 = *(const bf16x8*)(vsrc + k0_ * 2048); stv1 = *(const bf16x8*)(vsrc + (k0_ + 32) * 2048); } while (0)
#define ST_WRITE(buf) do { ALDS char* kb_ = lds + OFF_K + (buf) * SHM_K + kws; \
        _Pragma("unroll") for (int i_ = 0; i_ < KI; ++i_) *(ALDS bf16x8*)(kb_ + i_ * 128) = stk[i_]; \
        *(ALDS bf16x8*)(lds + OFF_V + (buf) * SHM_V + vst0) = stv0; *(ALDS bf16x8*)(lds + OFF_V + (buf) * SHM_V + vst1) = stv1; } while (0)
    int kb[4];
#pragma unroll
    for (int dd = 0; dd < 4; ++dd) kb[dd] = OFF_K + r32 * KROW + (((dd * 2 + hi) ^ (r32 & 7)) << 4);
    const int vb0 = (int)(unsigned)(uintptr_t)(lds + OFF_V) + v_rd_base(lane);
    ALDS float* wsf = (ALDS float*)(lds + OFF_S) + wid * 64;
    const int NT = 4 * qb + 4;
    f32x16 o[4] = {};
    float m_reg = -1e30f, l_reg = 0.f, carry = 0.f;
    const float NEG = -__builtin_inff();
#define TILE_OF(s) (MODE == 0 ? (s) : NT - 1 - (s))
    ST_LOAD(TILE_OF(0)); ST_WRITE(0);
    __syncthreads();
    for (int s = 0; s < NT; ++s) {
        const int j = TILE_OF(s), buf = s & 1;
        if (s + 1 < NT) ST_LOAD(TILE_OF(s + 1));
        const int kb0 = j * KVBLK;
        const bool active = (MODE == 0) ? (kb0 <= qlo + QBLK - 1) : (kb0 < qlo + QBLK - 1);
        if (active) {
            f32x16 p0 = {}, p1 = {};
            { const ALDS char* kbase = lds + buf * SHM_K;
#pragma unroll
              for (int d0 = 0; d0 < NQ; ++d0) { const ALDS char* a = kbase + kb[d0 & 3] + (d0 >> 2) * 128;
                  const bf16x8 b0 = *(const ALDS bf16x8*)a; const bf16x8 b1 = *(const ALDS bf16x8*)(a + 32 * KROW);
                  p0 = __builtin_amdgcn_mfma_f32_32x32x16_bf16(b0, qr[d0], p0, 0, 0, 0);
                  p1 = __builtin_amdgcn_mfma_f32_32x32x16_bf16(b1, qr[d0], p1, 0, 0, 0); } }
            const bool needmask = (MODE == 0) ? (kb0 + KVBLK - 1 > qlo) : (kb0 + KVBLK - 1 >= qlo);
            if (needmask) { const int dq = qlo + r32 - kb0 - 4 * hi;
#pragma unroll
                for (int r = 0; r < 16; ++r) { const int c = (r & 3) + 8 * (r >> 2);
                    if (MODE == 0) { if (c > dq) p0[r] = NEG; if (c + 32 > dq) p1[r] = NEG; }
                    else { if (c >= dq) p0[r] = NEG; if (c + 32 >= dq) p1[r] = NEG; } } }
            bf16x8 pa0, pa1, pa2, pa3;
            if (MODE == 0) {
                float pmax = p0[0];
#pragma unroll
                for (int r = 1; r < 16; ++r) pmax = fmaxf(pmax, p0[r]);
#pragma unroll
                for (int r = 0; r < 16; ++r) pmax = fmaxf(pmax, p1[r]);
                pmax = swap_max(pmax);
                float alpha = 1.f;
                if (!__all(pmax - m_reg <= 8.0f)) { const float mn = fmaxf(m_reg, pmax); alpha = __builtin_amdgcn_exp2f(m_reg - mn); m_reg = mn; }
                float ps = 0.f;
#pragma unroll
                for (int r = 0; r < 16; ++r) { p0[r] = __builtin_amdgcn_exp2f(p0[r] - m_reg); ps += p0[r]; }
#pragma unroll
                for (int r = 0; r < 16; ++r) { p1[r] = __builtin_amdgcn_exp2f(p1[r] - m_reg); ps += p1[r]; }
                ps = swap_sum(ps);
                l_reg = l_reg * alpha + ps;
                if (__any(alpha < 1.f)) { if (hi == 0) wsf[r32] = alpha; asm volatile("s_waitcnt lgkmcnt(0)" ::: "memory");
#pragma unroll
                    for (int r = 0; r < 16; ++r) { const float f = wsf[crow(r, hi)];
#pragma unroll
                        for (int d_ = 0; d_ < 4; ++d_) o[d_][r] *= f; }
                    asm volatile("s_waitcnt lgkmcnt(0)" ::: "memory"); }
            } else {
                float si[9];
#define SB_GRP(P, B_, k) do { const float za = P[B_], zb = P[B_ + 1], zc = P[B_ + 2], zd = P[B_ + 3]; \
                    const float sa = fmaxf(za, 0.f) + __builtin_amdgcn_logf(1.0f + __builtin_amdgcn_exp2f(-fabsf(za))), sb = fmaxf(zb, 0.f) + __builtin_amdgcn_logf(1.0f + __builtin_amdgcn_exp2f(-fabsf(zb))); \
                    const float sc_ = fmaxf(zc, 0.f) + __builtin_amdgcn_logf(1.0f + __builtin_amdgcn_exp2f(-fabsf(zc))), sd = fmaxf(zd, 0.f) + __builtin_amdgcn_logf(1.0f + __builtin_amdgcn_exp2f(-fabsf(zd))); \
                    const float u1 = -sd, u2 = u1 - sc_, u3 = u2 - sb; si[k] = u3 - sa; \
                    P[B_ + 3] = zd - sd; P[B_ + 2] = (zc - sc_) + u1; P[B_ + 1] = (zb - sb) + u2; P[B_] = (za - sa) + u3; } while (0)
                SB_GRP(p0, 0, 0); SB_GRP(p0, 4, 1); SB_GRP(p0, 8, 2); SB_GRP(p0, 12, 3); SB_GRP(p1, 0, 4); SB_GRP(p1, 4, 5); SB_GRP(p1, 8, 6); SB_GRP(p1, 12, 7);
#undef SB_GRP
                si[8] = 0.f;
#pragma unroll
                for (int k = 6; k >= 0; --k) si[k] += si[k + 1];
#pragma unroll
                for (int k = 0; k < 8; ++k) {
                    auto rr = __builtin_amdgcn_permlane32_swap(__float_as_uint(si[k]), __float_as_uint(si[k + 1]), false, false);
                    const float other = hi ? __uint_as_float(rr[0]) : __uint_as_float(rr[1]);
                    const float X = carry + si[k + 1] + other;
                    if (k < 4) {
#pragma unroll
                        for (int i = 0; i < 4; ++i) p0[4 * k + i] = __builtin_amdgcn_exp2f(p0[4 * k + i] + X); }
                    else {
#pragma unroll
                        for (int i = 0; i < 4; ++i) p1[4 * (k - 4) + i] = __builtin_amdgcn_exp2f(p1[4 * (k - 4) + i] + X); }
                }
                carry += swap_sum(si[0]);
            }
            pack_p(p0, p1, pa0, pa1, pa2, pa3);
            pv_tile(o, vb0 + buf * SHM_V, pa0, pa1, pa2, pa3);
        }
        if (s + 1 < NT) ST_WRITE((s + 1) & 1);
        __syncthreads();
    }
    float rli[16];
    if (MODE == 0) { if (hi == 0) wsf[32 + r32] = l_reg; asm volatile("s_waitcnt lgkmcnt(0)" ::: "memory");
#pragma unroll
        for (int r = 0; r < 16; ++r) rli[r] = __builtin_amdgcn_rcpf(wsf[32 + crow(r, hi)]);
    } else {
#pragma unroll
        for (int r = 0; r < 16; ++r) rli[r] = 1.f; }
    bf16_t* Ow = Op + (tok0 + qlo) * 1024 + h * 128;
#pragma unroll
    for (int r = 0; r < 16; ++r) { const int orow = crow(r, hi);
#pragma unroll
        for (int d0 = 0; d0 < 4; ++d0) { const float v = o[d0][r] * rli[r]; const float vn = __shfl_xor(v, 1);
            if ((r32 & 1) == 0) *(unsigned*)(Ow + (size_t)orow * 1024 + d0 * 32 + r32) = cvtpk(v, vn); } }
    asm volatile("s_waitcnt lgkmcnt(0)" ::: "memory");
    __syncthreads();
#undef ST_LOAD
#undef ST_WRITE
#undef TILE_OF
}
#undef ASBAR
}

constexpr int NWAVES = 8;
#ifndef MK_PER_PHASE
#define MK_PER_PHASE 0
#endif
constexpr int BATCH = 8, SEQ = 4096, DM = 1024, NTOK = BATCH * SEQ;
constexpr int QLORA = 384, QLP = 512  , KVLORA = 256, ROPE = 64, NLAT = 704, NLATP = 768, NHEAD = 8;
constexpr int NQ = NHEAD * 192, NKV = NHEAD * 256, DFF = 3584, NGU = 2 * DFF, NEXP = 8;
constexpr int MOE_ROWS = 2 * NTOK + NEXP * 256;
constexpr float EPSN = 1e-6f;
constexpr float C2_MLA = 1.4426950408889634f * 0.07216878364870322f;
constexpr float C2_SB = 1.4426950408889634f * 0.08838834764831845f;
constexpr size_t MiB = 1u << 20;
constexpr size_t WS_CTL = 0, CTL_ZERO_BYTES = 1 * MiB;
constexpr size_t WS_MOD = 1 * MiB;
constexpr size_t WS_MODKV = WS_MOD + (size_t)2 * 8 * 6144 * 4;
constexpr size_t WS_RT_E = 2 * MiB, WS_RT_POS = WS_RT_E + 256 * 1024, WS_RT_W = WS_RT_POS + 256 * 1024;
constexpr size_t WS_COS = 4 * MiB;
constexpr size_t WS_WAD = 12 * MiB, WS_WUQ = 14 * MiB, WS_WUKV = 16 * MiB, WS_WOA = 18 * MiB, WS_WKVSB = 20 * MiB, WS_WQSB = 24 * MiB, WS_WOSB = 26 * MiB;
constexpr size_t WS_WDN = 28 * MiB, WS_WGU = 36 * MiB, WS_WEGU = 50 * MiB, WS_WEDN = 162 * MiB;
constexpr size_t WS_HB0 = 224 * MiB, WS_LAT = 288 * MiB, WS_CQ = 384 * MiB, WS_CKV = 416 * MiB, WS_KROT = 720 * MiB, WS_Q = 432 * MiB, WS_KV = 528 * MiB, WS_AO = 656 * MiB;
constexpr size_t WS_ACT = 288 * MiB;
constexpr size_t WS_HB1 = 288 * MiB, WS_KVSB = 352 * MiB, WS_QSB = 480 * MiB;
constexpr size_t WS_HS = 224 * MiB, WS_ACT2 = 356 * MiB, WS_Y = 224 * MiB;
constexpr size_t WS_END = 818 * MiB;
static_assert(WS_ACT2 + (size_t)MOE_ROWS * DFF * 2 <= WS_END && WS_HS + (size_t)MOE_ROWS * DM * 2 <= WS_ACT2 && WS_WEDN + (size_t)NEXP * DM * DFF * 2 <= WS_HB0, "d_ws map");
constexpr int CW_TMO = 0, CW_CODE = 1;
constexpr int CW_BAR = 4096;
constexpr int CW_CNT = 16384;
constexpr int CW_CHK = 20480;
constexpr int RING_OFF = 0, RING_BYTES = 131072;
constexpr int LDSCTL_OFF = RING_BYTES, MISC_OFF = LDSCTL_OFF + 320;
constexpr int LDS_BYTES = 147456;
static_assert(MISC_OFF + 128 <= LDS_BYTES && att::LDS_BYTES <= RING_BYTES, "LDS map");

#define GAS __attribute__((address_space(1)))
#define LAS __attribute__((address_space(3)))
typedef unsigned short bf16;
typedef unsigned v4u __attribute__((ext_vector_type(4)));
typedef unsigned v2u __attribute__((ext_vector_type(2)));
typedef float f32x4 __attribute__((ext_vector_type(4)));
typedef float f32x2 __attribute__((ext_vector_type(2)));
typedef GAS unsigned gu32;
#define RLX_AGENT __ATOMIC_RELAXED, __HIP_MEMORY_SCOPE_AGENT
#define LDS_WAIT() asm volatile("s_waitcnt lgkmcnt(0)" ::: "memory")
#define VM_WAIT() asm volatile("s_waitcnt vmcnt(0)" ::: "memory")
__device__ __forceinline__ unsigned f2bf(float f) { unsigned u = __builtin_bit_cast(unsigned, f); return (u + 0x7fffu + ((u >> 16) & 1u)) >> 16; }
__device__ __forceinline__ unsigned pk2(float lo, float hi) { return f2bf(lo) | (f2bf(hi) << 16); }
__device__ __forceinline__ float bf2f(unsigned short h) { return __builtin_bit_cast(float, (unsigned)h << 16); }


#define XB_TMO      128
#define XB_XCNT(j)  (256  + 64 * (j))
#define XB_XSUB(j)  (1280 + 64 * (j))
#define XB_XGEN(j)  (2304 + 64 * (j))
#define XB_TOP      3328
#define XB_TOPGEN   3392
#define XCD_BAR_WORDS 3456
#define XB_SPIN_CAP (1u << 18)

__device__ __forceinline__ unsigned xb_ld(unsigned* p)              { return __hip_atomic_load(p, __ATOMIC_RELAXED, __HIP_MEMORY_SCOPE_AGENT); }
__device__ __forceinline__ unsigned xb_add(unsigned* p, unsigned v) { return __hip_atomic_fetch_add(p, v, __ATOMIC_RELAXED, __HIP_MEMORY_SCOPE_AGENT); }
__device__ __forceinline__ unsigned xb_xcc_id() { return (unsigned)__builtin_amdgcn_s_getreg((3 << 11) | 20) & 0xFu; }
#define XB_SPIN(cond, bar) do { unsigned _sp = 0; while (cond) { __builtin_amdgcn_s_sleep(1); \
    if ((++_sp & 255u) == 0u) { if (xb_ld(&(bar)[XB_TMO])) break; if (_sp > XB_SPIN_CAP) { atomicAdd(&(bar)[XB_TMO], 1u); break; } } } } while (0)

struct XcdBarrier {
    unsigned* bar; unsigned x;
    volatile LAS unsigned* st;
};

__device__ __forceinline__ XcdBarrier xcd_barrier_post(unsigned* bar, volatile LAS unsigned* st) {
    XcdBarrier b; b.bar = bar; b.x = xb_xcc_id(); b.st = st;
    if (threadIdx.x == 0) (void)xb_add(&bar[XB_XCNT(b.x)], 1u);
    return b;
}
__device__ __forceinline__ void xcd_barrier_complete(unsigned* bar, unsigned x, unsigned& nloc, unsigned& nx) {
    const unsigned G = gridDim.x * gridDim.y * gridDim.z;
    unsigned sum, cnt, mine, sp = 0u;
    for (;;) {
        sum = 0u; cnt = 0u; mine = 0u;
#pragma unroll
        for (unsigned j = 0; j < 16; ++j) { const unsigned c = xb_ld(&bar[XB_XCNT(j)]); sum += c; cnt += (c > 0u) ? 1u : 0u; mine = (j == x) ? c : mine; }
        if (sum == G) break;
        __builtin_amdgcn_s_sleep(1);
        if ((++sp & 255u) == 0u) { if (xb_ld(&bar[XB_TMO])) break; if (sp > XB_SPIN_CAP) { atomicAdd(&bar[XB_TMO], 1u); break; } }
    }
    nloc = mine > 0u ? mine : 1u; nx = cnt > 0u ? cnt : 1u;
}

__device__ __forceinline__ void xcd_barrier(const XcdBarrier& b) {
    asm volatile("s_waitcnt vmcnt(0)" ::: "memory");
    __syncthreads();
    if (threadIdx.x == 0) {
        unsigned* bar = b.bar;
        __builtin_amdgcn_s_waitcnt(0);
        unsigned nloc = b.st[0], nx = b.st[1];
        if (nloc == 0u) { xcd_barrier_complete(bar, b.x, nloc, nx); b.st[0] = nloc; b.st[1] = nx; }
        const unsigned old = xb_add(&bar[XB_XSUB(b.x)], 1u);
        const unsigned gen = old / nloc;
        if (old + 1u == (gen + 1u) * nloc) {
            __builtin_amdgcn_fence(__ATOMIC_RELEASE, "agent");
            asm volatile("s_waitcnt vmcnt(0)" ::: "memory");
            const unsigned og = xb_add(&bar[XB_TOP], 1u);
            const unsigned tg = og / nx;
            if (og + 1u == (tg + 1u) * nx) xb_add(&bar[XB_TOPGEN], 1u);
            else XB_SPIN(xb_ld(&bar[XB_TOPGEN]) == tg, bar);
            __builtin_amdgcn_fence(__ATOMIC_ACQUIRE, "agent");
            xb_add(&bar[XB_XGEN(b.x)], 1u);
            asm volatile("s_waitcnt vmcnt(0)" ::: "memory");
        } else {
            XB_SPIN(xb_ld(&bar[XB_XGEN(b.x)]) == gen, bar);
            __builtin_amdgcn_fence(__ATOMIC_ACQUIRE, "agent");
            asm volatile("s_waitcnt vmcnt(0)" ::: "memory");
        }
    }
    __syncthreads();
}


struct Frame {
    LAS unsigned char* lds;
    volatile LAS unsigned* MISC;
    gu32* ctl;
    int tid, lane, wave;
    int vcu, G;
    unsigned char* ws;
};
struct Args { const float* in[26]; float* out; unsigned char* ws; float inv[32]; int ph_lo, ph_hi, li, pad; };

__device__ __forceinline__ float wave_sum(float v) {
#pragma unroll
    for (int o = 1; o < 64; o <<= 1) v += __shfl_xor(v, o);
    return v;
}
__device__ __forceinline__ int rope_src(int p) { const int g = p >> 3, jj = p & 7; return jj < 4 ? 4 * g + jj : 32 + 4 * g + (jj - 4); }
__device__ __forceinline__ int src_col(int kind, int rho) {
    if (kind == 1) return rho < 640 ? rho : (rho < 704 ? 640 + rope_src(rho - 640) : -1);
    if (kind == 2) { if (rho < 1024) return (rho >> 7) * 192 + (rho & 127); const int r = rho - 1024; return (r >> 6) * 192 + 128 + rope_src(r & 63); }
    if (kind == 3) { const int t = rho >> 8, r = rho & 255; return r < 128 ? t * 128 + r : DFF + t * 128 + (r - 128); }
    return rho;
}
__device__ __forceinline__ void p0_transpose_item(const float* W, int K, int N, bf16* WT, int kind, LAS float* scr, int item, int nblk, int lane, int Kd = 0) {
    if (Kd == 0) Kd = K;
    const int kb = item / nblk, nb = item % nblk, k0 = 64 * kb, n0 = 32 * nb;
    const int sc = src_col(kind, n0 + (lane & 31));
#pragma unroll 8
    for (int i = 0; i < 32; ++i) { const int kk = 2 * i + (lane >> 5); scr[kk * 33 + (lane & 31)] = (sc >= 0 && k0 + kk < K) ? W[(size_t)(k0 + kk) * N + sc] : 0.f; }
    LDS_WAIT(); asm volatile("" ::: "memory");
    const int c = lane & 7;
#pragma unroll
    for (int j = 0; j < 4; ++j) { const int n = (lane >> 3) + 8 * j; const LAS float* s = scr + (8 * c) * 33 + n;
        v4u o; o.x = pk2(s[0 * 33], s[1 * 33]); o.y = pk2(s[2 * 33], s[3 * 33]); o.z = pk2(s[4 * 33], s[5 * 33]); o.w = pk2(s[6 * 33], s[7 * 33]);
        *(GAS v4u*)(WT + (size_t)(n0 + n) * Kd + k0 + 8 * c) = o; }
    LDS_WAIT(); asm volatile("" ::: "memory");
}

__device__ __forceinline__ void p0_prologue(Frame& F, const Args& a) {
    {
        LAS float* sl = (LAS float*)(F.lds + RING_OFF);
        LAS float* red = (LAS float*)(F.lds + RING_OFF + 32768);
        float* MOD = (float*)(F.ws + WS_MOD); float* MODKV = (float*)(F.ws + WS_MODKV);
        if (F.vcu < 112) {
            for (int i = F.tid; i < 8192; i += NWAVES * 64) { const float c = a.in[1][i]; sl[i] = c / (1.0f + __expf(-c)); }
            __syncthreads();
        }
        for (int cg = F.vcu; cg < 112; cg += F.G) {
            const float* W; const float* bias; float* out; int ldw, ldo, col0;
            if (cg < 48) { W = a.in[3]; bias = a.in[4]; out = MOD; ldw = 6144; ldo = 6144; col0 = cg * 128; }
            else if (cg < 96) { W = a.in[3] + (size_t)DM * 6144; bias = a.in[4] + 6144; out = MOD + 8 * 6144; ldw = 6144; ldo = 6144; col0 = (cg - 48) * 128; }
            else { W = a.in[13]; bias = a.in[14]; out = MODKV; ldw = 2048; ldo = 2048; col0 = (cg - 96) * 128; }
            f32x2 acc[8];
#pragma unroll
            for (int b = 0; b < 8; ++b) acc[b] = (f32x2){0.f, 0.f};
            const float* wp = W + (size_t)(F.wave * 128) * ldw + col0 + 2 * F.lane;
#pragma unroll 4
            for (int k = 0; k < 128; ++k) { const f32x2 w2 = *(const f32x2*)(wp + (size_t)k * ldw);
#pragma unroll
                for (int b = 0; b < 8; ++b) { const float s = sl[b * 1024 + F.wave * 128 + k]; acc[b] += w2 * s; } }
#pragma unroll
            for (int b = 0; b < 8; ++b) *(LAS f32x2*)(red + (F.wave * 8 + b) * 128 + 2 * F.lane) = acc[b];
            __syncthreads();
            for (int idx = F.tid; idx < 1024; idx += NWAVES * 64) { const int b = idx >> 7, col = idx & 127; float s = bias[col0 + col];
#pragma unroll
                for (int w = 0; w < 8; ++w) s += red[(w * 8 + b) * 128 + col];
                out[(size_t)b * ldo + col0 + col] = s; }
            __syncthreads();
        }
        __syncthreads();
    }
    {
        float* CS = (float*)(F.ws + WS_COS); const int* pos = (const int*)a.in[2];
        for (int idx = (F.vcu * NWAVES * 64) + F.tid; idx < NTOK * 32; idx += F.G * NWAVES * 64) {
            const int t = idx >> 5, i = idx & 31;
            const double rev = (double)pos[t] * (double)a.inv[i] * 0.15915494309189535;
            const float fr = (float)(rev - __builtin_rint(rev));
            CS[t * 64 + i] = __builtin_amdgcn_cosf(fr); CS[t * 64 + 32 + i] = __builtin_amdgcn_sinf(fr);
        }
    }
    {
        LAS float* scr = (LAS float*)(F.lds + RING_OFF + F.wave * 16384);
        const int gw = F.vcu * NWAVES + F.wave, NGW = F.G * NWAVES;
        constexpr int I_EGU = (DM / 64) * (NGU / 32), I_EDN = (DFF / 64) * (DM / 32);
        constexpr int I_GU = I_EGU, I_DN = I_EDN, I_AD = (DM / 64) * (NLATP / 32), I_UQ = (QLP / 64) * (NQ / 32), I_UKV = (KVLORA / 64) * (NKV / 32);
        constexpr int I_SQ = (DM / 64) * (DM / 32), I_KVSB = (DM / 64) * (2048 / 32);
        constexpr int NITEMS = NEXP * I_EGU + NEXP * I_EDN + I_GU + I_DN + I_AD + I_UQ + I_UKV + 3 * I_SQ + I_KVSB;
        for (int it = gw; it < NITEMS; it += NGW) {
            int r = it;
            if (r < NEXP * I_EGU) { const int e = r / I_EGU; r -= e * I_EGU; p0_transpose_item(a.in[23] + (size_t)e * DM * NGU, DM, NGU, (bf16*)(F.ws + WS_WEGU) + (size_t)e * NGU * DM, 3, scr, r, NGU / 32, F.lane); continue; } r -= NEXP * I_EGU;
            if (r < NEXP * I_EDN) { const int e = r / I_EDN; r -= e * I_EDN; p0_transpose_item(a.in[24] + (size_t)e * DFF * DM, DFF, DM, (bf16*)(F.ws + WS_WEDN) + (size_t)e * DM * DFF, 0, scr, r, DM / 32, F.lane); continue; } r -= NEXP * I_EDN;
            if (r < I_GU) { p0_transpose_item(a.in[19], DM, NGU, (bf16*)(F.ws + WS_WGU), 3, scr, r, NGU / 32, F.lane); continue; } r -= I_GU;
            if (r < I_DN) { p0_transpose_item(a.in[20], DFF, DM, (bf16*)(F.ws + WS_WDN), 0, scr, r, DM / 32, F.lane); continue; } r -= I_DN;
            if (r < I_AD) { p0_transpose_item(a.in[7], DM, NLAT, (bf16*)(F.ws + WS_WAD), 1, scr, r, NLATP / 32, F.lane); continue; } r -= I_AD;
            if (r < I_UQ) { p0_transpose_item(a.in[10], QLORA, NQ, (bf16*)(F.ws + WS_WUQ), 2, scr, r, NQ / 32, F.lane, QLP); continue; } r -= I_UQ;
            if (r < I_UKV) { p0_transpose_item(a.in[11], KVLORA, NKV, (bf16*)(F.ws + WS_WUKV), 0, scr, r, NKV / 32, F.lane); continue; } r -= I_UKV;
            if (r < I_SQ) { p0_transpose_item(a.in[12], DM, DM, (bf16*)(F.ws + WS_WOA), 0, scr, r, DM / 32, F.lane); continue; } r -= I_SQ;
            if (r < I_SQ) { p0_transpose_item(a.in[17], DM, DM, (bf16*)(F.ws + WS_WQSB), 0, scr, r, DM / 32, F.lane); continue; } r -= I_SQ;
            if (r < I_SQ) { p0_transpose_item(a.in[18], DM, DM, (bf16*)(F.ws + WS_WOSB), 0, scr, r, DM / 32, F.lane); continue; } r -= I_SQ;
            p0_transpose_item(a.in[16], DM, 2048, (bf16*)(F.ws + WS_WKVSB), 0, scr, r, 2048 / 32, F.lane);
        }
    }
}

template <bool TWO>
__device__ __forceinline__ void norm_phase(Frame& F, const float* X, const float* g0, const float* sc0, const float* sh0, int st0, bf16* H0,
                                           const float* g1, const float* sc1, const float* sh1, int st1, bf16* H1) {
    const int gw = F.vcu * NWAVES + F.wave, NGW = F.G * NWAVES;
    for (int c = gw; c < NTOK / 16; c += NGW) {
        const int row0 = c * 16, b = row0 / SEQ;
        f32x4 A0[4], B0[4], A1[4], B1[4];
#pragma unroll
        for (int j = 0; j < 4; ++j) { const int col = 4 * F.lane + 256 * j;
            A0[j] = *(const f32x4*)(g0 + col) * (*(const f32x4*)(sc0 + (size_t)b * st0 + col) + 1.0f); B0[j] = *(const f32x4*)(sh0 + (size_t)b * st0 + col);
            if (TWO) { A1[j] = *(const f32x4*)(g1 + col) * (*(const f32x4*)(sc1 + (size_t)b * st1 + col) + 1.0f); B1[j] = *(const f32x4*)(sh1 + (size_t)b * st1 + col); } }
#pragma unroll 2
        for (int r = 0; r < 16; ++r) {
            const GAS f32x4* xr = (const GAS f32x4*)(X + (size_t)(row0 + r) * DM) + F.lane;
            f32x4 v[4]; float s2 = 0.f;
#pragma unroll
            for (int j = 0; j < 4; ++j) { v[j] = xr[64 * j]; s2 += (v[j].x * v[j].x + v[j].y * v[j].y) + (v[j].z * v[j].z + v[j].w * v[j].w); }
            const float rstd = 1.0f / sqrtf(wave_sum(s2) * (1.0f / DM) + EPSN);
            GAS unsigned long long* o0 = (GAS unsigned long long*)(H0 + (size_t)(row0 + r) * DM) + F.lane;
#pragma unroll
            for (int j = 0; j < 4; ++j) { const f32x4 y = v[j] * rstd * A0[j] + B0[j]; o0[64 * j] = (unsigned long long)pk2(y.x, y.y) | ((unsigned long long)pk2(y.z, y.w) << 32); }
            if (TWO) { GAS unsigned long long* o1 = (GAS unsigned long long*)(H1 + (size_t)(row0 + r) * DM) + F.lane;
#pragma unroll
                for (int j = 0; j < 4; ++j) { const f32x4 y = v[j] * rstd * A1[j] + B1[j]; o1[64 * j] = (unsigned long long)pk2(y.x, y.y) | ((unsigned long long)pk2(y.z, y.w) << 32); } }
        }
    }
}

__device__ __forceinline__ void lat_phase(Frame& F, const Args& a) {
    const int gw = F.vcu * NWAVES + F.wave, NGW = F.G * NWAVES, l = F.lane;
    const float* LAT = (const float*)(F.ws + WS_LAT); const float* CS = (const float*)(F.ws + WS_COS);
    bf16* CQ = (bf16*)(F.ws + WS_CQ); bf16* CKV = (bf16*)(F.ws + WS_CKV); bf16* KR = (bf16*)(F.ws + WS_KROT);
    const f32x4 G0 = *(const f32x4*)(a.in[8] + 4 * l);
    const f32x4 G1 = l < 32 ? *(const f32x4*)(a.in[8] + 256 + 4 * l) : *(const f32x4*)(a.in[9] + 4 * (l - 32));
    const f32x4 G2 = l < 32 ? *(const f32x4*)(a.in[9] + 128 + 4 * l) : (f32x4){0.f, 0.f, 0.f, 0.f};
    for (int row = gw; row < NTOK; row += NGW) {
        const GAS f32x4* xr = (const GAS f32x4*)(LAT + (size_t)row * NLATP) + l;
        const f32x4 v0 = xr[0], v1 = xr[64], v2 = xr[128];
        const float q0 = (v0.x * v0.x + v0.y * v0.y) + (v0.z * v0.z + v0.w * v0.w), q1 = (v1.x * v1.x + v1.y * v1.y) + (v1.z * v1.z + v1.w * v1.w), q2 = (v2.x * v2.x + v2.y * v2.y) + (v2.z * v2.z + v2.w * v2.w);
        const float sq = wave_sum(q0 + (l < 32 ? q1 : 0.f)), skv = wave_sum((l < 32 ? q2 : q1));
        const float rq = 1.0f / sqrtf(sq * (1.0f / QLORA) + EPSN), rkv = 1.0f / sqrtf(skv * (1.0f / KVLORA) + EPSN);
        { const f32x4 y = v0 * rq * G0; *(GAS unsigned long long*)(CQ + (size_t)row * QLP + 4 * l) = (unsigned long long)pk2(y.x, y.y) | ((unsigned long long)pk2(y.z, y.w) << 32); }
        { const f32x4 y = v1 * (l < 32 ? rq : rkv) * G1; bf16* dst = l < 32 ? CQ + (size_t)row * QLP + 256 + 4 * l : CKV + (size_t)row * KVLORA + 4 * (l - 32);
          *(GAS unsigned long long*)dst = (unsigned long long)pk2(y.x, y.y) | ((unsigned long long)pk2(y.z, y.w) << 32); }
        const int u = l - 32, g = (u >> 1) & 7;
        f32x4 pr; pr.x = __shfl_xor(v2.x, 1); pr.y = __shfl_xor(v2.y, 1); pr.z = __shfl_xor(v2.z, 1); pr.w = __shfl_xor(v2.w, 1);
        if (l < 32) { const f32x4 y = v2 * rkv * G2; *(GAS unsigned long long*)(CKV + (size_t)row * KVLORA + 128 + 4 * l) = (unsigned long long)pk2(y.x, y.y) | ((unsigned long long)pk2(y.z, y.w) << 32); }
        else { *(GAS unsigned long long*)(CQ + (size_t)row * QLP + QLORA + 4 * (l - 32)) = 0ull; }
        if (l >= 32 && l < 48) { const f32x4 cs = *(const f32x4*)(CS + (size_t)row * 64 + 4 * g), sn = *(const f32x4*)(CS + (size_t)row * 64 + 32 + 4 * g);
            const f32x4 y = (u & 1) ? (pr * sn + v2 * cs) : (v2 * cs - pr * sn);
            *(GAS unsigned long long*)(KR + (size_t)row * ROPE + 4 * u) = (unsigned long long)pk2(y.x, y.y) | ((unsigned long long)pk2(y.z, y.w) << 32); }
    }
}


__device__ __forceinline__ void router_phase(Frame& F, const Args& a) {
    const int gw = F.vcu * NWAVES + F.wave, NGW = F.G * NWAVES, l = F.lane;
    const float* X = a.out; const float* MOD1 = (const float*)(F.ws + WS_MOD) + 8 * 6144;
    int* RT_E = (int*)(F.ws + WS_RT_E); int* RT_POS = (int*)(F.ws + WS_RT_POS); float* RT_W = (float*)(F.ws + WS_RT_W);
    f32x4 wr[4][4][2];
#pragma unroll
    for (int j = 0; j < 4; ++j)
#pragma unroll
        for (int i = 0; i < 4; ++i) { const float* p = a.in[21] + (size_t)(4 * l + 256 * j + i) * 8; wr[j][i][0] = *(const f32x4*)p; wr[j][i][1] = *(const f32x4*)(p + 4); }
    float br[8];
#pragma unroll
    for (int e = 0; e < 8; ++e) br[e] = a.in[22][e];
    for (int c = gw; c < NTOK / 16; c += NGW) {
        const int row0 = c * 16, b = row0 / SEQ;
        f32x4 A0[4], B0[4];
#pragma unroll
        for (int j = 0; j < 4; ++j) { const int col = 4 * l + 256 * j;
            A0[j] = *(const f32x4*)(a.in[6] + DM + col) * (*(const f32x4*)(MOD1 + (size_t)b * 6144 + 4096 + col) + 1.0f); B0[j] = *(const f32x4*)(MOD1 + (size_t)b * 6144 + 3072 + col); }
        int my_e1 = 0, my_e2 = 0; float my_w1 = 0.f, my_w2 = 0.f;
        for (int r = 0; r < 16; ++r) {
            const GAS f32x4* xr = (const GAS f32x4*)(X + (size_t)(row0 + r) * DM) + l;
            f32x4 v[4]; float s2 = 0.f;
#pragma unroll
            for (int j = 0; j < 4; ++j) { v[j] = xr[64 * j]; s2 += (v[j].x * v[j].x + v[j].y * v[j].y) + (v[j].z * v[j].z + v[j].w * v[j].w); }
            const float rstd = 1.0f / sqrtf(wave_sum(s2) * (1.0f / DM) + EPSN);
            f32x4 lo = (f32x4){0.f, 0.f, 0.f, 0.f}, hi = (f32x4){0.f, 0.f, 0.f, 0.f};
#pragma unroll
            for (int j = 0; j < 4; ++j) { const f32x4 y = v[j] * rstd * A0[j] + B0[j];
                lo += wr[j][0][0] * y.x + wr[j][1][0] * y.y + wr[j][2][0] * y.z + wr[j][3][0] * y.w;
                hi += wr[j][0][1] * y.x + wr[j][1][1] * y.y + wr[j][2][1] * y.z + wr[j][3][1] * y.w; }
            float lg[8];
            lg[0] = wave_sum(lo.x) + br[0]; lg[1] = wave_sum(lo.y) + br[1]; lg[2] = wave_sum(lo.z) + br[2]; lg[3] = wave_sum(lo.w) + br[3];
            lg[4] = wave_sum(hi.x) + br[4]; lg[5] = wave_sum(hi.y) + br[5]; lg[6] = wave_sum(hi.z) + br[6]; lg[7] = wave_sum(hi.w) + br[7];
            int e1 = 0; float v1 = lg[0];
#pragma unroll
            for (int e = 1; e < 8; ++e) if (lg[e] > v1) { v1 = lg[e]; e1 = e; }
            int e2 = -1; float v2 = -__builtin_inff();
#pragma unroll
            for (int e = 0; e < 8; ++e) if (e != e1 && lg[e] > v2) { v2 = lg[e]; e2 = e; }
            const float t = __expf(v2 - v1), w1 = 1.0f / (1.0f + t), w2 = t * w1;
            if (l == r) { my_e1 = e1; my_e2 = e2; my_w1 = w1; my_w2 = w2; }
        }
        const int E1 = __shfl(my_e1, l & 15), E2 = __shfl(my_e2, l & 15); const float W1 = __shfl(my_w1, l & 15), W2 = __shfl(my_w2, l & 15);
        const int myE = l < 16 ? E1 : (l < 32 ? E2 : -1); const float myW = l < 16 ? W1 : W2;
        int mypos = 0;
#pragma unroll
        for (int e = 0; e < 8; ++e) {
            const unsigned long long m = __ballot(myE == e); const int n = __popcll(m);
            unsigned base = 0;
            if (n > 0 && l == 0) base = __hip_atomic_fetch_add((unsigned*)(F.ctl + CW_CNT + 16 * e), (unsigned)n, RLX_AGENT);
            base = (unsigned)__builtin_amdgcn_readfirstlane((int)base);
            if (myE == e) mypos = (int)base + __popcll(m & ((1ull << l) - 1ull));
        }
        if (l < 32) { const int idx = (row0 + (l & 15)) * 2 + (l >> 4); RT_E[idx] = myE; RT_POS[idx] = mypos; RT_W[idx] = myW; }
    }
}
__device__ __forceinline__ void moe_offsets(Frame& F, unsigned (&cnt)[8], int (&off)[8]) {
    int t = 0;
#pragma unroll
    for (int e = 0; e < 8; ++e) { cnt[e] = __hip_atomic_load((unsigned*)(F.ctl + CW_CNT + 16 * e), RLX_AGENT); off[e] = t; t += (int)((cnt[e] + 255u) & ~255u); }
}
__device__ __forceinline__ void scatter_phase(Frame& F, const Args& a) {
    const int gw = F.vcu * NWAVES + F.wave, NGW = F.G * NWAVES, l = F.lane;
    const float* X = a.out; const float* MOD1 = (const float*)(F.ws + WS_MOD) + 8 * 6144;
    const int* RT_E = (const int*)(F.ws + WS_RT_E); const int* RT_POS = (const int*)(F.ws + WS_RT_POS);
    bf16* HS = (bf16*)(F.ws + WS_HS);
    unsigned cnt[8]; int off[8]; moe_offsets(F, cnt, off);
    for (int c = gw; c < NTOK / 16; c += NGW) {
        const int row0 = c * 16, b = row0 / SEQ;
        f32x4 A0[4], B0[4];
#pragma unroll
        for (int j = 0; j < 4; ++j) { const int col = 4 * l + 256 * j;
            A0[j] = *(const f32x4*)(a.in[6] + DM + col) * (*(const f32x4*)(MOD1 + (size_t)b * 6144 + 4096 + col) + 1.0f); B0[j] = *(const f32x4*)(MOD1 + (size_t)b * 6144 + 3072 + col); }
#pragma unroll 2
        for (int r = 0; r < 16; ++r) {
            const int row = row0 + r;
            const GAS f32x4* xr = (const GAS f32x4*)(X + (size_t)row * DM) + l;
            f32x4 v[4]; float s2 = 0.f;
#pragma unroll
            for (int j = 0; j < 4; ++j) { v[j] = xr[64 * j]; s2 += (v[j].x * v[j].x + v[j].y * v[j].y) + (v[j].z * v[j].z + v[j].w * v[j].w); }
            const float rstd = 1.0f / sqrtf(wave_sum(s2) * (1.0f / DM) + EPSN);
            const int e1 = RT_E[row * 2], e2 = RT_E[row * 2 + 1], p1 = RT_POS[row * 2], p2 = RT_POS[row * 2 + 1];
            int o1 = 0, o2 = 0;
#pragma unroll
            for (int e = 0; e < 8; ++e) { o1 = (e1 == e) ? off[e] : o1; o2 = (e2 == e) ? off[e] : o2; }
            GAS unsigned long long* d1 = (GAS unsigned long long*)(HS + (size_t)(o1 + p1) * DM) + l; GAS unsigned long long* d2 = (GAS unsigned long long*)(HS + (size_t)(o2 + p2) * DM) + l;
#pragma unroll
            for (int j = 0; j < 4; ++j) { const f32x4 y = v[j] * rstd * A0[j] + B0[j]; const unsigned long long w = (unsigned long long)pk2(y.x, y.y) | ((unsigned long long)pk2(y.z, y.w) << 32); d1[64 * j] = w; d2[64 * j] = w; }
        }
    }
    for (int i = gw; i < 8 * 256; i += NGW) { const int e = i >> 8, r = i & 255; int oe = 0; unsigned ce = 0;
#pragma unroll
        for (int q = 0; q < 8; ++q) { oe = (e == q) ? off[q] : oe; ce = (e == q) ? cnt[q] : ce; }
        if (ce + (unsigned)r < ((ce + 255u) & ~255u)) { GAS unsigned long long* d = (GAS unsigned long long*)(HS + (size_t)(oe + (int)ce + r) * DM) + l;
#pragma unroll
            for (int j = 0; j < 4; ++j) d[64 * j] = 0ull; } }
}
__device__ __forceinline__ void final_phase(Frame& F, const Args& a) {
    const int gw = F.vcu * NWAVES + F.wave, NGW = F.G * NWAVES, l = F.lane;
    float* X = a.out; const float* MOD1 = (const float*)(F.ws + WS_MOD) + 8 * 6144;
    const int* RT_E = (const int*)(F.ws + WS_RT_E); const int* RT_POS = (const int*)(F.ws + WS_RT_POS); const float* RT_W = (const float*)(F.ws + WS_RT_W);
    const bf16* Y = (const bf16*)(F.ws + WS_Y);
    unsigned cnt[8]; int off[8]; moe_offsets(F, cnt, off);
    for (int c = gw; c < NTOK / 16; c += NGW) {
        const int row0 = c * 16, b = row0 / SEQ;
        f32x4 GT[4], GF[4];
#pragma unroll
        for (int j = 0; j < 4; ++j) { const int col = 4 * l + 256 * j; GT[j] = *(const f32x4*)(MOD1 + (size_t)b * 6144 + 5120 + col); GF[j] = *(const f32x4*)(a.in[25] + col); }
#pragma unroll 2
        for (int r = 0; r < 16; ++r) {
            const int row = row0 + r;
            GAS f32x4* xr = (GAS f32x4*)(X + (size_t)row * DM) + l;
            const int e1 = RT_E[row * 2], e2 = RT_E[row * 2 + 1], p1 = RT_POS[row * 2], p2 = RT_POS[row * 2 + 1]; const float w1 = RT_W[row * 2], w2 = RT_W[row * 2 + 1];
            int o1 = 0, o2 = 0;
#pragma unroll
            for (int e = 0; e < 8; ++e) { o1 = (e1 == e) ? off[e] : o1; o2 = (e2 == e) ? off[e] : o2; }
            const GAS v2u* y1 = (const GAS v2u*)(Y + (size_t)(o1 + p1) * DM) + l; const GAS v2u* y2 = (const GAS v2u*)(Y + (size_t)(o2 + p2) * DM) + l;
            f32x4 v[4]; float s2 = 0.f;
#pragma unroll
            for (int j = 0; j < 4; ++j) { const v2u a1 = y1[64 * j], a2 = y2[64 * j];
                f32x4 f; f.x = w1 * __uint_as_float(a1.x << 16) + w2 * __uint_as_float(a2.x << 16); f.y = w1 * __uint_as_float(a1.x & 0xffff0000u) + w2 * __uint_as_float(a2.x & 0xffff0000u);
                f.z = w1 * __uint_as_float(a1.y << 16) + w2 * __uint_as_float(a2.y << 16); f.w = w1 * __uint_as_float(a1.y & 0xffff0000u) + w2 * __uint_as_float(a2.y & 0xffff0000u);
                v[j] = xr[64 * j] + GT[j] * f; s2 += (v[j].x * v[j].x + v[j].y * v[j].y) + (v[j].z * v[j].z + v[j].w * v[j].w); }
            const float rstd = 1.0f / sqrtf(wave_sum(s2) * (1.0f / DM) + EPSN);
#pragma unroll
            for (int j = 0; j < 4; ++j) xr[64 * j] = v[j] * rstd * GF[j];
        }
    }
}
template <int MODE>
__device__ __forceinline__ void attn_phase(Frame& F, const bf16* Q, const bf16* KV, const bf16* KR, bf16* O) {
    for (int w = 0; ; ++w) {
        const int it = F.vcu + (w >> 1) * F.G; if (it >= BATCH * NHEAD * 8) break;
        const int bh = it >> 3, s = it & 7, b = bh >> 3, h = bh & 7;
        att::attn_unit<MODE>(b, h, (w & 1) ? s : 15 - s, Q, KV, KR, O, (LAS char*)(F.lds + RING_OFF));
    }
}


constexpr int NPH = 19;
#ifndef MK_PHMASK
#define MK_PHMASK 0x7ffff
#endif
__global__ void __launch_bounds__(NWAVES * 64, 2) yoco_fwd(Args args) {
    extern __shared__ __attribute__((aligned(16))) unsigned char lds[];
    Frame F;
    F.lds = (LAS unsigned char*)lds;
    F.MISC = (volatile LAS unsigned*)(F.lds + MISC_OFF);
    F.tid = threadIdx.x; F.lane = F.tid & 63; F.wave = __builtin_amdgcn_readfirstlane(F.tid >> 6);
    F.G = gridDim.x; { const int bx = blockIdx.x; F.vcu = (F.G % 8 == 0) ? (bx % 8) * (F.G / 8) + bx / 8 : bx; }
    F.ws = args.ws; F.ctl = (gu32*)(args.ws + WS_CTL);
    for (int u = F.tid; u < (LDS_BYTES - LDSCTL_OFF) / 4; u += NWAVES * 64) ((LAS unsigned*)(F.lds + LDSCTL_OFF))[u] = 0u;
    __syncthreads();
    XcdBarrier bar; bar.bar = (unsigned*)(F.ctl + CW_BAR); bar.x = 0; bar.st = nullptr;
    if (!MK_PER_PHASE) bar = xcd_barrier_post((unsigned*)(F.ctl + CW_BAR), F.MISC + 8);
#define GRID_BAR(seam) do { if (MK_PER_PHASE) { if (F.tid == 0) __hip_atomic_store(F.ctl + CW_TMO, 0xBADBA0u | (unsigned)(seam), RLX_AGENT); } else { xcd_barrier(bar); } } while (0)
    const int lo = args.ph_lo, hi = args.ph_hi;
#define IN(k) ((((unsigned)MK_PHMASK >> (k)) & 1u) && lo <= (k) && (k) < hi)
#define REFRESH() do { int t_ = threadIdx.x; asm volatile("" : "+v"(t_)); F.tid = t_; F.lane = t_ & 63; F.wave = __builtin_amdgcn_readfirstlane(t_ >> 6); } while (0)
#define SEAM(k) do { if (IN(k) && IN((k) + 1)) GRID_BAR(k); } while (0)
    unsigned char* ws = args.ws;
    float* XS = args.out;
    const float* MOD0 = (const float*)(ws + WS_MOD); const float* MOD1 = MOD0 + 8 * 6144; const float* MODKV = (const float*)(ws + WS_MODKV);
    bf16* HB0 = (bf16*)(ws + WS_HB0); bf16* HB1 = (bf16*)(ws + WS_HB1); bf16* AO = (bf16*)(ws + WS_AO);
    LAS unsigned char* ring = F.lds + RING_OFF;

    if (IN(0)) { REFRESH(); p0_prologue(F, args); } SEAM(0);
    if (IN(1)) { REFRESH(); norm_phase<false>(F, args.in[0], args.in[5], MOD0 + 1024, MOD0, 6144, HB0, nullptr, nullptr, nullptr, 0, nullptr); } SEAM(1);
    if (IN(2)) { REFRESH(); pg8::Gemm g{HB0, (const bf16*)(ws + WS_WAD), NTOK, NLATP, DM, 0}; pg8::StaticOrder S; S.init(NTOK, NLATP, F.G, (int)blockIdx.x);
        pg8::EpiF32 E{(float*)(ws + WS_LAT), NLATP}; pg8::gemm_phase<pg8::EpiF32, pg8::StaticOrder, true, true>(ring, g, S, E); } SEAM(2);
    if (IN(3)) { REFRESH(); lat_phase(F, args); } SEAM(3);
    if (IN(4)) { REFRESH();
        { pg8::Gemm g{(const bf16*)(ws + WS_CQ), (const bf16*)(ws + WS_WUQ), NTOK, 1024, QLP, 0}; pg8::StaticOrder S; S.init(NTOK, 1024, F.G, (int)blockIdx.x);
          pg8::EpiBf16 E{(bf16*)(ws + WS_Q), NQ, C2_MLA}; pg8::gemm_phase<pg8::EpiBf16, pg8::StaticOrder, true, true>(ring, g, S, E); }
        { pg8::Gemm g{(const bf16*)(ws + WS_CQ), (const bf16*)(ws + WS_WUQ) + (size_t)1024 * QLP, NTOK, 512, QLP, 0}; pg8::StaticOrder S; S.init(NTOK, 512, F.G, (int)blockIdx.x);
          pg8::EpiRope E{(bf16*)(ws + WS_Q) + 1024, NQ, C2_MLA, (const float*)(ws + WS_COS)}; pg8::gemm_phase<pg8::EpiRope, pg8::StaticOrder, true, true>(ring, g, S, E); }
        { pg8::Gemm g{(const bf16*)(ws + WS_CKV), (const bf16*)(ws + WS_WUKV), NTOK, NKV, KVLORA, 0}; pg8::StaticOrder S; S.init(NTOK, NKV, F.G, (int)blockIdx.x);
          pg8::EpiBf16 E{(bf16*)(ws + WS_KV), NKV, 1.0f}; pg8::gemm_phase<pg8::EpiBf16, pg8::StaticOrder, true, true>(ring, g, S, E); }
    } SEAM(4);
    if (IN(5)) { REFRESH(); attn_phase<0>(F, (const bf16*)(ws + WS_Q), (const bf16*)(ws + WS_KV), (const bf16*)(ws + WS_KROT), AO); } SEAM(5);
    if (IN(6)) { REFRESH(); pg8::Gemm g{AO, (const bf16*)(ws + WS_WOA), NTOK, DM, DM, 0}; pg8::StaticOrder S; S.init(NTOK, DM, F.G, (int)blockIdx.x);
        pg8::EpiResid E{args.in[0], XS, MOD0 + 2048, 6144}; pg8::gemm_phase<pg8::EpiResid, pg8::StaticOrder, true, true>(ring, g, S, E); } SEAM(6);
    if (IN(7)) { REFRESH(); norm_phase<false>(F, XS, args.in[6], MOD0 + 4096, MOD0 + 3072, 6144, HB0, nullptr, nullptr, nullptr, 0, nullptr); } SEAM(7);
    if (IN(8)) { REFRESH(); pg8::Gemm g{HB0, (const bf16*)(ws + WS_WGU), NTOK, NGU, DM, 0}; pg8::StaticOrder S; S.init(NTOK, NGU, F.G, (int)blockIdx.x);
        pg8::EpiSwiglu E{(bf16*)(ws + WS_ACT), DFF}; pg8::gemm_phase<pg8::EpiSwiglu, pg8::StaticOrder, true, true>(ring, g, S, E); } SEAM(8);
    if (IN(9)) { REFRESH(); pg8::Gemm g{(const bf16*)(ws + WS_ACT), (const bf16*)(ws + WS_WDN), NTOK, DM, DFF, 0}; pg8::StaticOrder S; S.init(NTOK, DM, F.G, (int)blockIdx.x);
        pg8::EpiResid E{XS, XS, MOD0 + 5120, 6144}; pg8::gemm_phase<pg8::EpiResid, pg8::StaticOrder, true, true>(ring, g, S, E); } SEAM(9);
    if (IN(10)) { REFRESH(); norm_phase<true>(F, XS, args.in[15], MODKV + 1024, MODKV, 2048, HB0, args.in[5] + DM, MOD1 + 1024, MOD1, 6144, HB1); } SEAM(10);
    if (IN(11)) { REFRESH();
        { pg8::Gemm g{HB0, (const bf16*)(ws + WS_WKVSB), NTOK, 2048, DM, 0}; pg8::StaticOrder S; S.init(NTOK, 2048, F.G, (int)blockIdx.x);
          pg8::EpiBf16 E{(bf16*)(ws + WS_KVSB), 2048, 1.0f}; pg8::gemm_phase<pg8::EpiBf16, pg8::StaticOrder, true, true>(ring, g, S, E); }
        { pg8::Gemm g{HB1, (const bf16*)(ws + WS_WQSB), NTOK, DM, DM, 0}; pg8::StaticOrder S; S.init(NTOK, DM, F.G, (int)blockIdx.x);
          pg8::EpiBf16 E{(bf16*)(ws + WS_QSB), DM, C2_SB}; pg8::gemm_phase<pg8::EpiBf16, pg8::StaticOrder, true, true>(ring, g, S, E); }
    } SEAM(11);
    if (IN(12)) { REFRESH(); attn_phase<1>(F, (const bf16*)(ws + WS_QSB), (const bf16*)(ws + WS_KVSB), nullptr, AO); } SEAM(12);
    if (IN(13)) { REFRESH(); pg8::Gemm g{AO, (const bf16*)(ws + WS_WOSB), NTOK, DM, DM, 0}; pg8::StaticOrder S; S.init(NTOK, DM, F.G, (int)blockIdx.x);
        pg8::EpiResid E{XS, XS, MOD1 + 2048, 6144}; pg8::gemm_phase<pg8::EpiResid, pg8::StaticOrder, true, true>(ring, g, S, E); } SEAM(13);
    if (IN(14)) { REFRESH(); router_phase(F, args); } SEAM(14);
    if (IN(15)) { REFRESH(); scatter_phase(F, args); } SEAM(15);
    if (IN(16)) { REFRESH(); unsigned cnt[8]; int off[8]; moe_offsets(F, cnt, off);
        pg8::Gemm g{(const bf16*)(ws + WS_HS), (const bf16*)(ws + WS_WEGU), 0, NGU, DM, (size_t)NGU * DM * 2}; pg8::MoeOrder S; S.init(cnt, NGU, F.G, (int)blockIdx.x);
        pg8::EpiSwiglu E{(bf16*)(ws + WS_ACT2), DFF}; pg8::gemm_phase<pg8::EpiSwiglu, pg8::MoeOrder, true, true>(ring, g, S, E); } SEAM(16);
    if (IN(17)) { REFRESH(); unsigned cnt[8]; int off[8]; moe_offsets(F, cnt, off);
        pg8::Gemm g{(const bf16*)(ws + WS_ACT2), (const bf16*)(ws + WS_WEDN), 0, DM, DFF, (size_t)DM * DFF * 2}; pg8::MoeOrder S; S.init(cnt, DM, F.G, (int)blockIdx.x);
        pg8::EpiBf16 E{(bf16*)(ws + WS_Y), DM, 1.0f}; pg8::gemm_phase<pg8::EpiBf16, pg8::MoeOrder, true, true>(ring, g, S, E); } SEAM(17);
    if (IN(18)) { REFRESH(); final_phase(F, args); }
#undef IN
#undef SEAM
#undef REFRESH
#undef GRID_BAR
}

extern "C" void kernel_launch(void* const* d_in, const int* in_sizes, int n_in, void* d_out, int out_size, void* d_ws, size_t ws_size, hipStream_t stream) {
    static int grid = 0;
    if (grid == 0) {
        if (n_in != 26 || in_sizes[0] != NTOK * DM || out_size != NTOK * DM || ws_size < WS_END) { fprintf(stderr, "kernel_launch: shape/workspace mismatch (n_in %d, in0 %d, out %d, ws %zu, need %zu)\n", n_in, n_in > 0 ? in_sizes[0] : -1, out_size, ws_size, (size_t)WS_END); grid = -1; return; }
        int dev = 0, cus = 0, per_cu = 0;
        if (hipGetDevice(&dev) != hipSuccess || hipDeviceGetAttribute(&cus, hipDeviceAttributeMultiprocessorCount, dev) != hipSuccess) { grid = -1; return; }
        if (hipFuncSetAttribute((const void*)yoco_fwd, hipFuncAttributeMaxDynamicSharedMemorySize, LDS_BYTES) != hipSuccess) { fprintf(stderr, "kernel_launch: hipFuncSetAttribute failed\n"); grid = -1; return; }
        if (hipOccupancyMaxActiveBlocksPerMultiprocessor(&per_cu, (const void*)yoco_fwd, NWAVES * 64, LDS_BYTES) != hipSuccess || per_cu < 1) { fprintf(stderr, "kernel_launch: occupancy query reports %d\n", per_cu); }
        (void)hipGetLastError();
        grid = cus;
    }
    if (grid < 0) return;
    if (hipMemsetAsync((char*)d_ws + WS_CTL, 0, CTL_ZERO_BYTES, stream) != hipSuccess) return;
    Args a{};
    for (int i = 0; i < 26; ++i) a.in[i] = (const float*)d_in[i];
    a.out = (float*)d_out; a.ws = (unsigned char*)d_ws;
    for (int i = 0; i < 32; ++i) a.inv[i] = (float)pow(10000.0, -(double)i / 32.0);
#if MK_PER_PHASE
    for (int p = 0; p < NPH; ++p) { a.ph_lo = p; a.ph_hi = p + 1; a.li = p; hipLaunchKernelGGL(yoco_fwd, dim3(grid), dim3(NWAVES * 64), LDS_BYTES, stream, a); }
#else
    a.ph_lo = 0; a.ph_hi = NPH; a.li = 0;
    hipLaunchKernelGGL(yoco_fwd, dim3(grid), dim3(NWAVES * 64), LDS_BYTES, stream, a);
#endif
    const hipError_t le = hipPeekAtLastError();
    if (le != hipSuccess) fprintf(stderr, "kernel_launch: launch failed: %s\n", hipGetErrorName(le));
}
```

```cpp
#include <hip/hip_runtime.h>
#include <cstdio>
#include <cstdint>
#include <cmath>

namespace pg8 {
#define PG8_LAS __attribute__((address_space(3)))
typedef unsigned short bf16_t;
typedef short bf16x8 __attribute__((ext_vector_type(8)));
typedef float f32x4 __attribute__((ext_vector_type(4)));
typedef unsigned u32x4 __attribute__((ext_vector_type(4)));
constexpr int BM = 256, BK = 64, HALF = 128, HTB = HALF * BK * 2  , STAGE_BYTES = 8 * HTB, NXCD = 8, WGM = 8;

__host__ __device__ __forceinline__ int lds_byte(int r, int c) { const int st = (r >> 4) * 2 + (c >> 5), rr = r & 15, cc = c & 31, ob = rr * 64 + cc * 2; return st * 1024 + (ob ^ (((ob >> 9) & 1) << 5)); }
__host__ __device__ __forceinline__ void stage_rc(int b, int& R, int& C) { const int st = b / 1024, sb = b % 1024, swz = sb ^ (((sb >> 9) & 1) << 5); R = (st >> 1) * 16 + swz / 64; C = (st & 1) * 32 + (swz % 64) / 2; }
__host__ __device__ __forceinline__ int perm32(int rho) { const int n = rho >> 4, i = rho & 15; return 8 * (i >> 2) + 4 * n + (i & 3); }

struct Unit { int pm, pn, eb; };
struct Gemm { const bf16_t* A; const bf16_t* Bt; int M, N, K; size_t bstride; };

struct StaticOrder {
    int nM, nN, nwg, G, c;
    __host__ __device__ void init(int M, int N, int G_, int c_) { nM = M / BM; nN = N / BM; nwg = nM * nN; G = G_; c = c_; }
    __host__ __device__ bool next(int i, Unit& u) const {
        const long L = (long)i * G + c; if (L >= nwg) return false;
        int wgid = (int)L; { const int q = nwg / NXCD, r = nwg % NXCD, xcd = wgid % NXCD, off = wgid / NXCD; wgid = (xcd < r ? xcd * (q + 1) : r * (q + 1) + (xcd - r) * q) + off; }
        const int nig = WGM * nN, gid = wgid / nig, fm = gid * WGM, gsz = (nM - fm) < WGM ? (nM - fm) : WGM;
        u.pm = fm + ((wgid % nig) % gsz); u.pn = (wgid % nig) / gsz; u.eb = 0; return true;
    }
    __device__ __forceinline__ void a_ready(const Unit&) const {}
    __device__ __forceinline__ void done(const Unit&) const {}
};
struct MoeOrder {
    int nM, nN, nwg, G, c; int t1, t2, t3, t4, t5, t6, t7;
    __device__ __forceinline__ void init(const unsigned* cnt, int N, int G_, int c_) {
        int t = 0;
        t += (int)((cnt[0] + 255u) >> 8); t1 = t; t += (int)((cnt[1] + 255u) >> 8); t2 = t; t += (int)((cnt[2] + 255u) >> 8); t3 = t; t += (int)((cnt[3] + 255u) >> 8); t4 = t;
        t += (int)((cnt[4] + 255u) >> 8); t5 = t; t += (int)((cnt[5] + 255u) >> 8); t6 = t; t += (int)((cnt[6] + 255u) >> 8); t7 = t; t += (int)((cnt[7] + 255u) >> 8);
        nM = t; nN = N / BM; nwg = nM * nN; G = G_; c = c_; }
    __device__ __forceinline__ bool next(int i, Unit& u) const {
        const long L = (long)i * G + c; if (L >= nwg) return false;
        int wgid = (int)L; { const int q = nwg / NXCD, r = nwg % NXCD, xcd = wgid % NXCD, off = wgid / NXCD; wgid = (xcd < r ? xcd * (q + 1) : r * (q + 1) + (xcd - r) * q) + off; }
        const int nig = WGM * nN, gid = wgid / nig, fm = gid * WGM, gsz = (nM - fm) < WGM ? (nM - fm) : WGM;
        u.pm = fm + ((wgid % nig) % gsz); u.pn = (wgid % nig) / gsz;
        u.eb = (u.pm >= t1) + (u.pm >= t2) + (u.pm >= t3) + (u.pm >= t4) + (u.pm >= t5) + (u.pm >= t6) + (u.pm >= t7); return true;
    }
    __device__ __forceinline__ void a_ready(const Unit&) const {}
    __device__ __forceinline__ void done(const Unit&) const {}
};

__device__ __forceinline__ unsigned cvt_pk_bf16(float lo, float hi) { unsigned r; asm volatile("v_cvt_pk_bf16_f32 %0, %1, %2" : "=v"(r) : "v"(lo), "v"(hi)); return r; }

struct EpiF32 {
    static constexpr bool PERM = false, AFTER_DRAIN = false;
    float* C; int ldc;
    __device__ __forceinline__ void operator()(const f32x4 (&acc)[2][2][4][2], const Unit& u, int wr, int wc, int fr, int fq) const {
        asm volatile("" : "+v"(fr), "+v"(fq));
        const int row0 = u.pm * BM + wr * 64 + fr, col0 = u.pn * BM + wc * 32 + 4 * fq;
#pragma unroll
        for (int ai = 0; ai < 2; ++ai)
#pragma unroll
            for (int m = 0; m < 4; ++m) { float* rowp = C + (size_t)(row0 + ai * HALF + m * 16) * ldc + col0;
#pragma unroll
                for (int bj = 0; bj < 2; ++bj)
#pragma unroll
                    for (int n = 0; n < 2; ++n) *(f32x4*)(rowp + bj * HALF + n * 16) = acc[ai][bj][m][n]; }
    }
};
struct EpiBf16 {
    static constexpr bool PERM = true, AFTER_DRAIN = false;
    bf16_t* O; int ldc; float scale;
    __device__ __forceinline__ void operator()(const f32x4 (&acc)[2][2][4][2], const Unit& u, int wr, int wc, int fr, int fq) const {
        asm volatile("" : "+v"(fr), "+v"(fq));
        const int row0 = u.pm * BM + wr * 64 + fr; const int col0 = u.pn * BM + wc * 32 + 8 * fq; const float sc = scale;
#pragma unroll
        for (int ai = 0; ai < 2; ++ai)
#pragma unroll
            for (int m = 0; m < 4; ++m) { bf16_t* rowp = O + (size_t)(row0 + ai * HALF + m * 16) * ldc + col0;
#pragma unroll
                for (int bj = 0; bj < 2; ++bj) { f32x4 v0 = acc[ai][bj][m][0] * sc, v1 = acc[ai][bj][m][1] * sc;
                    u32x4 w; w.x = cvt_pk_bf16(v0[0], v0[1]); w.y = cvt_pk_bf16(v0[2], v0[3]); w.z = cvt_pk_bf16(v1[0], v1[1]); w.w = cvt_pk_bf16(v1[2], v1[3]);
                    *(u32x4*)(rowp + bj * HALF) = w; } }
    }
};
struct EpiRope {
    static constexpr bool PERM = true, AFTER_DRAIN = false;
    bf16_t* O; int ldc; float scale; const float* CS;
    __device__ __forceinline__ void operator()(const f32x4 (&acc)[2][2][4][2], const Unit& u, int wr, int wc, int fr, int fq) const {
        asm volatile("" : "+v"(fr), "+v"(fq));
        const int row0 = u.pm * BM + wr * 64 + fr; const int col0 = u.pn * BM + wc * 32 + 8 * fq; const float sc = scale;
        const int g4 = ((wc & 1) * 4 + fq) * 4;
#pragma unroll
        for (int ai = 0; ai < 2; ++ai)
#pragma unroll
            for (int m = 0; m < 4; ++m) { int ro = ai * HALF + m * 16; asm volatile("" : "+s"(ro)); const int row = row0 + ro; bf16_t* rowp = O + (size_t)row * ldc + col0;
                const f32x4 cs = *(const f32x4*)(CS + (size_t)row * 64 + g4) * sc, sn = *(const f32x4*)(CS + (size_t)row * 64 + 32 + g4) * sc;
#pragma unroll
                for (int bj = 0; bj < 2; ++bj) { const f32x4 x1 = acc[ai][bj][m][0], x2 = acc[ai][bj][m][1];
                    const f32x4 v0 = x1 * cs - x2 * sn, v1 = x1 * sn + x2 * cs;
                    u32x4 w; w.x = cvt_pk_bf16(v0[0], v0[1]); w.y = cvt_pk_bf16(v0[2], v0[3]); w.z = cvt_pk_bf16(v1[0], v1[1]); w.w = cvt_pk_bf16(v1[2], v1[3]);
                    *(u32x4*)(rowp + bj * HALF) = w; }
                asm volatile("" ::: "memory"); }
    }
};
struct EpiResid {
    static constexpr bool PERM = false, AFTER_DRAIN = false;
    const float* base; float* out; const float* gate; int gstride;
    __device__ __forceinline__ void operator()(const f32x4 (&acc)[2][2][4][2], const Unit& u, int wr, int wc, int fr, int fq) const {
        asm volatile("" : "+v"(fr), "+v"(fq));
        const int row0 = u.pm * BM + wr * 64 + fr, col0 = u.pn * BM + wc * 32 + 4 * fq; const int b = u.pm >> 4;
        f32x4 gv[2][2];
#pragma unroll
        for (int bj = 0; bj < 2; ++bj)
#pragma unroll
            for (int n = 0; n < 2; ++n) gv[bj][n] = *(const f32x4*)(gate + (size_t)b * gstride + col0 + bj * HALF + n * 16);
#pragma unroll
        for (int ai = 0; ai < 2; ++ai)
#pragma unroll
            for (int m = 0; m < 4; ++m) { const size_t off = (size_t)(row0 + ai * HALF + m * 16) * 1024 + col0;
#pragma unroll
                for (int bj = 0; bj < 2; ++bj)
#pragma unroll
                    for (int n = 0; n < 2; ++n) { const f32x4 bs = *(const f32x4*)(base + off + bj * HALF + n * 16); *(f32x4*)(out + off + bj * HALF + n * 16) = bs + gv[bj][n] * acc[ai][bj][m][n]; }
                if (m & 1) asm volatile("" ::: "memory"); }
    }
};
struct EpiSwiglu {
    static constexpr bool PERM = true, AFTER_DRAIN = false;
    bf16_t* O; int ldc;
    __device__ __forceinline__ static float act(float g, float up) { const float e = __builtin_amdgcn_exp2f(g * -1.4426950408889634f); return g * __builtin_amdgcn_rcpf(1.0f + e) * up; }
    __device__ __forceinline__ void operator()(const f32x4 (&acc)[2][2][4][2], const Unit& u, int wr, int wc, int fr, int fq) const {
        asm volatile("" : "+v"(fr), "+v"(fq));
        const int row0 = u.pm * BM + wr * 64 + fr; const int col0 = u.pn * HALF + wc * 32 + 8 * fq;
#pragma unroll
        for (int ai = 0; ai < 2; ++ai)
#pragma unroll
            for (int m = 0; m < 4; ++m) { bf16_t* rowp = O + (size_t)(row0 + ai * HALF + m * 16) * ldc + col0;
                const f32x4 g0 = acc[ai][0][m][0], g1 = acc[ai][0][m][1], u0 = acc[ai][1][m][0], u1 = acc[ai][1][m][1];
                u32x4 w; w.x = cvt_pk_bf16(act(g0[0], u0[0]), act(g0[1], u0[1])); w.y = cvt_pk_bf16(act(g0[2], u0[2]), act(g0[3], u0[3]));
                w.z = cvt_pk_bf16(act(g1[0], u1[0]), act(g1[1], u1[1])); w.w = cvt_pk_bf16(act(g1[2], u1[2]), act(g1[3], u1[3]));
                *(u32x4*)rowp = w; }
    }
};

template <class Epi, class Sched, bool ALIGN_EPI = false, bool SP2 = false>
__device__ __forceinline__ void gemm_phase(PG8_LAS unsigned char* lds, const Gemm g, const Sched& S, const Epi& E) {
    int tid_ = threadIdx.x; asm volatile("" : "+v"(tid_));
    const int tid = tid_, wid = __builtin_amdgcn_readfirstlane(tid >> 6), lane = tid & 63, wr = wid >> 2, wc = wid & 3, fr = lane & 15, fq = lane >> 4;
    const int K = g.K, nt = K / BK;
    unsigned voffA[2], voffB[2];
#pragma unroll
    for (int i = 0; i < 2; ++i) { int R, C; stage_rc(tid * 16 + i * 8192, R, C); const int Rb = Epi::PERM ? ((R & ~31) + perm32(R & 31)) : R;
        voffA[i] = (unsigned)(R * K + C) * 2u; voffB[i] = (unsigned)(Rb * K + C) * 2u; }
    const size_t kstep = (size_t)(BK * 2);
    const size_t hstep = (size_t)HALF * K * 2;
    const size_t tstep = 2 * hstep;
    const unsigned ldsw = (unsigned)wid * 1024u;
    const int aoff = lds_byte(wr * 64 + fr, fq * 8), boff = lds_byte(wc * 32 + fr, fq * 8);
#define PG8_SA(b, h) (((b) * 2 + (h)) * HTB)
#define PG8_SB(b, h) ((4 + (b) * 2 + (h)) * HTB)
#define PG8_STAGE(bufoff, gbase, voff) do { _Pragma("unroll") for (int _i = 0; _i < 2; ++_i) \
        __builtin_amdgcn_global_load_lds((const unsigned*)((const char*)(gbase) + (voff)[_i]), (PG8_LAS unsigned*)(lds + (bufoff) + ldsw + _i * 8192), 16, 0, 0); } while (0)
#define PG8_LDA(dst, b, h) do { _Pragma("unroll") for (int m = 0; m < 4; ++m) _Pragma("unroll") for (int k = 0; k < 2; ++k) dst[m][k] = *(const PG8_LAS bf16x8*)(lds + PG8_SA(b, h) + aoff + m * 2048 + k * 1024); } while (0)
#define PG8_LDB(dst, b, h) do { _Pragma("unroll") for (int n = 0; n < 2; ++n) _Pragma("unroll") for (int k = 0; k < 2; ++k) dst[n][k] = *(const PG8_LAS bf16x8*)(lds + PG8_SB(b, h) + boff + n * 2048 + k * 1024); } while (0)
#define PG8_MMA(ai, bj, At, Bt) do { __builtin_amdgcn_s_setprio(1); _Pragma("unroll") for (int m = 0; m < 4; ++m) _Pragma("unroll") for (int n = 0; n < 2; ++n) _Pragma("unroll") for (int k = 0; k < 2; ++k) \
        acc[ai][bj][m][n] = __builtin_amdgcn_mfma_f32_16x16x32_bf16(Bt[n][k], At[m][k], acc[ai][bj][m][n], 0, 0, 0); __builtin_amdgcn_s_setprio(0); } while (0)
#define PG8_WAIT_V(n) asm volatile("s_waitcnt vmcnt(" #n ")" ::: "memory")
#define PG8_WAIT_L(n) asm volatile("s_waitcnt lgkmcnt(" #n ")" ::: "memory")
#define PG8_BAR __builtin_amdgcn_s_barrier()
#define PG8_SCHED __builtin_amdgcn_sched_barrier(0)
    Unit cur, nxt; int ui = 0;
    if (!S.next(0, cur)) return;
    f32x4 acc[2][2][4][2];
#pragma unroll
    for (int a = 0; a < 2; ++a)
#pragma unroll
        for (int b = 0; b < 2; ++b)
#pragma unroll
            for (int m = 0; m < 4; ++m)
#pragma unroll
                for (int n = 0; n < 2; ++n) acc[a][b][m][n] = (f32x4){0.f, 0.f, 0.f, 0.f};
    bf16x8 At[4][2], B0[2][2], B1[2][2];
    const char* cA = (const char*)g.A + (size_t)cur.pm * tstep; const char* cB = (const char*)g.Bt + (size_t)cur.pn * tstep + (size_t)cur.eb * g.bstride;
    S.a_ready(cur);
    if constexpr (SP2) {
        PG8_STAGE(PG8_SB(0, 0), cB, voffB); PG8_STAGE(PG8_SB(0, 1), cB + hstep, voffB); PG8_STAGE(PG8_SA(0, 0), cA, voffA); PG8_STAGE(PG8_SA(0, 1), cA + hstep, voffA);
        if (wr == 1) PG8_BAR;
        PG8_WAIT_V(2); PG8_BAR;
        PG8_STAGE(PG8_SB(1, 0), cB + kstep, voffB); PG8_STAGE(PG8_SA(1, 0), cA + kstep, voffA); PG8_STAGE(PG8_SB(1, 1), cB + hstep + kstep, voffB);
        PG8_WAIT_V(6); PG8_BAR;
    } else {
        PG8_STAGE(PG8_SB(0, 0), cB, voffB); PG8_STAGE(PG8_SA(0, 0), cA, voffA); PG8_STAGE(PG8_SB(0, 1), cB + hstep, voffB); PG8_STAGE(PG8_SA(0, 1), cA + hstep, voffA);
        if (wr == 1) PG8_BAR;
        PG8_WAIT_V(4); PG8_BAR;
        PG8_STAGE(PG8_SB(1, 0), cB + kstep, voffB); PG8_STAGE(PG8_SA(1, 0), cA + kstep, voffA); PG8_STAGE(PG8_SB(1, 1), cB + hstep + kstep, voffB);
        PG8_WAIT_V(6); PG8_BAR;
    }
    for (;;) {
        const bool has_next = S.next(ui + 1, nxt);
        const char* nA = has_next ? (const char*)g.A + (size_t)nxt.pm * tstep : cA; const char* nB = has_next ? (const char*)g.Bt + (size_t)nxt.pn * tstep + (size_t)nxt.eb * g.bstride : cB;
        for (int t = 0; t < nt; t += 2) {
            const bool last = (t == nt - 2);
            const char* a1 = cA + (size_t)(t + 1) * kstep;
            const char* a2 = last ? nA : cA + (size_t)(t + 2) * kstep; const char* b2 = last ? nB : cB + (size_t)(t + 2) * kstep;
            const char* a3 = a2 + kstep; const char* b3 = b2 + kstep;
            if (last && has_next) S.a_ready(nxt);
            if constexpr (SP2) {
            PG8_LDB(B0, 0, 0); PG8_LDB(B1, 0, 1); PG8_SCHED; PG8_LDA(At, 0, 0); PG8_STAGE(PG8_SA(1, 1), a1 + hstep, voffA);
            PG8_WAIT_V(8); PG8_WAIT_L(0); PG8_BAR; PG8_MMA(0, 0, At, B0); PG8_MMA(0, 1, At, B1); PG8_BAR; PG8_SCHED;
            PG8_LDA(At, 0, 1); PG8_STAGE(PG8_SB(0, 0), b2, voffB); PG8_STAGE(PG8_SB(0, 1), b2 + hstep, voffB); PG8_STAGE(PG8_SA(0, 0), a2, voffA);
            PG8_WAIT_V(8); PG8_WAIT_L(0); PG8_BAR; PG8_MMA(1, 0, At, B0); PG8_MMA(1, 1, At, B1); PG8_BAR; PG8_SCHED;
            PG8_LDB(B0, 1, 0); PG8_LDB(B1, 1, 1); PG8_SCHED; PG8_LDA(At, 1, 0); PG8_STAGE(PG8_SA(0, 1), a2 + hstep, voffA);
            PG8_WAIT_V(8); PG8_WAIT_L(0); PG8_BAR; PG8_MMA(0, 0, At, B0); PG8_MMA(0, 1, At, B1); PG8_BAR; PG8_SCHED;
            PG8_LDA(At, 1, 1); PG8_STAGE(PG8_SB(1, 0), b3, voffB); PG8_STAGE(PG8_SB(1, 1), b3 + hstep, voffB); PG8_STAGE(PG8_SA(1, 0), a3, voffA);
            PG8_WAIT_V(8); PG8_WAIT_L(0); PG8_BAR; PG8_MMA(1, 0, At, B0); PG8_MMA(1, 1, At, B1); PG8_BAR; PG8_SCHED;
            } else {
            PG8_LDB(B0, 0, 0); PG8_SCHED; PG8_LDA(At, 0, 0); PG8_STAGE(PG8_SA(1, 1), a1 + hstep, voffA);
            PG8_WAIT_L(8); PG8_BAR; PG8_WAIT_L(0); PG8_MMA(0, 0, At, B0); PG8_BAR; PG8_SCHED;
            PG8_LDB(B1, 0, 1); PG8_STAGE(PG8_SB(0, 0), b2, voffB);
            PG8_BAR; PG8_WAIT_L(0); PG8_MMA(0, 1, At, B1); PG8_BAR;
            PG8_LDA(At, 0, 1); PG8_STAGE(PG8_SA(0, 0), a2, voffA);
            PG8_BAR; PG8_WAIT_L(0); PG8_MMA(1, 0, At, B0); PG8_BAR; PG8_SCHED;
            PG8_STAGE(PG8_SB(0, 1), b2 + hstep, voffB);
            PG8_WAIT_V(6); PG8_BAR; PG8_MMA(1, 1, At, B1); PG8_BAR;
            PG8_LDB(B0, 1, 0); PG8_SCHED; PG8_LDA(At, 1, 0); PG8_STAGE(PG8_SA(0, 1), a2 + hstep, voffA);
            PG8_WAIT_L(8); PG8_BAR; PG8_WAIT_L(0); PG8_MMA(0, 0, At, B0); PG8_BAR; PG8_SCHED;
            PG8_LDB(B1, 1, 1); PG8_STAGE(PG8_SB(1, 0), b3, voffB);
            PG8_BAR; PG8_WAIT_L(0); PG8_MMA(0, 1, At, B1); PG8_BAR;
            PG8_LDA(At, 1, 1); PG8_STAGE(PG8_SA(1, 0), a3, voffA);
            PG8_BAR; PG8_WAIT_L(0); PG8_MMA(1, 0, At, B0); PG8_BAR; PG8_SCHED;
            PG8_STAGE(PG8_SB(1, 1), b3 + hstep, voffB);
            PG8_WAIT_V(6); PG8_BAR; PG8_MMA(1, 1, At, B1); PG8_BAR;
            }
        }
        if constexpr (ALIGN_EPI) { if (wr == 0) PG8_BAR; }
        if constexpr (!Epi::AFTER_DRAIN) { E(acc, cur, wr, wc, fr, fq); S.done(cur); }
        if (!has_next) break;
#pragma unroll
        for (int a = 0; a < 2; ++a)
#pragma unroll
            for (int b = 0; b < 2; ++b)
#pragma unroll
                for (int m = 0; m < 4; ++m)
#pragma unroll
                    for (int n = 0; n < 2; ++n) acc[a][b][m][n] = (f32x4){0.f, 0.f, 0.f, 0.f};
        cur = nxt; cA = nA; cB = nB; ++ui;
        if constexpr (ALIGN_EPI) { if (wr == 1) PG8_BAR; }
    }
    PG8_WAIT_V(0);
    if constexpr (!ALIGN_EPI) { if (wr == 0) PG8_BAR; }
    PG8_BAR;
    if constexpr (Epi::AFTER_DRAIN) { E.fused(acc, cur, wr, wc, fr, fq, lds, wid, lane); S.done(cur); }
#undef PG8_SA
#undef PG8_SB
#undef PG8_STAGE
#undef PG8_LDA
#undef PG8_LDB
#undef PG8_MMA
#undef PG8_WAIT_V
#undef PG8_WAIT_L
#undef PG8_BAR
#undef PG8_SCHED
}
}

namespace att {
typedef unsigned short bf16_t;
typedef short bf16x8 __attribute__((ext_vector_type(8)));
typedef short s16x4 __attribute__((ext_vector_type(4)));
typedef float f32x16 __attribute__((ext_vector_type(16)));
typedef unsigned u32x4 __attribute__((ext_vector_type(4)));
#define ALDS __attribute__((address_space(3)))
#define ASBAR() __builtin_amdgcn_sched_barrier(0)
constexpr int SEQ = 4096, KVBLK = 64, QBLK = 32, NW = 8, QB = NW * QBLK;
constexpr int KROW = 512, SHM_K = KVBLK * KROW, SHM_V = KVBLK * 128 * 2;
constexpr int OFF_V = 0, OFF_K = 2 * SHM_V, OFF_S = OFF_K + 2 * SHM_K, LDS_BYTES = OFF_S + NW * 64 * 4;
__device__ __forceinline__ int v_st(int k, int c) { const int kk = (k & ~0xC) | ((k & 4) << 1) | ((k & 8) >> 1); return ((kk >> 3) * 4 + (c >> 5)) * 512 + ((kk & 7) * 32 + (c & 31)) * 2; }
__device__ __forceinline__ int v_rd_base(int lane) { return ((lane & 3) << 3) | (((lane >> 2) & 3) << 6) | (((lane >> 4) & 1) << 5) | (((lane >> 5) & 1) << 8); }
constexpr int v_rd_off(int d0, int ks, int half) { return d0 * 512 + ks * 4096 + half * 2048; }
__device__ __forceinline__ int crow(int r, int hi) { return (r & 3) + 8 * (r >> 2) + 4 * hi; }
__device__ __forceinline__ unsigned cvtpk(float lo, float hi) { unsigned r; asm volatile("v_cvt_pk_bf16_f32 %0, %1, %2" : "=v"(r) : "v"(lo), "v"(hi)); return r; }

__device__ __forceinline__ void pv_tile(f32x16* o, int vb, bf16x8 pa0, bf16x8 pa1, bf16x8 pa2, bf16x8 pa3) {
#define TRRD(dst, off) asm volatile("ds_read_b64_tr_b16 %0, %1 offset:%2" : "=&v"(dst) : "v"(vb), "i"(off) : "memory")
#define PV_D0(d0) do { s16x4 l0, l1, l2, l3, h0, h1, h2, h3; constexpr int b_ = v_rd_off(d0, 0, 0);   \
        TRRD(l0, b_); TRRD(h0, b_ + 2048); TRRD(l1, b_ + 4096); TRRD(h1, b_ + 6144); TRRD(l2, b_ + 8192); TRRD(h2, b_ + 10240); TRRD(l3, b_ + 12288); TRRD(h3, b_ + 14336); \
        asm volatile("s_waitcnt lgkmcnt(0)" ::: "memory"); ASBAR();   \
        o[d0] = __builtin_amdgcn_mfma_f32_32x32x16_bf16(pa0, (bf16x8){l0[0], l0[1], l0[2], l0[3], h0[0], h0[1], h0[2], h0[3]}, o[d0], 0, 0, 0);   \
        o[d0] = __builtin_amdgcn_mfma_f32_32x32x16_bf16(pa1, (bf16x8){l1[0], l1[1], l1[2], l1[3], h1[0], h1[1], h1[2], h1[3]}, o[d0], 0, 0, 0);   \
        o[d0] = __builtin_amdgcn_mfma_f32_32x32x16_bf16(pa2, (bf16x8){l2[0], l2[1], l2[2], l2[3], h2[0], h2[1], h2[2], h2[3]}, o[d0], 0, 0, 0);   \
        o[d0] = __builtin_amdgcn_mfma_f32_32x32x16_bf16(pa3, (bf16x8){l3[0], l3[1], l3[2], l3[3], h3[0], h3[1], h3[2], h3[3]}, o[d0], 0, 0, 0); } while (0)
    PV_D0(0); PV_D0(1); PV_D0(2); PV_D0(3);
#undef PV_D0
#undef TRRD
}
__device__ __forceinline__ void pack_p(const f32x16& p0, const f32x16& p1, bf16x8& pa0, bf16x8& pa1, bf16x8& pa2, bf16x8& pa3) {
#define PK4(P, B_, OUT) do { unsigned a0 = cvtpk(P[B_+0], P[B_+1]), a1 = cvtpk(P[B_+2], P[B_+3]);                          \
        unsigned b0 = cvtpk(P[B_+4], P[B_+5]), b1 = cvtpk(P[B_+6], P[B_+7]);                                             \
        auto r0 = __builtin_amdgcn_permlane32_swap(a0, b0, false, false); auto r1 = __builtin_amdgcn_permlane32_swap(a1, b1, false, false); \
        u32x4 w = {r0[0], r1[0], r0[1], r1[1]}; OUT = __builtin_bit_cast(bf16x8, w); } while (0)
    PK4(p0, 0, pa0); PK4(p0, 8, pa1); PK4(p1, 0, pa2); PK4(p1, 8, pa3);
#undef PK4
}
__device__ __forceinline__ float swap_max(float v) { auto rr = __builtin_amdgcn_permlane32_swap(__float_as_uint(v), __float_as_uint(v), false, false); return fmaxf(__uint_as_float(rr[0]), __uint_as_float(rr[1])); }
__device__ __forceinline__ float swap_sum(float v) { auto rr = __builtin_amdgcn_permlane32_swap(__float_as_uint(v), __float_as_uint(v), false, false); return __uint_as_float(rr[0]) + __uint_as_float(rr[1]); }

template <int MODE>
__device__ __forceinline__ void attn_unit(int b, int h, int qb, const bf16_t* __restrict__ Qp, const bf16_t* __restrict__ KVp, const bf16_t* __restrict__ KRp, bf16_t* __restrict__ Op, ALDS char* lds) {
    constexpr int DK = MODE == 0 ? 192 : 128, NQ = DK / 16, KI = DK / 64;
    int tid_ = threadIdx.x; asm volatile("" : "+v"(tid_));
    const int tid = tid_, wid = __builtin_amdgcn_readfirstlane(tid >> 6), lane = tid & 63, r32 = lane & 31, hi = lane >> 5;
    const size_t tok0 = (size_t)b * SEQ;
    const int q0 = qb * QB, qlo = q0 + wid * QBLK;
    bf16x8 qr[NQ];
    { const size_t row = tok0 + qlo + r32;
#pragma unroll
      for (int d0 = 0; d0 < NQ; ++d0) {
          const bf16_t* p;
          if (MODE == 0) p = (d0 < 8) ? Qp + row * 1536 + h * 128 + d0 * 16 + hi * 8 : Qp + row * 1536 + 1024 + h * 64 + (d0 - 8) * 16 + hi * 8;
          else p = Qp + row * 1024 + h * 128 + d0 * 16 + hi * 8;
          qr[d0] = *(const bf16x8*)p; } }
    const int krow = tid >> 3, kcg = tid & 7;
    const int kws = krow * KROW + ((kcg ^ (krow & 7)) << 4);
    const int sr = tid >> 4, sc = (tid & 15) * 8;
    const int vst0 = v_st(sr, sc), vst1 = v_st(32 + sr, sc);
    const bf16_t* ksrc = (MODE == 0) ? KVp + (tok0 + krow) * 2048 + h * 256 + kcg * 8 : KVp + (tok0 + krow) * 2048 + h * 128 + kcg * 8;
    const bf16_t* krsrc = (MODE == 0) ? KRp + (tok0 + krow) * 64 + kcg * 8 : nullptr;
    const bf16_t* vsrc = (MODE == 0) ? KVp + (tok0 + sr) * 2048 + h * 256 + 128 + sc : KVp + (tok0 + sr) * 2048 + 1024 + h * 128 + sc;
    bf16x8 stk[KI], stv0, stv1;
#define ST_LOAD(j) do { const size_t k0_ = (size_t)(j) * KVBLK; \
        stk[0] = *(const bf16x8*)(ksrc + k0_ * 2048); stk[1] = *(const bf16x8*)(ksrc + k0_ * 2048 + 64); \
        if (MODE == 0) stk[KI - 1] = *(const bf16x8*)(krsrc + k0_ * 64); \
        stv0 = *(const bf16x8*)(vsrc + k0_ * 2048); stv1 = *(const bf16x8*)(vsrc + (k0_ + 32) * 2048); } while (0)
#define ST_WRITE(buf) do { ALDS char* kb_ = lds + OFF_K + (buf) * SHM_K + kws; \
        _Pragma("unroll") for (int i_ = 0; i_ < KI; ++i_) *(ALDS bf16x8*)(kb_ + i_ * 128) = stk[i_]; \
        *(ALDS bf16x8*)(lds + OFF_V + (buf) * SHM_V + vst0) = stv0; *(ALDS bf16x8*)(lds + OFF_V + (buf) * SHM_V + vst1) = stv1; } while (0)
    int kb[4];
#pragma unroll
    for (int dd = 0; dd < 4; ++dd) kb[dd] = OFF_K + r32 * KROW + (((dd * 2 + hi) ^ (r32 & 7)) << 4);
    const int vb0 = (int)(unsigned)(uintptr_t)(lds + OFF_V) + v_rd_base(lane);
    ALDS float* wsf = (ALDS float*)(lds + OFF_S) + wid * 64;
    const int NT = 4 * qb + 4;
    f32x16 o[4] = {};
    float m_reg = -1e30f, l_reg = 0.f, carry = 0.f;
    const float NEG = -__builtin_inff();
#define TILE_OF(s) (MODE == 0 ? (s) : NT - 1 - (s))
    ST_LOAD(TILE_OF(0)); ST_WRITE(0);
    __syncthreads();
    for (int s = 0; s < NT; ++s) {
        const int j = TILE_OF(s), buf = s & 1;
        if (s + 1 < NT) ST_LOAD(TILE_OF(s + 1));
        const int kb0 = j * KVBLK;
        const bool active = (MODE == 0) ? (kb0 <= qlo + QBLK - 1) : (kb0 < qlo + QBLK - 1);
        if (active) {
            f32x16 p0 = {}, p1 = {};
            { const ALDS char* kbase = lds + buf * SHM_K;
#pragma unroll
              for (int d0 = 0; d0 < NQ; ++d0) { const ALDS char* a = kbase + kb[d0 & 3] + (d0 >> 2) * 128;
                  const bf16x8 b0 = *(const ALDS bf16x8*)a; const bf16x8 b1 = *(const ALDS bf16x8*)(a + 32 * KROW);
                  p0 = __builtin_amdgcn_mfma_f32_32x32x16_bf16(b0, qr[d0], p0, 0, 0, 0);
                  p1 = __builtin_amdgcn_mfma_f32_32x32x16_bf16(b1, qr[d0], p1, 0, 0, 0); } }
            const bool needmask = (MODE == 0) ? (kb0 + KVBLK - 1 > qlo) : (kb0 + KVBLK - 1 >= qlo);
            if (needmask) { const int dq = qlo + r32 - kb0 - 4 * hi;
#pragma unroll
                for (int r = 0; r < 16; ++r) { const int c = (r & 3) + 8 * (r >> 2);
                    if (MODE == 0) { if (c > dq) p0[r] = NEG; if (c + 32 > dq) p1[r] = NEG; }
                    else { if (c >= dq) p0[r] = NEG; if (c + 32 >= dq) p1[r] = NEG; } } }
            bf16x8 pa0, pa1, pa2, pa3;
            if (MODE == 0) {
                float pmax = p0[0];
#pragma unroll
                for (int r = 1; r < 16; ++r) pmax = fmaxf(pmax, p0[r]);
#pragma unroll
                for (int r = 0; r < 16; ++r) pmax = fmaxf(pmax, p1[r]);
                pmax = swap_max(pmax);
                float alpha = 1.f;
                if (!__all(pmax - m_reg <= 8.0f)) { const float mn = fmaxf(m_reg, pmax); alpha = __builtin_amdgcn_exp2f(m_reg - mn); m_reg = mn; }
                float ps = 0.f;
#pragma unroll
                for (int r = 0; r < 16; ++r) { p0[r] = __builtin_amdgcn_exp2f(p0[r] - m_reg); ps += p0[r]; }
#pragma unroll
                for (int r = 0; r < 16; ++r) { p1[r] = __builtin_amdgcn_exp2f(p1[r] - m_reg); ps += p1[r]; }
                ps = swap_sum(ps);
                l_reg = l_reg * alpha + ps;
                if (__any(alpha < 1.f)) { if (hi == 0) wsf[r32] = alpha; asm volatile("s_waitcnt lgkmcnt(0)" ::: "memory");
#pragma unroll
                    for (int r = 0; r < 16; ++r) { const float f = wsf[crow(r, hi)];
#pragma unroll
                        for (int d_ = 0; d_ < 4; ++d_) o[d_][r] *= f; }
                    asm volatile("s_waitcnt lgkmcnt(0)" ::: "memory"); }
            } else {
                float si[9];
#define SB_GRP(P, B_, k) do { const float za = P[B_], zb = P[B_ + 1], zc = P[B_ + 2], zd = P[B_ + 3]; \
                    const float sa = fmaxf(za, 0.f) + __builtin_amdgcn_logf(1.0f + __builtin_amdgcn_exp2f(-fabsf(za))), sb = fmaxf(zb, 0.f) + __builtin_amdgcn_logf(1.0f + __builtin_amdgcn_exp2f(-fabsf(zb))); \
                    const float sc_ = fmaxf(zc, 0.f) + __builtin_amdgcn_logf(1.0f + __builtin_amdgcn_exp2f(-fabsf(zc))), sd = fmaxf(zd, 0.f) + __builtin_amdgcn_logf(1.0f + __builtin_amdgcn_exp2f(-fabsf(zd))); \
                    const float u1 = -sd, u2 = u1 - sc_, u3 = u2 - sb; si[k] = u3 - sa; \
                    P[B_ + 3] = zd - sd; P[B_ + 2] = (zc - sc_) + u1; P[B_ + 1] = (zb - sb) + u2; P[B_] = (za - sa) + u3; } while (0)
                SB_GRP(p0, 0, 0); SB_GRP(p0, 4, 1); SB_GRP(p0, 8, 2); SB_GRP(p0, 12, 3); SB_GRP(p1, 0, 4); SB_GRP(p1, 4, 5); SB_GRP(p1, 8, 6); SB_GRP(p1, 12, 7);
#undef SB_GRP
                si[8] = 0.f;
#pragma unroll
                for (int k = 6; k >= 0; --k) si[k] += si[k + 1];
#pragma unroll
                for (int k = 0; k < 8; ++k) {
                    auto rr = __builtin_amdgcn_permlane32_swap(__float_as_uint(si[k]), __float_as_uint(si[k + 1]), false, false);
                    const float other = hi ? __uint_as_float(rr[0]) : __uint_as_float(rr[1]);
                    const float X = carry + si[k + 1] + other;
                    if (k < 4) {
#pragma unroll
                        for (int i = 0; i < 4; ++i) p0[4 * k + i] = __builtin_amdgcn_exp2f(p0[4 * k + i] + X); }
                    else {
#pragma unroll
                        for (int i = 0; i < 4; ++i) p1[4 * (k - 4) + i] = __builtin_amdgcn_exp2f(p1[4 * (k - 4) + i] + X); }
                }
                carry += swap_sum(si[0]);
            }
            pack_p(p0, p1, pa0, pa1, pa2, pa3);
            pv_tile(o, vb0 + buf * SHM_V, pa0, pa1, pa2, pa3);
        }
        if (s + 1 < NT) ST_WRITE((s + 1) & 1);
        __syncthreads();
    }
    float rli[16];
    if (MODE == 0) { if (hi == 0) wsf[32 + r32] = l_reg; asm volatile("s_waitcnt lgkmcnt(0)" ::: "memory");
#pragma unroll
        for (int r = 0; r < 16; ++r) rli[r] = __builtin_amdgcn_rcpf(wsf[32 + crow(r, hi)]);
    } else {
#pragma unroll
        for (int r = 0; r < 16; ++r) rli[r] = 1.f; }
    bf16_t* Ow = Op + (tok0 + qlo) * 1024 + h * 128;
#pragma unroll
    for (int r = 0; r < 16; ++r) { const int orow = crow(r, hi);
#pragma unroll
        for (int d0 = 0; d0 < 4; ++d0) { const float v = o[d0][r] * rli[r]; const float vn = __shfl_xor(v, 1);
            if ((r32 & 1) == 0) *(unsigned*)(Ow + (size_t)orow * 1024 + d0 * 32 + r32) = cvtpk(v, vn); } }
    asm volatile("s_waitcnt lgkmcnt(0)" ::: "memory");
    __syncthreads();
#undef ST_LOAD
#undef ST_WRITE
#undef TILE_OF
}
#undef ASBAR
}

constexpr int NWAVES = 8;
#ifndef MK_PER_PHASE
#define MK_PER_PHASE 0
#endif
constexpr int BATCH = 8, SEQ = 4096, DM = 1024, NTOK = BATCH * SEQ;
constexpr int QLORA = 384, QLP = 512  , KVLORA = 256, ROPE = 64, NLAT = 704, NLATP = 768, NHEAD = 8;
constexpr int NQ = NHEAD * 192, NKV = NHEAD * 256, DFF = 3584, NGU = 2 * DFF, NEXP = 8;
constexpr int MOE_ROWS = 2 * NTOK + NEXP * 256;
constexpr float EPSN = 1e-6f;
constexpr float C2_MLA = 1.4426950408889634f * 0.07216878364870322f;
constexpr float C2_SB = 1.4426950408889634f * 0.08838834764831845f;
constexpr size_t MiB = 1u << 20;
constexpr size_t WS_CTL = 0, CTL_ZERO_BYTES = 1 * MiB;
constexpr size_t WS_MOD = 1 * MiB;
constexpr size_t WS_MODKV = WS_MOD + (size_t)2 * 8 * 6144 * 4;
constexpr size_t WS_RT_E = 2 * MiB, WS_RT_POS = WS_RT_E + 256 * 1024, WS_RT_W = WS_RT_POS + 256 * 1024;
constexpr size_t WS_COS = 4 * MiB;
constexpr size_t WS_WAD = 12 * MiB, WS_WUQ = 14 * MiB, WS_WUKV = 16 * MiB, WS_WOA = 18 * MiB, WS_WKVSB = 20 * MiB, WS_WQSB = 24 * MiB, WS_WOSB = 26 * MiB;
constexpr size_t WS_WDN = 28 * MiB, WS_WGU = 36 * MiB, WS_WEGU = 50 * MiB, WS_WEDN = 162 * MiB;
constexpr size_t WS_HB0 = 224 * MiB, WS_LAT = 288 * MiB, WS_CQ = 384 * MiB, WS_CKV = 416 * MiB, WS_KROT = 720 * MiB, WS_Q = 432 * MiB, WS_KV = 528 * MiB, WS_AO = 656 * MiB;
constexpr size_t WS_ACT = 288 * MiB;
constexpr size_t WS_HB1 = 288 * MiB, WS_KVSB = 352 * MiB, WS_QSB = 480 * MiB;
constexpr size_t WS_HS = 224 * MiB, WS_ACT2 = 356 * MiB, WS_Y = 224 * MiB;
constexpr size_t WS_END = 818 * MiB;
static_assert(WS_ACT2 + (size_t)MOE_ROWS * DFF * 2 <= WS_END && WS_HS + (size_t)MOE_ROWS * DM * 2 <= WS_ACT2 && WS_WEDN + (size_t)NEXP * DM * DFF * 2 <= WS_HB0, "d_ws map");
constexpr int CW_TMO = 0, CW_CODE = 1;
constexpr int CW_BAR = 4096;
constexpr int CW_CNT = 16384;
constexpr int CW_CHK = 20480;
constexpr int CW_TRQ = 24576;
constexpr int RING_OFF = 0, RING_BYTES = 131072;
constexpr int LDSCTL_OFF = RING_BYTES, MISC_OFF = LDSCTL_OFF + 320;
constexpr int LDS_BYTES = 147456;
static_assert(MISC_OFF + 128 <= LDS_BYTES && att::LDS_BYTES <= RING_BYTES, "LDS map");

#define GAS __attribute__((address_space(1)))
#define LAS __attribute__((address_space(3)))
typedef unsigned short bf16;
typedef unsigned v4u __attribute__((ext_vector_type(4)));
typedef unsigned v2u __attribute__((ext_vector_type(2)));
typedef float f32x4 __attribute__((ext_vector_type(4)));
typedef float f32x2 __attribute__((ext_vector_type(2)));
typedef GAS unsigned gu32;
#define RLX_AGENT __ATOMIC_RELAXED, __HIP_MEMORY_SCOPE_AGENT
#define LDS_WAIT() asm volatile("s_waitcnt lgkmcnt(0)" ::: "memory")
#define VM_WAIT() asm volatile("s_waitcnt vmcnt(0)" ::: "memory")
__device__ __forceinline__ unsigned f2bf(float f) { unsigned u = __builtin_bit_cast(unsigned, f); return (u + 0x7fffu + ((u >> 16) & 1u)) >> 16; }
__device__ __forceinline__ unsigned pk2(float lo, float hi) { return f2bf(lo) | (f2bf(hi) << 16); }
__device__ __forceinline__ float bf2f(unsigned short h) { return __builtin_bit_cast(float, (unsigned)h << 16); }


#define XB_TMO      128
#define XB_XCNT(j)  (256  + 64 * (j))
#define XB_XSUB(j)  (1280 + 64 * (j))
#define XB_XGEN(j)  (2304 + 64 * (j))
#define XB_TOP      3328
#define XB_TOPGEN   3392
#define XCD_BAR_WORDS 3456
#define XB_SPIN_CAP (1u << 18)

__device__ __forceinline__ unsigned xb_ld(unsigned* p)              { return __hip_atomic_load(p, __ATOMIC_RELAXED, __HIP_MEMORY_SCOPE_AGENT); }
__device__ __forceinline__ unsigned xb_add(unsigned* p, unsigned v) { return __hip_atomic_fetch_add(p, v, __ATOMIC_RELAXED, __HIP_MEMORY_SCOPE_AGENT); }
__device__ __forceinline__ unsigned xb_xcc_id() { return (unsigned)__builtin_amdgcn_s_getreg((3 << 11) | 20) & 0xFu; }
#define XB_SPIN(cond, bar) do { unsigned _sp = 0; while (cond) { __builtin_amdgcn_s_sleep(1); \
    if ((++_sp & 255u) == 0u) { if (xb_ld(&(bar)[XB_TMO])) break; if (_sp > XB_SPIN_CAP) { atomicAdd(&(bar)[XB_TMO], 1u); break; } } } } while (0)

struct XcdBarrier {
    unsigned* bar; unsigned x;
    volatile LAS unsigned* st;
};

__device__ __forceinline__ XcdBarrier xcd_barrier_post(unsigned* bar, volatile LAS unsigned* st) {
    XcdBarrier b; b.bar = bar; b.x = xb_xcc_id(); b.st = st;
    if (threadIdx.x == 0) (void)xb_add(&bar[XB_XCNT(b.x)], 1u);
    return b;
}
__device__ __forceinline__ void xcd_barrier_complete(unsigned* bar, unsigned x, unsigned& nloc, unsigned& nx) {
    const unsigned G = gridDim.x * gridDim.y * gridDim.z;
    unsigned sum, cnt, mine, sp = 0u;
    for (;;) {
        sum = 0u; cnt = 0u; mine = 0u;
#pragma unroll
        for (unsigned j = 0; j < 16; ++j) { const unsigned c = xb_ld(&bar[XB_XCNT(j)]); sum += c; cnt += (c > 0u) ? 1u : 0u; mine = (j == x) ? c : mine; }
        if (sum == G) break;
        __builtin_amdgcn_s_sleep(1);
        if ((++sp & 255u) == 0u) { if (xb_ld(&bar[XB_TMO])) break; if (sp > XB_SPIN_CAP) { atomicAdd(&bar[XB_TMO], 1u); break; } }
    }
    nloc = mine > 0u ? mine : 1u; nx = cnt > 0u ? cnt : 1u;
}

__device__ __forceinline__ void xcd_barrier(const XcdBarrier& b) {
    asm volatile("s_waitcnt vmcnt(0)" ::: "memory");
    __syncthreads();
    if (threadIdx.x == 0) {
        unsigned* bar = b.bar;
        __builtin_amdgcn_s_waitcnt(0);
        unsigned nloc = b.st[0], nx = b.st[1];
        if (nloc == 0u) { xcd_barrier_complete(bar, b.x, nloc, nx); b.st[0] = nloc; b.st[1] = nx; }
        const unsigned old = xb_add(&bar[XB_XSUB(b.x)], 1u);
        const unsigned gen = old / nloc;
        if (old + 1u == (gen + 1u) * nloc) {
            __builtin_amdgcn_fence(__ATOMIC_RELEASE, "agent");
            asm volatile("s_waitcnt vmcnt(0)" ::: "memory");
            const unsigned og = xb_add(&bar[XB_TOP], 1u);
            const unsigned tg = og / nx;
            if (og + 1u == (tg + 1u) * nx) xb_add(&bar[XB_TOPGEN], 1u);
            else XB_SPIN(xb_ld(&bar[XB_TOPGEN]) == tg, bar);
            __builtin_amdgcn_fence(__ATOMIC_ACQUIRE, "agent");
            xb_add(&bar[XB_XGEN(b.x)], 1u);
            asm volatile("s_waitcnt vmcnt(0)" ::: "memory");
        } else {
            XB_SPIN(xb_ld(&bar[XB_XGEN(b.x)]) == gen, bar);
            __builtin_amdgcn_fence(__ATOMIC_ACQUIRE, "agent");
            asm volatile("s_waitcnt vmcnt(0)" ::: "memory");
        }
    }
    __syncthreads();
}


struct Frame {
    LAS unsigned char* lds;
    volatile LAS unsigned* MISC;
    gu32* ctl;
    int tid, lane, wave;
    int vcu, G;
    unsigned char* ws;
};
struct Args { const float* in[26]; float* out; unsigned char* ws; float inv[32]; int ph_lo, ph_hi, li, pad; };

__device__ __forceinline__ float wave_sum(float v) {
#pragma unroll
    for (int o = 1; o < 64; o <<= 1) v += __shfl_xor(v, o);
    return v;
}
__device__ __forceinline__ int rope_src(int p) { const int g = p >> 3, jj = p & 7; return jj < 4 ? 4 * g + jj : 32 + 4 * g + (jj - 4); }
__device__ __forceinline__ int src_col(int kind, int rho) {
    if (kind == 1) return rho < 640 ? rho : (rho < 704 ? 640 + rope_src(rho - 640) : -1);
    if (kind == 2) { if (rho < 1024) return (rho >> 7) * 192 + (rho & 127); const int r = rho - 1024; return (r >> 6) * 192 + 128 + rope_src(r & 63); }
    if (kind == 3) { const int t = rho >> 8, r = rho & 255; return r < 128 ? t * 128 + r : DFF + t * 128 + (r - 128); }
    return rho;
}
struct TrItem { f32x4 v[16]; };
__device__ __forceinline__ void tr_load(TrItem& t, const float* W, int K, int N, int kind, int item, int nblk, int lane) {
    const int kb = item / nblk, nb = item % nblk, k0 = 64 * kb, n0 = 64 * nb, kq = lane >> 4, nq = lane & 15;
    const int sc = src_col(kind, n0 + 4 * nq);
#pragma unroll
    for (int i = 0; i < 8; ++i) { const int k = k0 + 8 * i + 2 * kq;
        const bool ok = sc >= 0 && k < K;
        t.v[2 * i] = ok ? *(const f32x4*)(W + (size_t)k * N + sc) : (f32x4){0.f, 0.f, 0.f, 0.f};
        t.v[2 * i + 1] = ok ? *(const f32x4*)(W + (size_t)(k + 1) * N + sc) : (f32x4){0.f, 0.f, 0.f, 0.f}; }
}
__device__ __forceinline__ void tr_store(const TrItem& t, bf16* WT, int Kd, LAS unsigned* T, int item, int nblk, int lane) {
    const int kb = item / nblk, nb = item % nblk, k0 = 64 * kb, n0 = 64 * nb, kq = lane >> 4, nq = lane & 15;
#pragma unroll
    for (int i = 0; i < 8; ++i) { const f32x4 a = t.v[2 * i], b = t.v[2 * i + 1]; LAS unsigned* p = T + (4 * nq) * 33 + 4 * i + kq;
        p[0] = pg8::cvt_pk_bf16(a.x, b.x); p[33] = pg8::cvt_pk_bf16(a.y, b.y); p[66] = pg8::cvt_pk_bf16(a.z, b.z); p[99] = pg8::cvt_pk_bf16(a.w, b.w); }
    LDS_WAIT(); asm volatile("" ::: "memory");
    const int c = lane & 7, nl = lane >> 3;
#pragma unroll
    for (int j = 0; j < 8; ++j) { const int n = nl + 8 * j; const LAS unsigned* s = T + n * 33 + 4 * c;
        v4u o; o.x = s[0]; o.y = s[1]; o.z = s[2]; o.w = s[3];
        *(GAS v4u*)(WT + (size_t)(n0 + n) * Kd + k0 + 8 * c) = o; }
    LDS_WAIT(); asm volatile("" ::: "memory");
}
struct TrDesc { const float* W; bf16* WT; int K, N, Kd, kind, nblk; };
constexpr int TR_NITEMS = NEXP * (DM / 64) * (NGU / 64) + NEXP * (DFF / 64) * (DM / 64) + (DM / 64) * (NGU / 64) + (DFF / 64) * (DM / 64) + (DM / 64) * (NLATP / 64) + (QLP / 64) * (NQ / 64) + (KVLORA / 64) * (NKV / 64) + 3 * (DM / 64) * (DM / 64) + (DM / 64) * (2048 / 64);
__device__ __forceinline__ bool tr_decode(Frame& F, const Args& a, int it, TrDesc& d, int& r) {
    constexpr int I_EGU = (DM / 64) * (NGU / 64), I_EDN = (DFF / 64) * (DM / 64);
    constexpr int I_GU = I_EGU, I_DN = I_EDN, I_AD = (DM / 64) * (NLATP / 64), I_UQ = (QLP / 64) * (NQ / 64), I_UKV = (KVLORA / 64) * (NKV / 64);
    constexpr int I_SQ = (DM / 64) * (DM / 64), I_KVSB = (DM / 64) * (2048 / 64);
    constexpr int NITEMS = NEXP * I_EGU + NEXP * I_EDN + I_GU + I_DN + I_AD + I_UQ + I_UKV + 3 * I_SQ + I_KVSB;
    static_assert(NITEMS == TR_NITEMS, "item count"); if (it >= NITEMS) return false;
    r = it;
    if (r < NEXP * I_EGU) { const int e = r / I_EGU; r -= e * I_EGU; d = TrDesc{a.in[23] + (size_t)e * DM * NGU, (bf16*)(F.ws + WS_WEGU) + (size_t)e * NGU * DM, DM, NGU, DM, 3, NGU / 64}; return true; } r -= NEXP * I_EGU;
    if (r < NEXP * I_EDN) { const int e = r / I_EDN; r -= e * I_EDN; d = TrDesc{a.in[24] + (size_t)e * DFF * DM, (bf16*)(F.ws + WS_WEDN) + (size_t)e * DM * DFF, DFF, DM, DFF, 0, DM / 64}; return true; } r -= NEXP * I_EDN;
    if (r < I_GU) { d = TrDesc{a.in[19], (bf16*)(F.ws + WS_WGU), DM, NGU, DM, 3, NGU / 64}; return true; } r -= I_GU;
    if (r < I_DN) { d = TrDesc{a.in[20], (bf16*)(F.ws + WS_WDN), DFF, DM, DFF, 0, DM / 64}; return true; } r -= I_DN;
    if (r < I_AD) { d = TrDesc{a.in[7], (bf16*)(F.ws + WS_WAD), DM, NLAT, DM, 1, NLATP / 64}; return true; } r -= I_AD;
    if (r < I_UQ) { d = TrDesc{a.in[10], (bf16*)(F.ws + WS_WUQ), QLORA, NQ, QLP, 2, NQ / 64}; return true; } r -= I_UQ;
    if (r < I_UKV) { d = TrDesc{a.in[11], (bf16*)(F.ws + WS_WUKV), KVLORA, NKV, KVLORA, 0, NKV / 64}; return true; } r -= I_UKV;
    if (r < I_SQ) { d = TrDesc{a.in[12], (bf16*)(F.ws + WS_WOA), DM, DM, DM, 0, DM / 64}; return true; } r -= I_SQ;
    if (r < I_SQ) { d = TrDesc{a.in[17], (bf16*)(F.ws + WS_WQSB), DM, DM, DM, 0, DM / 64}; return true; } r -= I_SQ;
    if (r < I_SQ) { d = TrDesc{a.in[18], (bf16*)(F.ws + WS_WOSB), DM, DM, DM, 0, DM / 64}; return true; } r -= I_SQ;
    d = TrDesc{a.in[16], (bf16*)(F.ws + WS_WKVSB), DM, 2048, DM, 0, 2048 / 64}; return true;
}

__device__ __forceinline__ void p0_prologue(Frame& F, const Args& a) {
    {
        LAS float* sl = (LAS float*)(F.lds + RING_OFF);
        LAS float* red = (LAS float*)(F.lds + RING_OFF + 32768);
        float* MOD = (float*)(F.ws + WS_MOD); float* MODKV = (float*)(F.ws + WS_MODKV);
        const int bxg = (int)blockIdx.x;
        if (bxg < 112) {
            for (int i = F.tid; i < 8192; i += NWAVES * 64) { const float c = a.in[1][i]; sl[i] = c / (1.0f + __expf(-c)); }
            __syncthreads();
        }
        for (int cg = bxg; cg < 112; cg += F.G) {
            const float* W; const float* bias; float* out; int ldw, ldo, col0;
            if (cg < 48) { W = a.in[3]; bias = a.in[4]; out = MOD; ldw = 6144; ldo = 6144; col0 = cg * 128; }
            else if (cg < 96) { W = a.in[3] + (size_t)DM * 6144; bias = a.in[4] + 6144; out = MOD + 8 * 6144; ldw = 6144; ldo = 6144; col0 = (cg - 48) * 128; }
            else { W = a.in[13]; bias = a.in[14]; out = MODKV; ldw = 2048; ldo = 2048; col0 = (cg - 96) * 128; }
            f32x4 acc[8];
#pragma unroll
            for (int b = 0; b < 8; ++b) acc[b] = (f32x4){0.f, 0.f, 0.f, 0.f};
            const int half = F.lane >> 5, l32 = F.lane & 31;
            const float* wp = W + (size_t)(F.wave * 128 + half) * ldw + col0 + 4 * l32;
            for (int k8 = 0; k8 < 64; k8 += 8) {
                f32x4 wv[8];
#pragma unroll
                for (int u = 0; u < 8; ++u) wv[u] = *(const f32x4*)(wp + (size_t)(2 * (k8 + u)) * ldw);
#pragma unroll
                for (int u = 0; u < 8; ++u) {
#pragma unroll
                    for (int b = 0; b < 8; ++b) { const float s = sl[b * 1024 + F.wave * 128 + 2 * (k8 + u) + half]; acc[b] += wv[u] * s; } }
            }
#pragma unroll
            for (int b = 0; b < 8; ++b) *(LAS f32x4*)(red + ((F.wave * 2 + half) * 8 + b) * 128 + 4 * l32) = acc[b];
            __syncthreads();
            for (int idx = F.tid; idx < 1024; idx += NWAVES * 64) { const int b = idx >> 7, col = idx & 127; float s = bias[col0 + col];
#pragma unroll
                for (int w = 0; w < 16; ++w) s += red[(w * 8 + b) * 128 + col];
                out[(size_t)b * ldo + col0 + col] = s; }
            __syncthreads();
        }
        __syncthreads();
    }
    {
        float* CS = (float*)(F.ws + WS_COS); const int* pos = (const int*)a.in[2];
        for (int idx = (F.vcu * NWAVES * 64) + F.tid; idx < NTOK * 32; idx += F.G * NWAVES * 64) {
            const int t = idx >> 5, i = idx & 31;
            const double rev = (double)pos[t] * (double)a.inv[i] * 0.15915494309189535;
            const float fr = (float)(rev - __builtin_rint(rev));
            CS[t * 64 + i] = __builtin_amdgcn_cosf(fr); CS[t * 64 + 32 + i] = __builtin_amdgcn_sinf(fr);
        }
    }
    {
        LAS unsigned* T = (LAS unsigned*)(F.lds + RING_OFF + F.wave * 8448);
        const int q0 = (int)(xb_xcc_id() & 7u);
        int qd = 0;
        TrItem cur, nxt; TrDesc dc, dn; int rc = 0, rn = 0;
#define TR_NEXT(itv) do { itv = -1; while (qd < 8) { const int qq_ = (q0 + qd) & 7; gu32* head_ = F.ctl + CW_TRQ + 64 * qq_; const int nq_ = (TR_NITEMS - qq_ + 7) >> 3; \
            int c_ = nq_; if (qd == 0 || (int)__hip_atomic_load(head_, RLX_AGENT) < nq_) { c_ = 0; if (F.lane == 0) c_ = (int)__hip_atomic_fetch_add(head_, 1u, RLX_AGENT); c_ = __builtin_amdgcn_readfirstlane(c_); } \
            if (c_ < nq_) { itv = c_ * 8 + qq_; break; } ++qd; } } while (0)
        int it; TR_NEXT(it);
        bool have = it >= 0 && tr_decode(F, a, it, dc, rc);
        if (have) tr_load(cur, dc.W, dc.K, dc.N, dc.kind, rc, dc.nblk, F.lane);
        while (have) {
            int itn; TR_NEXT(itn);
            const bool haven = itn >= 0 && tr_decode(F, a, itn, dn, rn);
            if (haven) tr_load(nxt, dn.W, dn.K, dn.N, dn.kind, rn, dn.nblk, F.lane);
            tr_store(cur, dc.WT, dc.Kd, T, rc, dc.nblk, F.lane);
            cur = nxt; dc = dn; rc = rn; have = haven;
        }
#undef TR_NEXT
    }
    __syncthreads();
}

template <bool TWO>
__device__ __forceinline__ void norm_phase(Frame& F, const float* X, const float* g0, const float* sc0, const float* sh0, int st0, bf16* H0,
                                           const float* g1, const float* sc1, const float* sh1, int st1, bf16* H1) {
    const int gw = F.vcu * NWAVES + F.wave, NGW = F.G * NWAVES;
    for (int c = gw; c < NTOK / 16; c += NGW) {
        const int row0 = c * 16, b = row0 / SEQ;
        f32x4 A0[4], B0[4], A1[4], B1[4];
#pragma unroll
        for (int j = 0; j < 4; ++j) { const int col = 4 * F.lane + 256 * j;
            A0[j] = *(const f32x4*)(g0 + col) * (*(const f32x4*)(sc0 + (size_t)b * st0 + col) + 1.0f); B0[j] = *(const f32x4*)(sh0 + (size_t)b * st0 + col);
            if (TWO) { A1[j] = *(const f32x4*)(g1 + col) * (*(const f32x4*)(sc1 + (size_t)b * st1 + col) + 1.0f); B1[j] = *(const f32x4*)(sh1 + (size_t)b * st1 + col); } }
#pragma unroll 2
        for (int r = 0; r < 16; ++r) {
            const GAS f32x4* xr = (const GAS f32x4*)(X + (size_t)(row0 + r) * DM) + F.lane;
            f32x4 v[4]; float s2 = 0.f;
#pragma unroll
            for (int j = 0; j < 4; ++j) { v[j] = xr[64 * j]; s2 += (v[j].x * v[j].x + v[j].y * v[j].y) + (v[j].z * v[j].z + v[j].w * v[j].w); }
            const float rstd = 1.0f / sqrtf(wave_sum(s2) * (1.0f / DM) + EPSN);
            GAS unsigned long long* o0 = (GAS unsigned long long*)(H0 + (size_t)(row0 + r) * DM) + F.lane;
#pragma unroll
            for (int j = 0; j < 4; ++j) { const f32x4 y = v[j] * rstd * A0[j] + B0[j]; o0[64 * j] = (unsigned long long)pk2(y.x, y.y) | ((unsigned long long)pk2(y.z, y.w) << 32); }
            if (TWO) { GAS unsigned long long* o1 = (GAS unsigned long long*)(H1 + (size_t)(row0 + r) * DM) + F.lane;
#pragma unroll
                for (int j = 0; j < 4; ++j) { const f32x4 y = v[j] * rstd * A1[j] + B1[j]; o1[64 * j] = (unsigned long long)pk2(y.x, y.y) | ((unsigned long long)pk2(y.z, y.w) << 32); } }
        }
    }
}

__device__ __forceinline__ void lat_phase(Frame& F, const Args& a) {
    const int gw = F.vcu * NWAVES + F.wave, NGW = F.G * NWAVES, l = F.lane;
    const float* LAT = (const float*)(F.ws + WS_LAT); const float* CS = (const float*)(F.ws + WS_COS);
    bf16* CQ = (bf16*)(F.ws + WS_CQ); bf16* CKV = (bf16*)(F.ws + WS_CKV); bf16* KR = (bf16*)(F.ws + WS_KROT);
    const f32x4 G0 = *(const f32x4*)(a.in[8] + 4 * l);
    const f32x4 G1 = l < 32 ? *(const f32x4*)(a.in[8] + 256 + 4 * l) : *(const f32x4*)(a.in[9] + 4 * (l - 32));
    const f32x4 G2 = l < 32 ? *(const f32x4*)(a.in[9] + 128 + 4 * l) : (f32x4){0.f, 0.f, 0.f, 0.f};
    for (int row = gw; row < NTOK; row += NGW) {
        const GAS f32x4* xr = (const GAS f32x4*)(LAT + (size_t)row * NLATP) + l;
        const f32x4 v0 = xr[0], v1 = xr[64], v2 = xr[128];
        const float q0 = (v0.x * v0.x + v0.y * v0.y) + (v0.z * v0.z + v0.w * v0.w), q1 = (v1.x * v1.x + v1.y * v1.y) + (v1.z * v1.z + v1.w * v1.w), q2 = (v2.x * v2.x + v2.y * v2.y) + (v2.z * v2.z + v2.w * v2.w);
        const float sq = wave_sum(q0 + (l < 32 ? q1 : 0.f)), skv = wave_sum((l < 32 ? q2 : q1));
        const float rq = 1.0f / sqrtf(sq * (1.0f / QLORA) + EPSN), rkv = 1.0f / sqrtf(skv * (1.0f / KVLORA) + EPSN);
        { const f32x4 y = v0 * rq * G0; *(GAS unsigned long long*)(CQ + (size_t)row * QLP + 4 * l) = (unsigned long long)pk2(y.x, y.y) | ((unsigned long long)pk2(y.z, y.w) << 32); }
        { const f32x4 y = v1 * (l < 32 ? rq : rkv) * G1; bf16* dst = l < 32 ? CQ + (size_t)row * QLP + 256 + 4 * l : CKV + (size_t)row * KVLORA + 4 * (l - 32);
          *(GAS unsigned long long*)dst = (unsigned long long)pk2(y.x, y.y) | ((unsigned long long)pk2(y.z, y.w) << 32); }
        const int u = l - 32, g = (u >> 1) & 7;
        f32x4 pr; pr.x = __shfl_xor(v2.x, 1); pr.y = __shfl_xor(v2.y, 1); pr.z = __shfl_xor(v2.z, 1); pr.w = __shfl_xor(v2.w, 1);
        if (l < 32) { const f32x4 y = v2 * rkv * G2; *(GAS unsigned long long*)(CKV + (size_t)row * KVLORA + 128 + 4 * l) = (unsigned long long)pk2(y.x, y.y) | ((unsigned long long)pk2(y.z, y.w) << 32); }
        else { *(GAS unsigned long long*)(CQ + (size_t)row * QLP + QLORA + 4 * (l - 32)) = 0ull; }
        if (l >= 32 && l < 48) { const f32x4 cs = *(const f32x4*)(CS + (size_t)row * 64 + 4 * g), sn = *(const f32x4*)(CS + (size_t)row * 64 + 32 + 4 * g);
            const f32x4 y = (u & 1) ? (pr * sn + v2 * cs) : (v2 * cs - pr * sn);
            *(GAS unsigned long long*)(KR + (size_t)row * ROPE + 4 * u) = (unsigned long long)pk2(y.x, y.y) | ((unsigned long long)pk2(y.z, y.w) << 32); }
    }
}


__device__ __forceinline__ void router_phase(Frame& F, const Args& a) {
    const int gw = F.vcu * NWAVES + F.wave, NGW = F.G * NWAVES, l = F.lane;
    const float* X = a.out; const float* MOD1 = (const float*)(F.ws + WS_MOD) + 8 * 6144;
    int* RT_E = (int*)(F.ws + WS_RT_E); int* RT_POS = (int*)(F.ws + WS_RT_POS); float* RT_W = (float*)(F.ws + WS_RT_W);
    f32x4 wr[4][4][2];
#pragma unroll
    for (int j = 0; j < 4; ++j)
#pragma unroll
        for (int i = 0; i < 4; ++i) { const float* p = a.in[21] + (size_t)(4 * l + 256 * j + i) * 8; wr[j][i][0] = *(const f32x4*)p; wr[j][i][1] = *(const f32x4*)(p + 4); }
    float br[8];
#pragma unroll
    for (int e = 0; e < 8; ++e) br[e] = a.in[22][e];
    for (int c = gw; c < NTOK / 16; c += NGW) {
        const int row0 = c * 16, b = row0 / SEQ;
        f32x4 A0[4], B0[4];
#pragma unroll
        for (int j = 0; j < 4; ++j) { const int col = 4 * l + 256 * j;
            A0[j] = *(const f32x4*)(a.in[6] + DM + col) * (*(const f32x4*)(MOD1 + (size_t)b * 6144 + 4096 + col) + 1.0f); B0[j] = *(const f32x4*)(MOD1 + (size_t)b * 6144 + 3072 + col); }
        int my_e1 = 0, my_e2 = 0; float my_w1 = 0.f, my_w2 = 0.f;
        for (int r = 0; r < 16; ++r) {
            const GAS f32x4* xr = (const GAS f32x4*)(X + (size_t)(row0 + r) * DM) + l;
            f32x4 v[4]; float s2 = 0.f;
#pragma unroll
            for (int j = 0; j < 4; ++j) { v[j] = xr[64 * j]; s2 += (v[j].x * v[j].x + v[j].y * v[j].y) + (v[j].z * v[j].z + v[j].w * v[j].w); }
            const float rstd = 1.0f / sqrtf(wave_sum(s2) * (1.0f / DM) + EPSN);
            f32x4 lo = (f32x4){0.f, 0.f, 0.f, 0.f}, hi = (f32x4){0.f, 0.f, 0.f, 0.f};
#pragma unroll
            for (int j = 0; j < 4; ++j) { const f32x4 y = v[j] * rstd * A0[j] + B0[j];
                lo += wr[j][0][0] * y.x + wr[j][1][0] * y.y + wr[j][2][0] * y.z + wr[j][3][0] * y.w;
                hi += wr[j][0][1] * y.x + wr[j][1][1] * y.y + wr[j][2][1] * y.z + wr[j][3][1] * y.w; }
            float lg[8];
            lg[0] = wave_sum(lo.x) + br[0]; lg[1] = wave_sum(lo.y) + br[1]; lg[2] = wave_sum(lo.z) + br[2]; lg[3] = wave_sum(lo.w) + br[3];
            lg[4] = wave_sum(hi.x) + br[4]; lg[5] = wave_sum(hi.y) + br[5]; lg[6] = wave_sum(hi.z) + br[6]; lg[7] = wave_sum(hi.w) + br[7];
            int e1 = 0; float v1 = lg[0];
#pragma unroll
            for (int e = 1; e < 8; ++e) if (lg[e] > v1) { v1 = lg[e]; e1 = e; }
            int e2 = -1; float v2 = -__builtin_inff();
#pragma unroll
            for (int e = 0; e < 8; ++e) if (e != e1 && lg[e] > v2) { v2 = lg[e]; e2 = e; }
            const float t = __expf(v2 - v1), w1 = 1.0f / (1.0f + t), w2 = t * w1;
            if (l == r) { my_e1 = e1; my_e2 = e2; my_w1 = w1; my_w2 = w2; }
        }
        const int E1 = __shfl(my_e1, l & 15), E2 = __shfl(my_e2, l & 15); const float W1 = __shfl(my_w1, l & 15), W2 = __shfl(my_w2, l & 15);
        const int myE = l < 16 ? E1 : (l < 32 ? E2 : -1); const float myW = l < 16 ? W1 : W2;
        int mypos = 0;
#pragma unroll
        for (int e = 0; e < 8; ++e) {
            const unsigned long long m = __ballot(myE == e); const int n = __popcll(m);
            unsigned base = 0;
            if (n > 0 && l == 0) base = __hip_atomic_fetch_add((unsigned*)(F.ctl + CW_CNT + 16 * e), (unsigned)n, RLX_AGENT);
            base = (unsigned)__builtin_amdgcn_readfirstlane((int)base);
            if (myE == e) mypos = (int)base + __popcll(m & ((1ull << l) - 1ull));
        }
        if (l < 32) { const int idx = (row0 + (l & 15)) * 2 + (l >> 4); RT_E[idx] = myE; RT_POS[idx] = mypos; RT_W[idx] = myW; }
    }
}
__device__ __forceinline__ void moe_offsets(Frame& F, unsigned (&cnt)[8], int (&off)[8]) {
    int t = 0;
#pragma unroll
    for (int e = 0; e < 8; ++e) { cnt[e] = __hip_atomic_load((unsigned*)(F.ctl + CW_CNT + 16 * e), RLX_AGENT); off[e] = t; t += (int)((cnt[e] + 255u) & ~255u); }
}
__device__ __forceinline__ void scatter_phase(Frame& F, const Args& a) {
    const int gw = F.vcu * NWAVES + F.wave, NGW = F.G * NWAVES, l = F.lane;
    const float* X = a.out; const float* MOD1 = (const float*)(F.ws + WS_MOD) + 8 * 6144;
    const int* RT_E = (const int*)(F.ws + WS_RT_E); const int* RT_POS = (const int*)(F.ws + WS_RT_POS);
    bf16* HS = (bf16*)(F.ws + WS_HS);
    unsigned cnt[8]; int off[8]; moe_offsets(F, cnt, off);
    for (int c = gw; c < NTOK / 16; c += NGW) {
        const int row0 = c * 16, b = row0 / SEQ;
        f32x4 A0[4], B0[4];
#pragma unroll
        for (int j = 0; j < 4; ++j) { const int col = 4 * l + 256 * j;
            A0[j] = *(const f32x4*)(a.in[6] + DM + col) * (*(const f32x4*)(MOD1 + (size_t)b * 6144 + 4096 + col) + 1.0f); B0[j] = *(const f32x4*)(MOD1 + (size_t)b * 6144 + 3072 + col); }
#pragma unroll 2
        for (int r = 0; r < 16; ++r) {
            const int row = row0 + r;
            const GAS f32x4* xr = (const GAS f32x4*)(X + (size_t)row * DM) + l;
            f32x4 v[4]; float s2 = 0.f;
#pragma unroll
            for (int j = 0; j < 4; ++j) { v[j] = xr[64 * j]; s2 += (v[j].x * v[j].x + v[j].y * v[j].y) + (v[j].z * v[j].z + v[j].w * v[j].w); }
            const float rstd = 1.0f / sqrtf(wave_sum(s2) * (1.0f / DM) + EPSN);
            const int e1 = RT_E[row * 2], e2 = RT_E[row * 2 + 1], p1 = RT_POS[row * 2], p2 = RT_POS[row * 2 + 1];
            int o1 = 0, o2 = 0;
#pragma unroll
            for (int e = 0; e < 8; ++e) { o1 = (e1 == e) ? off[e] : o1; o2 = (e2 == e) ? off[e] : o2; }
            GAS unsigned long long* d1 = (GAS unsigned long long*)(HS + (size_t)(o1 + p1) * DM) + l; GAS unsigned long long* d2 = (GAS unsigned long long*)(HS + (size_t)(o2 + p2) * DM) + l;
#pragma unroll
            for (int j = 0; j < 4; ++j) { const f32x4 y = v[j] * rstd * A0[j] + B0[j]; const unsigned long long w = (unsigned long long)pk2(y.x, y.y) | ((unsigned long long)pk2(y.z, y.w) << 32); d1[64 * j] = w; d2[64 * j] = w; }
        }
    }
    for (int i = gw; i < 8 * 256; i += NGW) { const int e = i >> 8, r = i & 255; int oe = 0; unsigned ce = 0;
#pragma unroll
        for (int q = 0; q < 8; ++q) { oe = (e == q) ? off[q] : oe; ce = (e == q) ? cnt[q] : ce; }
        if (ce + (unsigned)r < ((ce + 255u) & ~255u)) { GAS unsigned long long* d = (GAS unsigned long long*)(HS + (size_t)(oe + (int)ce + r) * DM) + l;
#pragma unroll
            for (int j = 0; j < 4; ++j) d[64 * j] = 0ull; } }
}
__device__ __forceinline__ void final_phase(Frame& F, const Args& a) {
    const int gw = F.vcu * NWAVES + F.wave, NGW = F.G * NWAVES, l = F.lane;
    float* X = a.out; const float* MOD1 = (const float*)(F.ws + WS_MOD) + 8 * 6144;
    const int* RT_E = (const int*)(F.ws + WS_RT_E); const int* RT_POS = (const int*)(F.ws + WS_RT_POS); const float* RT_W = (const float*)(F.ws + WS_RT_W);
    const bf16* Y = (const bf16*)(F.ws + WS_Y);
    unsigned cnt[8]; int off[8]; moe_offsets(F, cnt, off);
    for (int c = gw; c < NTOK / 16; c += NGW) {
        const int row0 = c * 16, b = row0 / SEQ;
        f32x4 GT[4], GF[4];
#pragma unroll
        for (int j = 0; j < 4; ++j) { const int col = 4 * l + 256 * j; GT[j] = *(const f32x4*)(MOD1 + (size_t)b * 6144 + 5120 + col); GF[j] = *(const f32x4*)(a.in[25] + col); }
#pragma unroll 2
        for (int r = 0; r < 16; ++r) {
            const int row = row0 + r;
            GAS f32x4* xr = (GAS f32x4*)(X + (size_t)row * DM) + l;
            const int e1 = RT_E[row * 2], e2 = RT_E[row * 2 + 1], p1 = RT_POS[row * 2], p2 = RT_POS[row * 2 + 1]; const float w1 = RT_W[row * 2], w2 = RT_W[row * 2 + 1];
            int o1 = 0, o2 = 0;
#pragma unroll
            for (int e = 0; e < 8; ++e) { o1 = (e1 == e) ? off[e] : o1; o2 = (e2 == e) ? off[e] : o2; }
            const GAS v2u* y1 = (const GAS v2u*)(Y + (size_t)(o1 + p1) * DM) + l; const GAS v2u* y2 = (const GAS v2u*)(Y + (size_t)(o2 + p2) * DM) + l;
            f32x4 v[4]; float s2 = 0.f;
#pragma unroll
            for (int j = 0; j < 4; ++j) { const v2u a1 = y1[64 * j], a2 = y2[64 * j];
                f32x4 f; f.x = w1 * __uint_as_float(a1.x << 16) + w2 * __uint_as_float(a2.x << 16); f.y = w1 * __uint_as_float(a1.x & 0xffff0000u) + w2 * __uint_as_float(a2.x & 0xffff0000u);
                f.z = w1 * __uint_as_float(a1.y << 16) + w2 * __uint_as_float(a2.y << 16); f.w = w1 * __uint_as_float(a1.y & 0xffff0000u) + w2 * __uint_as_float(a2.y & 0xffff0000u);
                v[j] = xr[64 * j] + GT[j] * f; s2 += (v[j].x * v[j].x + v[j].y * v[j].y) + (v[j].z * v[j].z + v[j].w * v[j].w); }
            const float rstd = 1.0f / sqrtf(wave_sum(s2) * (1.0f / DM) + EPSN);
#pragma unroll
            for (int j = 0; j < 4; ++j) xr[64 * j] = v[j] * rstd * GF[j];
        }
    }
}
template <int MODE>
__device__ __forceinline__ void attn_phase(Frame& F, const bf16* Q, const bf16* KV, const bf16* KR, bf16* O) {
    for (int w = 0; ; ++w) {
        const int it = F.vcu + (w >> 1) * F.G; if (it >= BATCH * NHEAD * 8) break;
        const int bh = it >> 3, s = it & 7, b = bh >> 3, h = bh & 7;
        att::attn_unit<MODE>(b, h, (w & 1) ? s : 15 - s, Q, KV, KR, O, (LAS char*)(F.lds + RING_OFF));
    }
}


constexpr int NPH = 19;
#ifndef MK_DUP_MASK
#define MK_DUP_MASK 0
#endif
#ifndef MK_PHMASK
#define MK_PHMASK 0x7ffff
#endif
__global__ void __launch_bounds__(NWAVES * 64, 2) yoco_fwd(Args args) {
    extern __shared__ __attribute__((aligned(16))) unsigned char lds[];
    Frame F;
    F.lds = (LAS unsigned char*)lds;
    F.MISC = (volatile LAS unsigned*)(F.lds + MISC_OFF);
    F.tid = threadIdx.x; F.lane = F.tid & 63; F.wave = __builtin_amdgcn_readfirstlane(F.tid >> 6);
    F.G = gridDim.x; { const int bx = blockIdx.x; F.vcu = (F.G % 8 == 0) ? (bx % 8) * (F.G / 8) + bx / 8 : bx; }
    F.ws = args.ws; F.ctl = (gu32*)(args.ws + WS_CTL);
    for (int u = F.tid; u < (LDS_BYTES - LDSCTL_OFF) / 4; u += NWAVES * 64) ((LAS unsigned*)(F.lds + LDSCTL_OFF))[u] = 0u;
    __syncthreads();
    XcdBarrier bar; bar.bar = (unsigned*)(F.ctl + CW_BAR); bar.x = 0; bar.st = nullptr;
    if (!MK_PER_PHASE) bar = xcd_barrier_post((unsigned*)(F.ctl + CW_BAR), F.MISC + 8);
#define GRID_BAR(seam) do { if (MK_PER_PHASE) { if (F.tid == 0) __hip_atomic_store(F.ctl + CW_TMO, 0xBADBA0u | (unsigned)(seam), RLX_AGENT); } else { xcd_barrier(bar); } } while (0)
    const int lo = args.ph_lo, hi = args.ph_hi;
#define IN(k) ((((unsigned)MK_PHMASK >> (k)) & 1u) && lo <= (k) && (k) < hi)
#define REFRESH() do { int t_ = threadIdx.x; asm volatile("" : "+v"(t_)); F.tid = t_; F.lane = t_ & 63; F.wave = __builtin_amdgcn_readfirstlane(t_ >> 6); } while (0)
#define SEAM(k) do { if (IN(k) && IN((k) + 1)) GRID_BAR(k); } while (0)
    unsigned char* ws = args.ws;
    float* XS = args.out;
    const float* MOD0 = (const float*)(ws + WS_MOD); const float* MOD1 = MOD0 + 8 * 6144; const float* MODKV = (const float*)(ws + WS_MODKV);
    bf16* HB0 = (bf16*)(ws + WS_HB0); bf16* HB1 = (bf16*)(ws + WS_HB1); bf16* AO = (bf16*)(ws + WS_AO);
    LAS unsigned char* ring = F.lds + RING_OFF;

    if (IN(0)) for (int rep_ = 0; rep_ < (((MK_DUP_MASK >> 0) & 1) ? 2 : 1); ++rep_) { REFRESH(); p0_prologue(F, args); } SEAM(0);
    if (IN(1)) for (int rep_ = 0; rep_ < (((MK_DUP_MASK >> 1) & 1) ? 2 : 1); ++rep_) { REFRESH(); norm_phase<false>(F, args.in[0], args.in[5], MOD0 + 1024, MOD0, 6144, HB0, nullptr, nullptr, nullptr, 0, nullptr); } SEAM(1);
    if (IN(2)) for (int rep_ = 0; rep_ < (((MK_DUP_MASK >> 2) & 1) ? 2 : 1); ++rep_) { REFRESH(); pg8::Gemm g{HB0, (const bf16*)(ws + WS_WAD), NTOK, NLATP, DM, 0}; pg8::StaticOrder S; S.init(NTOK, NLATP, F.G, (int)blockIdx.x);
        pg8::EpiF32 E{(float*)(ws + WS_LAT), NLATP}; pg8::gemm_phase<pg8::EpiF32, pg8::StaticOrder, true, true>(ring, g, S, E); } SEAM(2);
    if (IN(3)) for (int rep_ = 0; rep_ < (((MK_DUP_MASK >> 3) & 1) ? 2 : 1); ++rep_) { REFRESH(); lat_phase(F, args); } SEAM(3);
    if (IN(4)) for (int rep_ = 0; rep_ < (((MK_DUP_MASK >> 4) & 1) ? 2 : 1); ++rep_) { REFRESH();
        { pg8::Gemm g{(const bf16*)(ws + WS_CQ), (const bf16*)(ws + WS_WUQ), NTOK, 1024, QLP, 0}; pg8::StaticOrder S; S.init(NTOK, 1024, F.G, (int)blockIdx.x);
          pg8::EpiBf16 E{(bf16*)(ws + WS_Q), NQ, C2_MLA}; pg8::gemm_phase<pg8::EpiBf16, pg8::StaticOrder, true, true>(ring, g, S, E); }
        { pg8::Gemm g{(const bf16*)(ws + WS_CQ), (const bf16*)(ws + WS_WUQ) + (size_t)1024 * QLP, NTOK, 512, QLP, 0}; pg8::StaticOrder S; S.init(NTOK, 512, F.G, (int)blockIdx.x);
          pg8::EpiRope E{(bf16*)(ws + WS_Q) + 1024, NQ, C2_MLA, (const float*)(ws + WS_COS)}; pg8::gemm_phase<pg8::EpiRope, pg8::StaticOrder, true, true>(ring, g, S, E); }
        { pg8::Gemm g{(const bf16*)(ws + WS_CKV), (const bf16*)(ws + WS_WUKV), NTOK, NKV, KVLORA, 0}; pg8::StaticOrder S; S.init(NTOK, NKV, F.G, (int)blockIdx.x);
          pg8::EpiBf16 E{(bf16*)(ws + WS_KV), NKV, 1.0f}; pg8::gemm_phase<pg8::EpiBf16, pg8::StaticOrder, true, true>(ring, g, S, E); }
    } SEAM(4);
    if (IN(5)) for (int rep_ = 0; rep_ < (((MK_DUP_MASK >> 5) & 1) ? 2 : 1); ++rep_) { REFRESH(); attn_phase<0>(F, (const bf16*)(ws + WS_Q), (const bf16*)(ws + WS_KV), (const bf16*)(ws + WS_KROT), AO); } SEAM(5);
    if (IN(6)) for (int rep_ = 0; rep_ < (((MK_DUP_MASK >> 6) & 1) ? 2 : 1); ++rep_) { REFRESH(); pg8::Gemm g{AO, (const bf16*)(ws + WS_WOA), NTOK, DM, DM, 0}; pg8::StaticOrder S; S.init(NTOK, DM, F.G, (int)blockIdx.x);
        pg8::EpiResid E{args.in[0], XS, MOD0 + 2048, 6144}; pg8::gemm_phase<pg8::EpiResid, pg8::StaticOrder, true, true>(ring, g, S, E); } SEAM(6);
    if (IN(7)) for (int rep_ = 0; rep_ < (((MK_DUP_MASK >> 7) & 1) ? 2 : 1); ++rep_) { REFRESH(); norm_phase<false>(F, XS, args.in[6], MOD0 + 4096, MOD0 + 3072, 6144, HB0, nullptr, nullptr, nullptr, 0, nullptr); } SEAM(7);
    if (IN(8)) for (int rep_ = 0; rep_ < (((MK_DUP_MASK >> 8) & 1) ? 2 : 1); ++rep_) { REFRESH(); pg8::Gemm g{HB0, (const bf16*)(ws + WS_WGU), NTOK, NGU, DM, 0}; pg8::StaticOrder S; S.init(NTOK, NGU, F.G, (int)blockIdx.x);
        pg8::EpiSwiglu E{(bf16*)(ws + WS_ACT), DFF}; pg8::gemm_phase<pg8::EpiSwiglu, pg8::StaticOrder, true, true>(ring, g, S, E); } SEAM(8);
    if (IN(9)) for (int rep_ = 0; rep_ < (((MK_DUP_MASK >> 9) & 1) ? 2 : 1); ++rep_) { REFRESH(); pg8::Gemm g{(const bf16*)(ws + WS_ACT), (const bf16*)(ws + WS_WDN), NTOK, DM, DFF, 0}; pg8::StaticOrder S; S.init(NTOK, DM, F.G, (int)blockIdx.x);
        pg8::EpiResid E{XS, XS, MOD0 + 5120, 6144}; pg8::gemm_phase<pg8::EpiResid, pg8::StaticOrder, true, true>(ring, g, S, E); } SEAM(9);
    if (IN(10)) for (int rep_ = 0; rep_ < (((MK_DUP_MASK >> 10) & 1) ? 2 : 1); ++rep_) { REFRESH(); norm_phase<true>(F, XS, args.in[15], MODKV + 1024, MODKV, 2048, HB0, args.in[5] + DM, MOD1 + 1024, MOD1, 6144, HB1); } SEAM(10);
    if (IN(11)) for (int rep_ = 0; rep_ < (((MK_DUP_MASK >> 11) & 1) ? 2 : 1); ++rep_) { REFRESH();
        { pg8::Gemm g{HB0, (const bf16*)(ws + WS_WKVSB), NTOK, 2048, DM, 0}; pg8::StaticOrder S; S.init(NTOK, 2048, F.G, (int)blockIdx.x);
          pg8::EpiBf16 E{(bf16*)(ws + WS_KVSB), 2048, 1.0f}; pg8::gemm_phase<pg8::EpiBf16, pg8::StaticOrder, true, true>(ring, g, S, E); }
        { pg8::Gemm g{HB1, (const bf16*)(ws + WS_WQSB), NTOK, DM, DM, 0}; pg8::StaticOrder S; S.init(NTOK, DM, F.G, (int)blockIdx.x);
          pg8::EpiBf16 E{(bf16*)(ws + WS_QSB), DM, C2_SB}; pg8::gemm_phase<pg8::EpiBf16, pg8::StaticOrder, true, true>(ring, g, S, E); }
    } SEAM(11);
    if (IN(12)) for (int rep_ = 0; rep_ < (((MK_DUP_MASK >> 12) & 1) ? 2 : 1); ++rep_) { REFRESH(); attn_phase<1>(F, (const bf16*)(ws + WS_QSB), (const bf16*)(ws + WS_KVSB), nullptr, AO); } SEAM(12);
    if (IN(13)) for (int rep_ = 0; rep_ < (((MK_DUP_MASK >> 13) & 1) ? 2 : 1); ++rep_) { REFRESH(); pg8::Gemm g{AO, (const bf16*)(ws + WS_WOSB), NTOK, DM, DM, 0}; pg8::StaticOrder S; S.init(NTOK, DM, F.G, (int)blockIdx.x);
        pg8::EpiResid E{XS, XS, MOD1 + 2048, 6144}; pg8::gemm_phase<pg8::EpiResid, pg8::StaticOrder, true, true>(ring, g, S, E); } SEAM(13);
    if (IN(14)) for (int rep_ = 0; rep_ < (((MK_DUP_MASK >> 14) & 1) ? 2 : 1); ++rep_) { REFRESH(); router_phase(F, args); } SEAM(14);
    if (IN(15)) for (int rep_ = 0; rep_ < (((MK_DUP_MASK >> 15) & 1) ? 2 : 1); ++rep_) { REFRESH(); scatter_phase(F, args); } SEAM(15);
    if (IN(16)) for (int rep_ = 0; rep_ < (((MK_DUP_MASK >> 16) & 1) ? 2 : 1); ++rep_) { REFRESH(); unsigned cnt[8]; int off[8]; moe_offsets(F, cnt, off);
        pg8::Gemm g{(const bf16*)(ws + WS_HS), (const bf16*)(ws + WS_WEGU), 0, NGU, DM, (size_t)NGU * DM * 2}; pg8::MoeOrder S; S.init(cnt, NGU, F.G, (int)blockIdx.x);
        pg8::EpiSwiglu E{(bf16*)(ws + WS_ACT2), DFF}; pg8::gemm_phase<pg8::EpiSwiglu, pg8::MoeOrder, true, true>(ring, g, S, E); } SEAM(16);
    if (IN(17)) for (int rep_ = 0; rep_ < (((MK_DUP_MASK >> 17) & 1) ? 2 : 1); ++rep_) { REFRESH(); unsigned cnt[8]; int off[8]; moe_offsets(F, cnt, off);
        pg8::Gemm g{(const bf16*)(ws + WS_ACT2), (const bf16*)(ws + WS_WEDN), 0, DM, DFF, (size_t)DM * DFF * 2}; pg8::MoeOrder S; S.init(cnt, DM, F.G, (int)blockIdx.x);
        pg8::EpiBf16 E{(bf16*)(ws + WS_Y), DM, 1.0f}; pg8::gemm_phase<pg8::EpiBf16, pg8::MoeOrder, true, true>(ring, g, S, E); } SEAM(17);
    if (IN(18)) for (int rep_ = 0; rep_ < (((MK_DUP_MASK >> 18) & 1) ? 2 : 1); ++rep_) { REFRESH(); final_phase(F, args); }
#undef IN
#undef SEAM
#undef REFRESH
#undef GRID_BAR
}

extern "C" void kernel_launch(void* const* d_in, const int* in_sizes, int n_in, void* d_out, int out_size, void* d_ws, size_t ws_size, hipStream_t stream) {
    static int grid = 0;
    if (grid == 0) {
        if (n_in != 26 || in_sizes[0] != NTOK * DM || out_size != NTOK * DM || ws_size < WS_END) { fprintf(stderr, "kernel_launch: shape/workspace mismatch (n_in %d, in0 %d, out %d, ws %zu, need %zu)\n", n_in, n_in > 0 ? in_sizes[0] : -1, out_size, ws_size, (size_t)WS_END); grid = -1; return; }
        int dev = 0, cus = 0, per_cu = 0;
        if (hipGetDevice(&dev) != hipSuccess || hipDeviceGetAttribute(&cus, hipDeviceAttributeMultiprocessorCount, dev) != hipSuccess) { grid = -1; return; }
        if (hipFuncSetAttribute((const void*)yoco_fwd, hipFuncAttributeMaxDynamicSharedMemorySize, LDS_BYTES) != hipSuccess) { fprintf(stderr, "kernel_launch: hipFuncSetAttribute failed\n"); grid = -1; return; }
        if (hipOccupancyMaxActiveBlocksPerMultiprocessor(&per_cu, (const void*)yoco_fwd, NWAVES * 64, LDS_BYTES) != hipSuccess || per_cu < 1) { fprintf(stderr, "kernel_launch: occupancy query reports %d\n", per_cu); }
        (void)hipGetLastError();
        grid = cus;
    }
    if (grid < 0) return;
    if (hipMemsetAsync((char*)d_ws + WS_CTL, 0, CTL_ZERO_BYTES, stream) != hipSuccess) return;
    Args a{};
    for (int i = 0; i < 26; ++i) a.in[i] = (const float*)d_in[i];
    a.out = (float*)d_out; a.ws = (unsigned char*)d_ws;
    for (int i = 0; i < 32; ++i) a.inv[i] = (float)pow(10000.0, -(double)i / 32.0);
#if MK_PER_PHASE
    for (int p = 0; p < NPH; ++p) { a.ph_lo = p; a.ph_hi = p + 1; a.li = p; hipLaunchKernelGGL(yoco_fwd, dim3(grid), dim3(NWAVES * 64), LDS_BYTES, stream, a); }
#else
    a.ph_lo = 0; a.ph_hi = NPH; a.li = 0;
    hipLaunchKernelGGL(yoco_fwd, dim3(grid), dim3(NWAVES * 64), LDS_BYTES, stream, a);
#endif
    const hipError_t le = hipPeekAtLastError();
    if (le != hipSuccess) fprintf(stderr, "kernel_launch: launch failed: %s\n", hipGetErrorName(le));
}
```

```cpp
#include <hip/hip_runtime.h>
#include <cstdio>
#include <cstdint>
#include <cmath>
#ifndef MK_FORCE_S7
#define MK_FORCE_S7 0
#endif

namespace pg8 {
#define PG8_LAS __attribute__((address_space(3)))
typedef unsigned short bf16_t;
typedef short bf16x8 __attribute__((ext_vector_type(8)));
typedef float f32x4 __attribute__((ext_vector_type(4)));
typedef unsigned u32x4 __attribute__((ext_vector_type(4)));
constexpr int BM = 256, BK = 64, HALF = 128, HTB = HALF * BK * 2  , STAGE_BYTES = 8 * HTB, NXCD = 8, WGM = 4;

__host__ __device__ __forceinline__ int lds_byte(int r, int c) { const int st = (r >> 4) * 2 + (c >> 5), rr = r & 15, cc = c & 31, ob = rr * 64 + cc * 2; return st * 1024 + (ob ^ (((ob >> 9) & 1) << 5)); }
__host__ __device__ __forceinline__ void stage_rc(int b, int& R, int& C) { const int st = b / 1024, sb = b % 1024, swz = sb ^ (((sb >> 9) & 1) << 5); R = (st >> 1) * 16 + swz / 64; C = (st & 1) * 32 + (swz % 64) / 2; }
__host__ __device__ __forceinline__ int perm32(int rho) { const int n = rho >> 4, i = rho & 15; return 8 * (i >> 2) + 4 * n + (i & 3); }

struct Unit { int pm, pn, eb, k0; };
struct Gemm { const bf16_t* A; const bf16_t* Bt; int M, N, K; size_t bstride; int Kloop; };

struct StaticOrder {
    int nM, nN, nwg, G, c, wgm;
    __host__ __device__ void init(int M, int N, int G_, int c_, int wgm_ = WGM) { nM = M / BM; nN = N / BM; nwg = nM * nN; G = G_; c = c_; wgm = wgm_; }
    __host__ __device__ bool next(int i, Unit& u) const {
        const long L = (long)i * G + c; if (L >= nwg) return false;
        int wgid = (int)L; { const int q = nwg / NXCD, r = nwg % NXCD, xcd = wgid % NXCD, off = wgid / NXCD; wgid = (xcd < r ? xcd * (q + 1) : r * (q + 1) + (xcd - r) * q) + off; }
        const int nig = wgm * nN, gid = wgid / nig, fm = gid * wgm, gsz = (nM - fm) < wgm ? (nM - fm) : wgm;
        u.pm = fm + ((wgid % nig) % gsz); u.pn = (wgid % nig) / gsz; u.eb = 0; u.k0 = 0; return true;
    }
    __device__ __forceinline__ void a_ready(const Unit&) const {}
    __device__ __forceinline__ void done(const Unit&) const {}
};
struct MoeOrder {
    int nM, nN, nwg, G, c, wgm; int t1, t2, t3, t4, t5, t6, t7;
    __device__ __forceinline__ void init(const unsigned* cnt, int N, int G_, int c_, int maxtiles, int wgm_ = WGM) {
        int t = 0;
        t += (int)((cnt[0] + 255u) >> 8); t1 = t; t += (int)((cnt[1] + 255u) >> 8); t2 = t; t += (int)((cnt[2] + 255u) >> 8); t3 = t; t += (int)((cnt[3] + 255u) >> 8); t4 = t;
        t += (int)((cnt[4] + 255u) >> 8); t5 = t; t += (int)((cnt[5] + 255u) >> 8); t6 = t; t += (int)((cnt[6] + 255u) >> 8); t7 = t; t += (int)((cnt[7] + 255u) >> 8);
        nM = t < maxtiles ? t : maxtiles; nN = N / BM; nwg = nM * nN; G = G_; c = c_; wgm = wgm_; }
    __device__ __forceinline__ bool next(int i, Unit& u) const {
        const long L = (long)i * G + c; if (L >= nwg) return false;
        int wgid = (int)L; { const int q = nwg / NXCD, r = nwg % NXCD, xcd = wgid % NXCD, off = wgid / NXCD; wgid = (xcd < r ? xcd * (q + 1) : r * (q + 1) + (xcd - r) * q) + off; }
        const int nig = wgm * nN, gid = wgid / nig, fm = gid * wgm, gsz = (nM - fm) < wgm ? (nM - fm) : wgm;
        u.pm = fm + ((wgid % nig) % gsz); u.pn = (wgid % nig) / gsz;
        u.eb = (u.pm >= t1) + (u.pm >= t2) + (u.pm >= t3) + (u.pm >= t4) + (u.pm >= t5) + (u.pm >= t6) + (u.pm >= t7); u.k0 = 0; return true;
    }
    __device__ __forceinline__ void a_ready(const Unit&) const {}
    __device__ __forceinline__ void done(const Unit&) const {}
};

struct LeftOrder {
    int nitems, S, Kc, G, c, base; int t1, t2, t3, t4, t5, t6, t7;
    __device__ __forceinline__ void init(const unsigned* cnt, int K, int G_, int c_, int base_) {
        int t = 0;
        t += (int)((cnt[0] + 255u) >> 8); t1 = t; t += (int)((cnt[1] + 255u) >> 8); t2 = t; t += (int)((cnt[2] + 255u) >> 8); t3 = t; t += (int)((cnt[3] + 255u) >> 8); t4 = t;
        t += (int)((cnt[4] + 255u) >> 8); t5 = t; t += (int)((cnt[5] + 255u) >> 8); t6 = t; t += (int)((cnt[6] + 255u) >> 8); t7 = t; t += (int)((cnt[7] + 255u) >> 8);
        const int nleft = (t > base_ ? t - base_ : 0) * 4;
        S = (nleft * 14 <= G_ && !MK_FORCE_S7) ? 14 : 7; Kc = K / S; nitems = nleft * S; G = G_; c = c_; base = base_; }
    __device__ __forceinline__ bool next(int i, Unit& u) const {
        const long L = (long)i * G + c; if (L >= nitems) return false;
        const int it = (int)L, un = it / S, ks = it - un * S;
        u.pm = base + (un >> 2); u.pn = un & 3; u.k0 = ks * Kc;
        u.eb = (u.pm >= t1) + (u.pm >= t2) + (u.pm >= t3) + (u.pm >= t4) + (u.pm >= t5) + (u.pm >= t6) + (u.pm >= t7); return true;
    }
    __device__ __forceinline__ void a_ready(const Unit&) const {}
    __device__ __forceinline__ void done(const Unit&) const {}
};

__device__ __forceinline__ unsigned cvt_pk_bf16(float lo, float hi) { unsigned r; asm volatile("v_cvt_pk_bf16_f32 %0, %1, %2" : "=v"(r) : "v"(lo), "v"(hi)); return r; }

struct EpiF32 {
    static constexpr bool PERM = false, AFTER_DRAIN = false;
    float* C; int ldc;
    __device__ __forceinline__ void operator()(const f32x4 (&acc)[2][2][4][2], const Unit& u, int wr, int wc, int fr, int fq) const {
        asm volatile("" : "+v"(fr), "+v"(fq));
        const int row0 = u.pm * BM + wr * 64 + fr, col0 = u.pn * BM + wc * 32 + 4 * fq;
#pragma unroll
        for (int ai = 0; ai < 2; ++ai)
#pragma unroll
            for (int m = 0; m < 4; ++m) { float* rowp = C + (size_t)(row0 + ai * HALF + m * 16) * ldc + col0;
#pragma unroll
                for (int bj = 0; bj < 2; ++bj)
#pragma unroll
                    for (int n = 0; n < 2; ++n) *(f32x4*)(rowp + bj * HALF + n * 16) = acc[ai][bj][m][n]; }
    }
};
struct EpiSlab {
    static constexpr bool PERM = false, AFTER_DRAIN = false;
    float* slab; int base, S, Kc;
    __device__ __forceinline__ void operator()(const f32x4 (&acc)[2][2][4][2], const Unit& u, int wr, int wc, int fr, int fq) const {
        asm volatile("" : "+v"(fr), "+v"(fq));
        float* C = slab + (size_t)((((u.pm - base) * 4 + u.pn) * S) + u.k0 / Kc) * 65536;
        const int row0 = wr * 64 + fr, col0 = wc * 32 + 4 * fq;
#pragma unroll
        for (int ai = 0; ai < 2; ++ai)
#pragma unroll
            for (int m = 0; m < 4; ++m) { float* rowp = C + (size_t)(row0 + ai * HALF + m * 16) * 256 + col0;
#pragma unroll
                for (int bj = 0; bj < 2; ++bj)
#pragma unroll
                    for (int n = 0; n < 2; ++n) *(f32x4*)(rowp + bj * HALF + n * 16) = acc[ai][bj][m][n]; }
    }
};
struct EpiBf16 {
    static constexpr bool PERM = true, AFTER_DRAIN = false;
    bf16_t* O; int ldc; float scale;
    __device__ __forceinline__ void operator()(const f32x4 (&acc)[2][2][4][2], const Unit& u, int wr, int wc, int fr, int fq) const {
        asm volatile("" : "+v"(fr), "+v"(fq));
        const int row0 = u.pm * BM + wr * 64 + fr; const int col0 = u.pn * BM + wc * 32 + 8 * fq; const float sc = scale;
#pragma unroll
        for (int ai = 0; ai < 2; ++ai)
#pragma unroll
            for (int m = 0; m < 4; ++m) { bf16_t* rowp = O + (size_t)(row0 + ai * HALF + m * 16) * ldc + col0;
#pragma unroll
                for (int bj = 0; bj < 2; ++bj) { f32x4 v0 = acc[ai][bj][m][0] * sc, v1 = acc[ai][bj][m][1] * sc;
                    u32x4 w; w.x = cvt_pk_bf16(v0[0], v0[1]); w.y = cvt_pk_bf16(v0[2], v0[3]); w.z = cvt_pk_bf16(v1[0], v1[1]); w.w = cvt_pk_bf16(v1[2], v1[3]);
                    *(u32x4*)(rowp + bj * HALF) = w; } }
    }
};
struct EpiRope {
    static constexpr bool PERM = true, AFTER_DRAIN = false;
    bf16_t* O; int ldc; float scale; const float* CS;
    __device__ __forceinline__ void operator()(const f32x4 (&acc)[2][2][4][2], const Unit& u, int wr, int wc, int fr, int fq) const {
        asm volatile("" : "+v"(fr), "+v"(fq));
        const int row0 = u.pm * BM + wr * 64 + fr; const int col0 = u.pn * BM + wc * 32 + 8 * fq; const float sc = scale;
        const int g4 = ((wc & 1) * 4 + fq) * 4;
#pragma unroll
        for (int ai = 0; ai < 2; ++ai)
#pragma unroll
            for (int m = 0; m < 4; ++m) { int ro = ai * HALF + m * 16; asm volatile("" : "+s"(ro)); const int row = row0 + ro; bf16_t* rowp = O + (size_t)row * ldc + col0;
                const f32x4 cs = *(const f32x4*)(CS + (size_t)row * 64 + g4) * sc, sn = *(const f32x4*)(CS + (size_t)row * 64 + 32 + g4) * sc;
#pragma unroll
                for (int bj = 0; bj < 2; ++bj) { const f32x4 x1 = acc[ai][bj][m][0], x2 = acc[ai][bj][m][1];
                    const f32x4 v0 = x1 * cs - x2 * sn, v1 = x1 * sn + x2 * cs;
                    u32x4 w; w.x = cvt_pk_bf16(v0[0], v0[1]); w.y = cvt_pk_bf16(v0[2], v0[3]); w.z = cvt_pk_bf16(v1[0], v1[1]); w.w = cvt_pk_bf16(v1[2], v1[3]);
                    *(u32x4*)(rowp + bj * HALF) = w; }
                asm volatile("" ::: "memory"); }
    }
};
struct EpiResid {
    static constexpr bool PERM = false, AFTER_DRAIN = false;
    const float* base; float* out; const float* gate; int gstride;
    __device__ __forceinline__ void operator()(const f32x4 (&acc)[2][2][4][2], const Unit& u, int wr, int wc, int fr, int fq) const {
        asm volatile("" : "+v"(fr), "+v"(fq));
        const int row0 = u.pm * BM + wr * 64 + fr, col0 = u.pn * BM + wc * 32 + 4 * fq; const int b = u.pm >> 4;
        f32x4 gv[2][2];
#pragma unroll
        for (int bj = 0; bj < 2; ++bj)
#pragma unroll
            for (int n = 0; n < 2; ++n) gv[bj][n] = *(const f32x4*)(gate + (size_t)b * gstride + col0 + bj * HALF + n * 16);
#pragma unroll
        for (int ai = 0; ai < 2; ++ai)
#pragma unroll
            for (int m = 0; m < 4; ++m) { const size_t off = (size_t)(row0 + ai * HALF + m * 16) * 1024 + col0;
#pragma unroll
                for (int bj = 0; bj < 2; ++bj)
#pragma unroll
                    for (int n = 0; n < 2; ++n) { const f32x4 bs = *(const f32x4*)(base + off + bj * HALF + n * 16); *(f32x4*)(out + off + bj * HALF + n * 16) = bs + gv[bj][n] * acc[ai][bj][m][n]; }
                if (m & 1) asm volatile("" ::: "memory"); }
    }
};
template <bool BASE_F32>
struct EpiResidB {
    static constexpr bool PERM = true, AFTER_DRAIN = false;
    const void* base; bf16_t* out; const float* gate; int gstride; int XP;
    __device__ __forceinline__ void operator()(const f32x4 (&acc)[2][2][4][2], const Unit& u, int wr, int wc, int fr, int fq) const {
        asm volatile("" : "+v"(fr), "+v"(fq));
        const int row0 = u.pm * BM + wr * 64 + fr, col0 = u.pn * BM + wc * 32 + 8 * fq; const int b = u.pm >> 4;
        f32x4 gv[2][2];
#pragma unroll
        for (int bj = 0; bj < 2; ++bj)
#pragma unroll
            for (int n = 0; n < 2; ++n) gv[bj][n] = *(const f32x4*)(gate + (size_t)b * gstride + col0 + bj * HALF + 4 * n);
#pragma unroll
        for (int ai = 0; ai < 2; ++ai)
#pragma unroll
            for (int m = 0; m < 4; ++m) { const int row = row0 + ai * HALF + m * 16;
#pragma unroll
                for (int bj = 0; bj < 2; ++bj) { f32x4 b0, b1;
                    if (BASE_F32) { const float* bp = (const float*)base + (size_t)row * 1024 + col0 + bj * HALF; b0 = *(const f32x4*)bp; b1 = *(const f32x4*)(bp + 4); }
                    else { const u32x4 w = *(const u32x4*)((const bf16_t*)base + (size_t)row * XP + col0 + bj * HALF);
                        b0 = (f32x4){__uint_as_float(w.x << 16), __uint_as_float(w.x & 0xffff0000u), __uint_as_float(w.y << 16), __uint_as_float(w.y & 0xffff0000u)};
                        b1 = (f32x4){__uint_as_float(w.z << 16), __uint_as_float(w.z & 0xffff0000u), __uint_as_float(w.w << 16), __uint_as_float(w.w & 0xffff0000u)}; }
                    const f32x4 v0 = b0 + gv[bj][0] * acc[ai][bj][m][0], v1 = b1 + gv[bj][1] * acc[ai][bj][m][1];
                    u32x4 o; o.x = cvt_pk_bf16(v0[0], v0[1]); o.y = cvt_pk_bf16(v0[2], v0[3]); o.z = cvt_pk_bf16(v1[0], v1[1]); o.w = cvt_pk_bf16(v1[2], v1[3]);
                    *(u32x4*)(out + (size_t)row * XP + col0 + bj * HALF) = o; }
                if (m & 1) asm volatile("" ::: "memory"); }
    }
};
struct EpiSwiglu {
    static constexpr bool PERM = true, AFTER_DRAIN = false;
    bf16_t* O; int ldc;
    __device__ __forceinline__ static float act(float g, float up) { const float e = __builtin_amdgcn_exp2f(g * -1.4426950408889634f); return g * __builtin_amdgcn_rcpf(1.0f + e) * up; }
    __device__ __forceinline__ void operator()(const f32x4 (&acc)[2][2][4][2], const Unit& u, int wr, int wc, int fr, int fq) const {
        asm volatile("" : "+v"(fr), "+v"(fq));
        const int row0 = u.pm * BM + wr * 64 + fr; const int col0 = u.pn * HALF + wc * 32 + 8 * fq;
#pragma unroll
        for (int ai = 0; ai < 2; ++ai)
#pragma unroll
            for (int m = 0; m < 4; ++m) { bf16_t* rowp = O + (size_t)(row0 + ai * HALF + m * 16) * ldc + col0;
                const f32x4 g0 = acc[ai][0][m][0], g1 = acc[ai][0][m][1], u0 = acc[ai][1][m][0], u1 = acc[ai][1][m][1];
                u32x4 w; w.x = cvt_pk_bf16(act(g0[0], u0[0]), act(g0[1], u0[1])); w.y = cvt_pk_bf16(act(g0[2], u0[2]), act(g0[3], u0[3]));
                w.z = cvt_pk_bf16(act(g1[0], u1[0]), act(g1[1], u1[1])); w.w = cvt_pk_bf16(act(g1[2], u1[2]), act(g1[3], u1[3]));
                *(u32x4*)rowp = w; }
    }
};

template <class Epi, class Sched, bool ALIGN_EPI = false, bool SP2 = false, int GEXP = 0  >
__device__ __forceinline__ void gemm_phase(PG8_LAS unsigned char* lds, const Gemm g, const Sched& S, const Epi& E, int wave_id) {
    int tid_ = (int)__builtin_amdgcn_mbcnt_hi(~0u, __builtin_amdgcn_mbcnt_lo(~0u, 0u)); asm volatile("" : "+v"(tid_)); tid_ += wave_id * 64;
    const int tid = tid_, wid = __builtin_amdgcn_readfirstlane(tid >> 6), lane = tid & 63, wr = wid >> 2, wc = wid & 3, fr = lane & 15, fq = lane >> 4;
    const int K = g.K, nt = (g.Kloop ? g.Kloop : K) / BK;
    unsigned voffA[2], voffB[2];
#pragma unroll
    for (int i = 0; i < 2; ++i) { int R, C; stage_rc(tid * 16 + i * 8192, R, C); const int Rb = Epi::PERM ? ((R & ~31) + perm32(R & 31)) : R;
        voffA[i] = (unsigned)(R * K + C) * 2u; voffB[i] = (unsigned)(Rb * K + C) * 2u; }
    const size_t kstep = (size_t)(BK * 2);
    const size_t hstep = (size_t)HALF * K * 2;
    const size_t tstep = 2 * hstep;
    const unsigned ldsw = (unsigned)wid * 1024u;
    const int aoff = lds_byte(wr * 64 + fr, fq * 8), boff = lds_byte(wc * 32 + fr, fq * 8);
#define PG8_SA(b, h) (((b) * 2 + (h)) * HTB)
#define PG8_SB(b, h) ((4 + (b) * 2 + (h)) * HTB)
#define PG8_STAGE(bufoff, gbase, voff) do { _Pragma("unroll") for (int _i = 0; _i < 2; ++_i) \
        __builtin_amdgcn_global_load_lds((const unsigned*)((const char*)(gbase) + (voff)[_i]), (PG8_LAS unsigned*)(lds + (bufoff) + ldsw + _i * 8192), 16, 0, 0); } while (0)
#define PG8_LDA(dst, b, h) do { _Pragma("unroll") for (int m = 0; m < 4; ++m) _Pragma("unroll") for (int k = 0; k < 2; ++k) dst[m][k] = *(const PG8_LAS bf16x8*)(lds + PG8_SA(b, h) + aoff + m * 2048 + k * 1024); } while (0)
#define PG8_LDB(dst, b, h) do { _Pragma("unroll") for (int n = 0; n < 2; ++n) _Pragma("unroll") for (int k = 0; k < 2; ++k) dst[n][k] = *(const PG8_LAS bf16x8*)(lds + PG8_SB(b, h) + boff + n * 2048 + k * 1024); } while (0)
#define PG8_MMA(ai, bj, At, Bt) do { __builtin_amdgcn_s_setprio(1); _Pragma("unroll") for (int m = 0; m < 4; ++m) _Pragma("unroll") for (int n = 0; n < 2; ++n) _Pragma("unroll") for (int k = 0; k < 2; ++k) \
        acc[ai][bj][m][n] = __builtin_amdgcn_mfma_f32_16x16x32_bf16(Bt[n][k], At[m][k], acc[ai][bj][m][n], 0, 0, 0); __builtin_amdgcn_s_setprio(0); } while (0)
#define PG8_WAIT_V(n) asm volatile("s_waitcnt vmcnt(" #n ")" ::: "memory")
#define PG8_WAIT_L(n) asm volatile("s_waitcnt lgkmcnt(" #n ")" ::: "memory")
#define PG8_BAR __builtin_amdgcn_s_barrier()
#define PG8_SCHED __builtin_amdgcn_sched_barrier(0)
    Unit cur, nxt; int ui = 0;
    if (!S.next(0, cur)) return;
    f32x4 acc[2][2][4][2];
#pragma unroll
    for (int a = 0; a < 2; ++a)
#pragma unroll
        for (int b = 0; b < 2; ++b)
#pragma unroll
            for (int m = 0; m < 4; ++m)
#pragma unroll
                for (int n = 0; n < 2; ++n) acc[a][b][m][n] = (f32x4){0.f, 0.f, 0.f, 0.f};
    bf16x8 At[4][2], B0[2][2], B1[2][2];
    const char* cA = (const char*)g.A + (size_t)cur.pm * tstep + (size_t)cur.k0 * 2; const char* cB = (const char*)g.Bt + (size_t)cur.pn * tstep + (size_t)cur.eb * g.bstride + (size_t)cur.k0 * 2;
    S.a_ready(cur);
    if constexpr (SP2) {
        PG8_STAGE(PG8_SB(0, 0), cB, voffB); PG8_STAGE(PG8_SB(0, 1), cB + hstep, voffB); PG8_STAGE(PG8_SA(0, 0), cA, voffA); PG8_STAGE(PG8_SA(0, 1), cA + hstep, voffA);
        if (wr == 1) PG8_BAR;
        PG8_WAIT_V(2); PG8_BAR;
        PG8_STAGE(PG8_SB(1, 0), cB + kstep, voffB); PG8_STAGE(PG8_SA(1, 0), cA + kstep, voffA); PG8_STAGE(PG8_SB(1, 1), cB + hstep + kstep, voffB);
        PG8_WAIT_V(6); PG8_BAR;
    } else {
        PG8_STAGE(PG8_SB(0, 0), cB, voffB); PG8_STAGE(PG8_SA(0, 0), cA, voffA); PG8_STAGE(PG8_SB(0, 1), cB + hstep, voffB); PG8_STAGE(PG8_SA(0, 1), cA + hstep, voffA);
        if (wr == 1) PG8_BAR;
        PG8_WAIT_V(4); PG8_BAR;
        PG8_STAGE(PG8_SB(1, 0), cB + kstep, voffB); PG8_STAGE(PG8_SA(1, 0), cA + kstep, voffA); PG8_STAGE(PG8_SB(1, 1), cB + hstep + kstep, voffB);
        PG8_WAIT_V(6); PG8_BAR;
    }
    for (;;) {
        const bool has_next = S.next(ui + 1, nxt);
        const char* nA = has_next ? (const char*)g.A + (size_t)nxt.pm * tstep + (size_t)nxt.k0 * 2 : cA; const char* nB = has_next ? (const char*)g.Bt + (size_t)nxt.pn * tstep + (size_t)nxt.eb * g.bstride + (size_t)nxt.k0 * 2 : cB;
        for (int t = 0; t < nt; t += 2) {
            const bool last = (t == nt - 2);
            const char* a1 = cA + (size_t)(t + 1) * kstep;
            const char* a2 = last ? nA : cA + (size_t)(t + 2) * kstep; const char* b2 = last ? nB : cB + (size_t)(t + 2) * kstep;
            const char* a3 = a2 + kstep; const char* b3 = b2 + kstep;
            if (last && has_next) S.a_ready(nxt);
            if constexpr (SP2) {
            PG8_LDB(B0, 0, 0); PG8_LDB(B1, 0, 1); PG8_SCHED; PG8_LDA(At, 0, 0); PG8_STAGE(PG8_SA(1, 1), a1 + hstep, voffA);
            PG8_WAIT_V(8); PG8_WAIT_L(0); PG8_BAR; PG8_MMA(0, 0, At, B0); PG8_MMA(0, 1, At, B1); PG8_BAR; PG8_SCHED;
            PG8_LDA(At, 0, 1); PG8_STAGE(PG8_SB(0, 0), b2, voffB); PG8_STAGE(PG8_SB(0, 1), b2 + hstep, voffB); PG8_STAGE(PG8_SA(0, 0), a2, voffA);
            PG8_WAIT_V(8); PG8_WAIT_L(0); PG8_BAR; PG8_MMA(1, 0, At, B0); PG8_MMA(1, 1, At, B1); PG8_BAR; PG8_SCHED;
            PG8_LDB(B0, 1, 0); PG8_LDB(B1, 1, 1); PG8_SCHED; PG8_LDA(At, 1, 0); PG8_STAGE(PG8_SA(0, 1), a2 + hstep, voffA);
            PG8_WAIT_V(8); PG8_WAIT_L(0); PG8_BAR; PG8_MMA(0, 0, At, B0); PG8_MMA(0, 1, At, B1); PG8_BAR; PG8_SCHED;
            PG8_LDA(At, 1, 1); PG8_STAGE(PG8_SB(1, 0), b3, voffB); PG8_STAGE(PG8_SB(1, 1), b3 + hstep, voffB); PG8_STAGE(PG8_SA(1, 0), a3, voffA);
            PG8_WAIT_V(8); PG8_WAIT_L(0); PG8_BAR; PG8_MMA(1, 0, At, B0); PG8_MMA(1, 1, At, B1); PG8_BAR; PG8_SCHED;
            } else {
            PG8_LDB(B0, 0, 0); PG8_SCHED; PG8_LDA(At, 0, 0); PG8_STAGE(PG8_SA(1, 1), a1 + hstep, voffA);
            PG8_WAIT_L(8); PG8_BAR; PG8_WAIT_L(0); PG8_MMA(0, 0, At, B0); PG8_BAR; PG8_SCHED;
            PG8_LDB(B1, 0, 1); PG8_STAGE(PG8_SB(0, 0), b2, voffB);
            PG8_BAR; PG8_WAIT_L(0); PG8_MMA(0, 1, At, B1); PG8_BAR;
            PG8_LDA(At, 0, 1); PG8_STAGE(PG8_SA(0, 0), a2, voffA);
            PG8_BAR; PG8_WAIT_L(0); PG8_MMA(1, 0, At, B0); PG8_BAR; PG8_SCHED;
            PG8_STAGE(PG8_SB(0, 1), b2 + hstep, voffB);
            PG8_WAIT_V(6); PG8_BAR; PG8_MMA(1, 1, At, B1); PG8_BAR;
            PG8_LDB(B0, 1, 0); PG8_SCHED; PG8_LDA(At, 1, 0); PG8_STAGE(PG8_SA(0, 1), a2 + hstep, voffA);
            PG8_WAIT_L(8); PG8_BAR; PG8_WAIT_L(0); PG8_MMA(0, 0, At, B0); PG8_BAR; PG8_SCHED;
            PG8_LDB(B1, 1, 1); PG8_STAGE(PG8_SB(1, 0), b3, voffB);
            PG8_BAR; PG8_WAIT_L(0); PG8_MMA(0, 1, At, B1); PG8_BAR;
            PG8_LDA(At, 1, 1); PG8_STAGE(PG8_SA(1, 0), a3, voffA);
            PG8_BAR; PG8_WAIT_L(0); PG8_MMA(1, 0, At, B0); PG8_BAR; PG8_SCHED;
            PG8_STAGE(PG8_SB(1, 1), b3 + hstep, voffB);
            PG8_WAIT_V(6); PG8_BAR; PG8_MMA(1, 1, At, B1); PG8_BAR;
            }
        }
        if constexpr (ALIGN_EPI) { if (wr == 0) PG8_BAR; }
        if constexpr (!Epi::AFTER_DRAIN) { if (!(GEXP & 1)) E(acc, cur, wr, wc, fr, fq); else { float z_ = 0.f; _Pragma("unroll") for (int a_ = 0; a_ < 2; ++a_) _Pragma("unroll") for (int b_ = 0; b_ < 2; ++b_) _Pragma("unroll") for (int m_ = 0; m_ < 4; ++m_) _Pragma("unroll") for (int n_ = 0; n_ < 2; ++n_) z_ += acc[a_][b_][m_][n_][0] + acc[a_][b_][m_][n_][1] + acc[a_][b_][m_][n_][2] + acc[a_][b_][m_][n_][3]; if (z_ == 1.2345e-30f) *(volatile float*)g.A = z_; } S.done(cur); }
        if (!has_next) break;
#pragma unroll
        for (int a = 0; a < 2; ++a)
#pragma unroll
            for (int b = 0; b < 2; ++b)
#pragma unroll
                for (int m = 0; m < 4; ++m)
#pragma unroll
                    for (int n = 0; n < 2; ++n) acc[a][b][m][n] = (f32x4){0.f, 0.f, 0.f, 0.f};
        cur = nxt; cA = nA; cB = nB; ++ui;
        if constexpr (ALIGN_EPI) { if (wr == 1) PG8_BAR; }
    }
    PG8_WAIT_V(0);
    if constexpr (!ALIGN_EPI) { if (wr == 0) PG8_BAR; }
    PG8_BAR;
    if constexpr (Epi::AFTER_DRAIN) { E.fused(acc, cur, wr, wc, fr, fq, lds, wid, lane); S.done(cur); }
#undef PG8_SA
#undef PG8_SB
#undef PG8_STAGE
#undef PG8_LDA
#undef PG8_LDB
#undef PG8_MMA
#undef PG8_WAIT_V
#undef PG8_WAIT_L
#undef PG8_BAR
#undef PG8_SCHED
}
}

namespace att {
typedef unsigned short bf16_t;
typedef short bf16x8 __attribute__((ext_vector_type(8)));
typedef short s16x4 __attribute__((ext_vector_type(4)));
typedef float f32x16 __attribute__((ext_vector_type(16)));
typedef unsigned u32x4 __attribute__((ext_vector_type(4)));
#define ALDS __attribute__((address_space(3)))
#define ASBAR() __builtin_amdgcn_sched_barrier(0)
#ifndef ATT_PRIO
#define ATT_PRIO 0
#endif
#ifndef ATT_SB_SKIP
#define ATT_SB_SKIP 1
#endif
#ifndef ATT_STAGGER
#define ATT_STAGGER 1
#endif
constexpr int SEQ = 4096, KVBLK = 64, QBLK = 32, NW = 8, QB = NW * QBLK;
constexpr int SHM_K = KVBLK * 384, SHM_V = KVBLK * 128 * 2;
constexpr int OFF_V = 0, OFF_K = 3 * SHM_V, OFF_S = OFF_K + 3 * SHM_K, LDS_BYTES = OFF_S + NW * 64 * 4;
__device__ __forceinline__ int v_st(int k, int c) { const int kk = (k & ~0xC) | ((k & 4) << 1) | ((k & 8) >> 1); return ((kk >> 3) * 4 + (c >> 5)) * 512 + ((kk & 7) * 32 + (c & 31)) * 2; }
__device__ __forceinline__ int v_rd_base(int lane) { return ((lane & 3) << 3) | (((lane >> 2) & 3) << 6) | (((lane >> 4) & 1) << 5) | (((lane >> 5) & 1) << 8); }
constexpr int v_rd_off(int d0, int ks, int half) { return d0 * 512 + ks * 4096 + half * 2048; }
__device__ __forceinline__ int crow(int r, int hi) { return (r & 3) + 8 * (r >> 2) + 4 * hi; }
__device__ __forceinline__ unsigned cvtpk(float lo, float hi) { unsigned r; asm volatile("v_cvt_pk_bf16_f32 %0, %1, %2" : "=v"(r) : "v"(lo), "v"(hi)); return r; }

typedef short v4i16_t __attribute__((ext_vector_type(4)));
__device__ __forceinline__ s16x4 vtr(const ALDS char* p) { return __builtin_bit_cast(s16x4, __builtin_amdgcn_ds_read_tr16_b64_v4i16((ALDS v4i16_t*)p)); }
__device__ __forceinline__ void pv_tile(f32x16* o, const ALDS char* vp, bf16x8 pa0, bf16x8 pa1, bf16x8 pa2, bf16x8 pa3) {
    s16x4 r[4][4];
#define PV_RD(g) do { constexpr int b_ = v_rd_off((g) >> 1, 0, 0) + ((g) & 1) * 8192; r[(g) & 3][0] = vtr(vp + b_); r[(g) & 3][1] = vtr(vp + b_ + 2048); r[(g) & 3][2] = vtr(vp + b_ + 4096); r[(g) & 3][3] = vtr(vp + b_ + 6144); } while (0)
#define PV_MM(g) do { const s16x4 L0 = r[(g) & 3][0], H0 = r[(g) & 3][1], L1 = r[(g) & 3][2], H1 = r[(g) & 3][3]; \
        o[(g) >> 1] = __builtin_amdgcn_mfma_f32_32x32x16_bf16(((g) & 1) ? pa2 : pa0, (bf16x8){L0[0], L0[1], L0[2], L0[3], H0[0], H0[1], H0[2], H0[3]}, o[(g) >> 1], 0, 0, 0); \
        o[(g) >> 1] = __builtin_amdgcn_mfma_f32_32x32x16_bf16(((g) & 1) ? pa3 : pa1, (bf16x8){L1[0], L1[1], L1[2], L1[3], H1[0], H1[1], H1[2], H1[3]}, o[(g) >> 1], 0, 0, 0); } while (0)
    PV_RD(0); PV_RD(1); PV_RD(2); ASBAR();
    PV_RD(3); PV_MM(0); ASBAR();
    PV_RD(4); PV_MM(1); ASBAR();
    PV_RD(5); PV_MM(2); ASBAR();
    PV_RD(6); PV_MM(3); ASBAR();
    PV_RD(7); PV_MM(4); ASBAR();
    PV_MM(5); ASBAR(); PV_MM(6); ASBAR(); PV_MM(7);
#undef PV_RD
#undef PV_MM
}
__device__ __forceinline__ void pv_tile2(f32x16* o, const ALDS char* vp, bf16x8 pa0, bf16x8 pa1, bf16x8 pa2, bf16x8 pa3) {
    s16x4 r[2][4];
#define PV_RD(g) do { constexpr int b_ = v_rd_off((g) >> 1, 0, 0) + ((g) & 1) * 8192; r[(g) & 1][0] = vtr(vp + b_); r[(g) & 1][1] = vtr(vp + b_ + 2048); r[(g) & 1][2] = vtr(vp + b_ + 4096); r[(g) & 1][3] = vtr(vp + b_ + 6144); } while (0)
#define PV_MM(g) do { const s16x4 L0 = r[(g) & 1][0], H0 = r[(g) & 1][1], L1 = r[(g) & 1][2], H1 = r[(g) & 1][3]; \
        o[(g) >> 1] = __builtin_amdgcn_mfma_f32_32x32x16_bf16(((g) & 1) ? pa2 : pa0, (bf16x8){L0[0], L0[1], L0[2], L0[3], H0[0], H0[1], H0[2], H0[3]}, o[(g) >> 1], 0, 0, 0); \
        o[(g) >> 1] = __builtin_amdgcn_mfma_f32_32x32x16_bf16(((g) & 1) ? pa3 : pa1, (bf16x8){L1[0], L1[1], L1[2], L1[3], H1[0], H1[1], H1[2], H1[3]}, o[(g) >> 1], 0, 0, 0); } while (0)
    PV_RD(0); ASBAR();
    PV_RD(1); PV_MM(0); ASBAR(); PV_RD(2); PV_MM(1); ASBAR(); PV_RD(3); PV_MM(2); ASBAR(); PV_RD(4); PV_MM(3); ASBAR();
    PV_RD(5); PV_MM(4); ASBAR(); PV_RD(6); PV_MM(5); ASBAR(); PV_RD(7); PV_MM(6); ASBAR(); PV_MM(7);
#undef PV_RD
#undef PV_MM
}
__device__ __forceinline__ void pack_p(const f32x16& p0, const f32x16& p1, bf16x8& pa0, bf16x8& pa1, bf16x8& pa2, bf16x8& pa3) {
#define PK4(P, B_, OUT) do { unsigned a0 = cvtpk(P[B_+0], P[B_+1]), a1 = cvtpk(P[B_+2], P[B_+3]);                          \
        unsigned b0 = cvtpk(P[B_+4], P[B_+5]), b1 = cvtpk(P[B_+6], P[B_+7]);                                             \
        auto r0 = __builtin_amdgcn_permlane32_swap(a0, b0, false, false); auto r1 = __builtin_amdgcn_permlane32_swap(a1, b1, false, false); \
        u32x4 w = {r0[0], r1[0], r0[1], r1[1]}; OUT = __builtin_bit_cast(bf16x8, w); } while (0)
    PK4(p0, 0, pa0); PK4(p0, 8, pa1); PK4(p1, 0, pa2); PK4(p1, 8, pa3);
#undef PK4
}
__device__ __forceinline__ float swap_max(float v) { auto rr = __builtin_amdgcn_permlane32_swap(__float_as_uint(v), __float_as_uint(v), false, false); return fmaxf(__uint_as_float(rr[0]), __uint_as_float(rr[1])); }
__device__ __forceinline__ float swap_sum(float v) { auto rr = __builtin_amdgcn_permlane32_swap(__float_as_uint(v), __float_as_uint(v), false, false); return __uint_as_float(rr[0]) + __uint_as_float(rr[1]); }

template <int MODE>
__device__ __forceinline__ void sm_stage(f32x16& p0, f32x16& p1, f32x16 (&o)[4], float& m_reg, float& l_reg, float& carry, int kb0, int qlo, int r32, int hi, ALDS float* wsf,
                                         bf16x8& pa0, bf16x8& pa1, bf16x8& pa2, bf16x8& pa3) {
    const float NEG = -__builtin_inff();
    const bool needmask = (MODE == 0) ? (kb0 + KVBLK - 1 > qlo) : (kb0 + KVBLK - 1 >= qlo);
    if (needmask) { const int dq = qlo + r32 - kb0 - 4 * hi;
#pragma unroll
        for (int r = 0; r < 16; ++r) { const int c = (r & 3) + 8 * (r >> 2);
            if (MODE == 0) { if (c > dq) p0[r] = NEG; if (c + 32 > dq) p1[r] = NEG; }
            else { if (c >= dq) p0[r] = NEG; if (c + 32 >= dq) p1[r] = NEG; } } }
    if (MODE == 0) {
        float pmax = p0[0];
#pragma unroll
        for (int r = 1; r < 16; ++r) pmax = fmaxf(pmax, p0[r]);
#pragma unroll
        for (int r = 0; r < 16; ++r) pmax = fmaxf(pmax, p1[r]);
        pmax = swap_max(pmax);
        float alpha = 1.f;
        if (!__all(pmax - m_reg <= 8.0f)) { const float mn = fmaxf(m_reg, pmax); alpha = __builtin_amdgcn_exp2f(m_reg - mn); m_reg = mn; }
        float ps = 0.f;
#pragma unroll
        for (int r = 0; r < 16; ++r) { p0[r] = __builtin_amdgcn_exp2f(p0[r] - m_reg); ps += p0[r]; }
#pragma unroll
        for (int r = 0; r < 16; ++r) { p1[r] = __builtin_amdgcn_exp2f(p1[r] - m_reg); ps += p1[r]; }
        ps = swap_sum(ps);
        l_reg = l_reg * alpha + ps;
        if (__any(alpha < 1.f)) { if (hi == 0) wsf[r32] = alpha; asm volatile("s_waitcnt lgkmcnt(0)" ::: "memory");
#pragma unroll
            for (int r = 0; r < 16; ++r) { const float f = wsf[crow(r, hi)];
#pragma unroll
                for (int d_ = 0; d_ < 4; ++d_) o[d_][r] *= f; }
            asm volatile("s_waitcnt lgkmcnt(0)" ::: "memory"); }
    } else {
        float si[9];
#define SB_GRP1(P, B_, k) do { \
            const float ba = __builtin_amdgcn_rcpf(1.0f + __builtin_amdgcn_exp2f(-P[B_])), bb = __builtin_amdgcn_rcpf(1.0f + __builtin_amdgcn_exp2f(-P[B_ + 1])); \
            const float bc = __builtin_amdgcn_rcpf(1.0f + __builtin_amdgcn_exp2f(-P[B_ + 2])), bd = __builtin_amdgcn_rcpf(1.0f + __builtin_amdgcn_exp2f(-P[B_ + 3])); \
            P[B_] = ba; P[B_ + 1] = bb; P[B_ + 2] = bc; P[B_ + 3] = bd; si[k] = ((1.0f - ba) * (1.0f - bb)) * ((1.0f - bc) * (1.0f - bd)); } while (0)
        SB_GRP1(p0, 0, 0); SB_GRP1(p0, 4, 1); SB_GRP1(p0, 8, 2); SB_GRP1(p0, 12, 3); SB_GRP1(p1, 0, 4); SB_GRP1(p1, 4, 5); SB_GRP1(p1, 8, 6); SB_GRP1(p1, 12, 7);
#undef SB_GRP1
        si[8] = 1.0f;
#pragma unroll
        for (int k = 6; k >= 0; --k) si[k] *= si[k + 1];
#define SB_GRP2(P, B_, k) do { \
            auto rr = __builtin_amdgcn_permlane32_swap(__float_as_uint(si[k]), __float_as_uint(si[(k) + 1]), false, false); \
              \
            const float other = hi ? __uint_as_float(rr[0]) : __uint_as_float(rr[1]); \
            const float ed = carry * si[(k) + 1] * other, ec = ed * (1.0f - P[B_ + 3]), eb = ec * (1.0f - P[B_ + 2]), ea = eb * (1.0f - P[B_ + 1]); \
            P[B_ + 3] *= ed; P[B_ + 2] *= ec; P[B_ + 1] *= eb; P[B_] *= ea; } while (0)
        SB_GRP2(p0, 0, 0); SB_GRP2(p0, 4, 1); SB_GRP2(p0, 8, 2); SB_GRP2(p0, 12, 3); SB_GRP2(p1, 0, 4); SB_GRP2(p1, 4, 5); SB_GRP2(p1, 8, 6); SB_GRP2(p1, 12, 7);
#undef SB_GRP2
        { auto rr = __builtin_amdgcn_permlane32_swap(__float_as_uint(si[0]), __float_as_uint(si[0]), false, false); carry *= __uint_as_float(rr[0]) * __uint_as_float(rr[1]); }
    }
    pack_p(p0, p1, pa0, pa1, pa2, pa3);
}

template <int MODE, int EXP = 0>
__device__ __forceinline__ void attn_unit(int b, int h, int qb, const bf16_t* __restrict__ Qp, const bf16_t* __restrict__ KVp, const bf16_t* __restrict__ KRp, bf16_t* __restrict__ Op, ALDS char* lds, int wave_id) {
    constexpr int DK = MODE == 0 ? 192 : 128, NQ = DK / 16, KI = DK / 64, KROW = MODE == 0 ? 384 : 256;
    int tid_ = (int)__builtin_amdgcn_mbcnt_hi(~0u, __builtin_amdgcn_mbcnt_lo(~0u, 0u)); asm volatile("" : "+v"(tid_)); tid_ += wave_id * 64;
    const int tid = tid_, wid = __builtin_amdgcn_readfirstlane(tid >> 6), lane = tid & 63, r32 = lane & 31, hi = lane >> 5;
    const size_t tok0 = (size_t)b * SEQ;
    const int q0 = qb * QB, qlo = q0 + wid * QBLK;
    bf16x8 qr[NQ];
    { const size_t row = tok0 + qlo + r32;
#pragma unroll
      for (int d0 = 0; d0 < NQ; ++d0) {
          const bf16_t* p;
          if (MODE == 0) p = (d0 < 8) ? Qp + row * 1536 + h * 128 + d0 * 16 + hi * 8 : Qp + row * 1536 + 1024 + h * 64 + (d0 - 8) * 16 + hi * 8;
          else p = Qp + row * 1024 + h * 128 + d0 * 16 + hi * 8;
          qr[d0] = *(const bf16x8*)p; } }
    const int krow = tid >> 3, kcg = tid & 7;
    int kw[KI];
    if (MODE == 0) {
#pragma unroll
        for (int i = 0; i < KI; ++i) kw[i] = krow * KROW + ((kcg ^ ((krow >> 1) & 7)) << 4) + i * 128;
    } else { const int x = krow & 15;
#pragma unroll
        for (int i = 0; i < KI; ++i) kw[i] = krow * KROW + ((kcg ^ (x & 7)) << 4) + ((i ^ (x >> 3)) << 7); }
    const int sr = tid >> 4, sc = (tid & 15) * 8;
    const int vst0 = v_st(sr, sc), vst1 = v_st(32 + sr, sc);
    const bf16_t* ksrc = (MODE == 0) ? KVp + (tok0 + krow) * 2048 + h * 256 + kcg * 8 : KVp + (tok0 + krow) * 2048 + h * 128 + kcg * 8;
    const bf16_t* krsrc = (MODE == 0) ? KRp + (tok0 + krow) * 64 + kcg * 8 : nullptr;
    const bf16_t* vsrc = (MODE == 0) ? KVp + (tok0 + sr) * 2048 + h * 256 + 128 + sc : KVp + (tok0 + sr) * 2048 + 1024 + h * 128 + sc;
    bf16x8 stk[KI], stv0, stv1;
#define ST_LOAD(j) do { const size_t k0_ = (size_t)(j) * KVBLK; \
        stk[0] = *(const bf16x8*)(ksrc + k0_ * 2048); stk[1] = *(const bf16x8*)(ksrc + k0_ * 2048 + 64); \
        if (MODE == 0) stk[KI - 1] = *(const bf16x8*)(krsrc + k0_ * 64); \
        stv0 = *(const bf16x8*)(vsrc + k0_ * 2048); stv1 = *(const bf16x8*)(vsrc + (k0_ + 32) * 2048); } while (0)
#define ST_WRITE(buf) do { ALDS char* kb_ = lds + OFF_K + (buf) * SHM_K; \
        _Pragma("unroll") for (int i_ = 0; i_ < KI; ++i_) *(ALDS bf16x8*)(kb_ + kw[i_]) = stk[i_]; \
        *(ALDS bf16x8*)(lds + OFF_V + (buf) * SHM_V + vst0) = stv0; *(ALDS bf16x8*)(lds + OFF_V + (buf) * SHM_V + vst1) = stv1; } while (0)
    int kb[4];
#pragma unroll
    for (int dd = 0; dd < 4; ++dd) kb[dd] = OFF_K + r32 * KROW + (MODE == 0 ? (((dd * 2 + hi) ^ ((r32 >> 1) & 7)) << 4) : ((((dd * 2 + hi) ^ (r32 & 7)) << 4) + (((r32 >> 3) & 1) << 7)));
    const ALDS char* vp0 = lds + OFF_V + v_rd_base(lane);
    ALDS float* wsf = (ALDS float*)(lds + OFF_S) + wid * 64;
    const int NT = 4 * qb + 4;
    f32x16 o[4] = {};
    float m_reg = -1e30f, l_reg = 0.f, carry = 1.0f;
#define TILE_OF(s) (MODE == 0 ? (s) : NT - 1 - (s))
    ST_LOAD(TILE_OF(0)); ST_WRITE(0);
    if (NT > 1) ST_LOAD(TILE_OF(1));
    __syncthreads();
#ifndef ATT_TOUCH
#define ATT_TOUCH 0
#endif
#ifndef ATT_PIPE
#define ATT_PIPE 0
#endif
    if constexpr (MODE == 1 && ATT_PIPE && !(EXP & 64)) {
    f32x16 pA0, pA1, pB0, pB1;
    const float NEGI = -__builtin_inff();
#define KAD(d0) (kbase + (((d0) >> 2) ? (kb[(d0) & 3] ^ 128) : kb[(d0) & 3]))
    { const ALDS char* kbase = lds;
      pA0 = f32x16{}; pA1 = f32x16{};
#pragma unroll
      for (int d0 = 0; d0 < NQ; ++d0) { const ALDS char* a_ = KAD(d0); const bf16x8 b0 = *(const ALDS bf16x8*)a_, b1 = *(const ALDS bf16x8*)(a_ + 32 * KROW);
          pA0 = __builtin_amdgcn_mfma_f32_32x32x16_bf16(b0, qr[d0], pA0, 0, 0, 0); pA1 = __builtin_amdgcn_mfma_f32_32x32x16_bf16(b1, qr[d0], pA1, 0, 0, 0); } }
    if (NT > 1) { ST_WRITE(1); if (NT > 2) ST_LOAD(TILE_OF(2)); }
    __syncthreads();
    int buf = 1, bufn = 2, bufp = 0;
    for (int s = 1; s <= NT; ++s) {
        const ALDS char* kbase = lds + buf * SHM_K;
        const ALDS char* vp = vp0 + bufp * SHM_V;
        const int kbp = TILE_OF(s - 1) * KVBLK;
        { const int dq = qlo + r32 - kbp - 4 * hi;
#pragma unroll
          for (int r = 0; r < 16; ++r) { const int c = (r & 3) + 8 * (r >> 2); pA0[r] = (c >= dq) ? NEGI : pA0[r]; pA1[r] = (c + 32 >= dq) ? NEGI : pA1[r]; } }
        float si[9];
        bf16x8 kf[2][2];
        pB0 = f32x16{}; pB1 = f32x16{};
#define K_RD(i) do { const ALDS char* a_ = KAD(i); kf[(i) & 1][0] = *(const ALDS bf16x8*)a_; kf[(i) & 1][1] = *(const ALDS bf16x8*)(a_ + 32 * KROW); } while (0)
#define SB_GRP1(P, B_, k) do { \
            const float ba = __builtin_amdgcn_rcpf(1.0f + __builtin_amdgcn_exp2f(-P[B_])), bb = __builtin_amdgcn_rcpf(1.0f + __builtin_amdgcn_exp2f(-P[B_ + 1])); \
            const float bc = __builtin_amdgcn_rcpf(1.0f + __builtin_amdgcn_exp2f(-P[B_ + 2])), bd = __builtin_amdgcn_rcpf(1.0f + __builtin_amdgcn_exp2f(-P[B_ + 3])); \
            P[B_] = ba; P[B_ + 1] = bb; P[B_ + 2] = bc; P[B_ + 3] = bd; si[k] = ((1.0f - ba) * (1.0f - bb)) * ((1.0f - bc) * (1.0f - bd)); } while (0)
#define QK_CHUNK(i, P, B_) do { if ((i) + 1 < NQ) K_RD((i) + 1); \
            pB0 = __builtin_amdgcn_mfma_f32_32x32x16_bf16(kf[(i) & 1][0], qr[i], pB0, 0, 0, 0); pB1 = __builtin_amdgcn_mfma_f32_32x32x16_bf16(kf[(i) & 1][1], qr[i], pB1, 0, 0, 0); \
            SB_GRP1(P, B_, i); ASBAR(); } while (0)
        K_RD(0); ASBAR();
        QK_CHUNK(0, pA0, 0); QK_CHUNK(1, pA0, 4); QK_CHUNK(2, pA0, 8); QK_CHUNK(3, pA0, 12); QK_CHUNK(4, pA1, 0); QK_CHUNK(5, pA1, 4); QK_CHUNK(6, pA1, 8); QK_CHUNK(7, pA1, 12);
#undef K_RD
#undef SB_GRP1
#undef QK_CHUNK
        si[8] = 1.0f;
#pragma unroll
        for (int k = 6; k >= 0; --k) si[k] *= si[k + 1];
        if (s + 1 < NT) { ST_WRITE(bufn); if (s + 2 < NT) ST_LOAD(TILE_OF(s + 2)); }
#define SB_GRP2(P, B_, k) do { \
            auto rr = __builtin_amdgcn_permlane32_swap(__float_as_uint(si[k]), __float_as_uint(si[(k) + 1]), false, false); \
            const float other = hi ? __uint_as_float(rr[0]) : __uint_as_float(rr[1]); \
            const float ed = carry * si[(k) + 1] * other, ec = ed * (1.0f - P[B_ + 3]), eb = ec * (1.0f - P[B_ + 2]), ea = eb * (1.0f - P[B_ + 1]); \
            P[B_ + 3] *= ed; P[B_ + 2] *= ec; P[B_ + 1] *= eb; P[B_] *= ea; } while (0)
#define PK4(P, B_, OUT) do { unsigned a0 = cvtpk(P[B_+0], P[B_+1]), a1 = cvtpk(P[B_+2], P[B_+3]); unsigned b0 = cvtpk(P[B_+4], P[B_+5]), b1 = cvtpk(P[B_+6], P[B_+7]); \
            auto r0 = __builtin_amdgcn_permlane32_swap(a0, b0, false, false); auto r1 = __builtin_amdgcn_permlane32_swap(a1, b1, false, false); \
            u32x4 w = {r0[0], r1[0], r0[1], r1[1]}; OUT = __builtin_bit_cast(bf16x8, w); } while (0)
        s16x4 vf[8];
#define V_RD(ks) do { _Pragma("unroll") for (int d_ = 0; d_ < 4; ++d_) { vf[2 * d_] = vtr(vp + v_rd_off(d_, ks, 0)); vf[2 * d_ + 1] = vtr(vp + v_rd_off(d_, ks, 1)); } } while (0)
#define V_MM(ks, PA) do { _Pragma("unroll") for (int d_ = 0; d_ < 4; ++d_) { const s16x4 L = vf[2 * d_], H = vf[2 * d_ + 1]; \
            o[d_] = __builtin_amdgcn_mfma_f32_32x32x16_bf16(PA, (bf16x8){L[0], L[1], L[2], L[3], H[0], H[1], H[2], H[3]}, o[d_], 0, 0, 0); } } while (0)
        bf16x8 pa0, pa1, pa2, pa3;
        V_RD(0); SB_GRP2(pA0, 0, 0); SB_GRP2(pA0, 4, 1); PK4(pA0, 0, pa0); ASBAR();
        V_MM(0, pa0); V_RD(1); SB_GRP2(pA0, 8, 2); SB_GRP2(pA0, 12, 3); PK4(pA0, 8, pa1); ASBAR();
        V_MM(1, pa1); V_RD(2); SB_GRP2(pA1, 0, 4); SB_GRP2(pA1, 4, 5); PK4(pA1, 0, pa2); ASBAR();
        V_MM(2, pa2); V_RD(3); SB_GRP2(pA1, 8, 6); SB_GRP2(pA1, 12, 7); PK4(pA1, 8, pa3); ASBAR();
        V_MM(3, pa3);
#undef SB_GRP2
#undef PK4
#undef V_RD
#undef V_MM
        { auto rr = __builtin_amdgcn_permlane32_swap(__float_as_uint(si[0]), __float_as_uint(si[0]), false, false); carry *= __uint_as_float(rr[0]) * __uint_as_float(rr[1]); }
        __syncthreads();
        pA0 = pB0; pA1 = pB1;
        bufp = buf; buf = bufn; bufn = (bufn == 2) ? 0 : bufn + 1;
    }
#undef KAD
    } else {
    constexpr bool STAG = ATT_STAGGER && !(EXP & 64);
    const bool grpB = STAG && wid >= 4;
    f32x16 p0 = {}, p1 = {};
    int buf = 0, bufn = 1, bufp = 2;
#define QK_STAGE() do { \
            const ALDS char* kbase = lds + buf * SHM_K; bf16x8 f[2][4]; \
            p0 = f32x16{}; p1 = f32x16{}; \
            QK_RD(0); ASBAR(); if (ATT_PRIO) __builtin_amdgcn_s_setprio(1); \
            _Pragma("unroll") for (int g = 0; g < NQ / 2; ++g) { if (g + 1 < NQ / 2) QK_RD(g + 1); QK_MM(g); ASBAR(); } if (ATT_PRIO) __builtin_amdgcn_s_setprio(0); } while (0)
#define QK_AD(d0) (kbase + (MODE == 0 ? kb[(d0) & 3] + ((d0) >> 2) * 128 : (((d0) >> 2) ? (kb[(d0) & 3] ^ 128) : kb[(d0) & 3])))
#define QK_RD(g) do { const int gg_ = (g) % (NQ / 4), hf_ = (g) / (NQ / 4); \
                if (!((EXP & 512) && hf_ == 1)) { _Pragma("unroll") for (int q_ = 0; q_ < 4; ++q_) f[(g) & 1][q_] = *(const ALDS bf16x8*)(QK_AD(4 * gg_ + q_) + hf_ * 32 * KROW); } } while (0)
#define QK_MM(g) do { const int gg_ = (g) % (NQ / 4), hf_ = (g) / (NQ / 4); \
                _Pragma("unroll") for (int q_ = 0; q_ < 4; ++q_) { if (hf_ == 0) p0 = __builtin_amdgcn_mfma_f32_32x32x16_bf16(f[(g) & 1][q_], qr[4 * gg_ + q_], p0, 0, 0, 0); else if (EXP & 256) asm volatile("" :: "v"(f[(g) & 1][q_])); else p1 = __builtin_amdgcn_mfma_f32_32x32x16_bf16(f[(g) & 1][q_], qr[4 * gg_ + q_], p1, 0, 0, 0); } } while (0)
#define SMPV_STAGE(jt, vbuf) do { bf16x8 pa0, pa1, pa2, pa3; \
            if (!(EXP & 1) && !((EXP & 128) && wid < 4)) sm_stage<MODE>(p0, p1, o, m_reg, l_reg, carry, (jt) * KVBLK, qlo, r32, hi, wsf, pa0, pa1, pa2, pa3); else pack_p(p0, p1, pa0, pa1, pa2, pa3); \
            if (!(EXP & 2) && !((EXP & 128) && wid >= 4)) { if (ATT_PRIO) __builtin_amdgcn_s_setprio(1); pv_tile(o, vp0 + (vbuf) * SHM_V, pa0, pa1, pa2, pa3); if (ATT_PRIO) __builtin_amdgcn_s_setprio(0); } else { o[0][0] += __builtin_bit_cast(float, (int)pa0[0] + (int)pa1[1] + (int)pa2[2] + (int)pa3[3]); } } while (0)
#define ACTIVE(jt) ((MODE == 0) ? ((jt) * KVBLK <= qlo + QBLK - 1) : ((jt) * KVBLK < qlo + QBLK - 1))
    constexpr int LPK = (MODE == 0) ? 5 : 4;
    const int tk_ = tid / LPK, tp_ = tid - LPK * tk_;
    const bf16_t* tsrc = (MODE == 0) ? ((tp_ < 4) ? KVp + (tok0 + tk_) * 2048 + h * 256 + tp_ * 64 : KRp + (tok0 + tk_) * 64) : KVp + (tok0 + tk_) * 2048 + (tp_ >> 1) * 1024 + h * 128 + (tp_ & 1) * 64;
    const int tstr = (MODE == 0 && tp_ >= 4) ? 64 : 2048;
    unsigned tchA = 0, tchB = 0;
#define TOUCH_(reg) do { asm volatile("" :: "v"(reg)); if (s + ATT_TOUCH < NT && tid < 64 * LPK) reg = *(const unsigned*)(tsrc + (size_t)TILE_OF(s + ATT_TOUCH) * KVBLK * tstr); } while (0)
#define MID_STAGE() do { if (!(EXP & 8) && s + 1 < NT) { ST_WRITE(bufn); \
            if (s + 2 < NT) ST_LOAD(TILE_OF(s + 2)); \
            if (ATT_TOUCH) { if (s & 1) TOUCH_(tchA); else TOUCH_(tchB); } } } while (0)
    const int NSTEP = STAG ? NT + 1 : NT;
    ALDS unsigned* vote = (ALDS unsigned*)(lds + OFF_S);
    for (int s = 0; s < NSTEP; ++s) {
        const int j = TILE_OF(s);
        const int jy = grpB ? TILE_OF(s - 1) : j; const int vby = grpB ? bufp : buf;
        const bool dead = (MODE == 1 && ATT_SB_SKIP) && __all(carry == 0.0f);
        const bool actq = s < NT && ACTIVE(j) && !(EXP & 4) && !((EXP & 128) && wid >= 4) && !dead, acty = (grpB ? s > 0 : s < NT) && ACTIVE(jy) && !dead;
        if (!grpB && actq) QK_STAGE();
        MID_STAGE();
        if (acty) SMPV_STAGE(jy, vby);
        if (grpB && actq) QK_STAGE();
        if (MODE == 1 && ATT_SB_SKIP) { const bool deadn = __all(carry == 0.0f); if (lane == 0) vote[(s & 1) * 8 + wid] = deadn ? 1u : 0u; }
        __syncthreads();
        bufp = buf; buf = bufn; bufn = (bufn == 2) ? 0 : bufn + 1;
        if (MODE == 1 && ATT_SB_SKIP) { const ALDS unsigned* vv = vote + (s & 1) * 8; const unsigned all8 = vv[0] & vv[1] & vv[2] & vv[3] & vv[4] & vv[5] & vv[6] & vv[7];
            if (__builtin_amdgcn_readfirstlane((int)all8)) break; }
    }
#undef QK_STAGE
#undef QK_AD
#undef QK_RD
#undef QK_MM
#undef SMPV_STAGE
#undef ACTIVE
#undef MID_STAGE
    }
    { int le_ = (int)__builtin_amdgcn_mbcnt_hi(~0u, __builtin_amdgcn_mbcnt_lo(~0u, 0u)); asm volatile("" : "+v"(le_));
      const int r32e = le_ & 31, hie = le_ >> 5;
      ALDS float* wse = (ALDS float*)(lds + OFF_S) + wid * 64;
      float rli[16];
      if (MODE == 0) { if (hie == 0) wse[32 + r32e] = l_reg; asm volatile("s_waitcnt lgkmcnt(0)" ::: "memory");
#pragma unroll
          for (int r = 0; r < 16; ++r) rli[r] = __builtin_amdgcn_rcpf(wse[32 + crow(r, hie)]);
      } else {
#pragma unroll
          for (int r = 0; r < 16; ++r) rli[r] = 1.f; }
      __syncthreads();
      ALDS unsigned* stg = (ALDS unsigned*)(lds + OFF_K) + wid * 2048;
#pragma unroll
      for (int r = 0; r < 16; ++r) { const int orow = crow(r, hie);
#pragma unroll
          for (int d0 = 0; d0 < 4; ++d0) { const float v = o[d0][r] * rli[r]; const float vn = __int_as_float(__builtin_amdgcn_mov_dpp(__float_as_int(v), 0xB1  , 0xF, 0xF, true));
              if ((r32e & 1) == 0) stg[orow * 64 + d0 * 16 + (r32e >> 1)] = cvtpk(v, vn); } }
      asm volatile("s_waitcnt lgkmcnt(0)" ::: "memory");
      bf16_t* Ow = Op + (tok0 + qlo) * 1024 + h * 128;
#pragma unroll
      for (int i = 0; i < 8; ++i) { const int row = (le_ >> 4) + 4 * i, ch = le_ & 15; const u32x4 w = *(const ALDS u32x4*)(stg + row * 64 + ch * 4);
          *(u32x4*)(Ow + (size_t)row * 1024 + ch * 8) = w; } }
    asm volatile("s_waitcnt lgkmcnt(0)" ::: "memory");
    __syncthreads();
#undef ST_LOAD
#undef ST_WRITE
#undef TILE_OF
}
#undef ASBAR
}

constexpr int NWAVES = 8;
#ifndef MK_PER_PHASE
#define MK_PER_PHASE 0
#endif
#ifndef MK_STAMP_A
#define MK_STAMP_A -1
#define MK_STAMP_B -1
#endif
#ifndef MK_STAMP_Q
#define MK_STAMP_Q 2000u
#endif
#ifndef MK_STAMP_T0
#define MK_STAMP_T0 100.0f
#endif
constexpr int BATCH = 8, SEQ = 4096, DM = 1024, NTOK = BATCH * SEQ;
constexpr int QLORA = 384, QLP = 512  , KVLORA = 256, ROPE = 64, NLAT = 704, NLATP = 768, NHEAD = 8;
constexpr int NQ = NHEAD * 192, NKV = NHEAD * 256, DFF = 3584, NGU = 2 * DFF, NEXP = 8;
constexpr int MOE_ROWS = 2 * NTOK + NEXP * 256;
constexpr float EPSN = 1e-6f;
constexpr int XSP = 2048;
constexpr float C2_MLA = 1.4426950408889634f * 0.07216878364870322f;
constexpr float C2_SB = 1.4426950408889634f * 0.08838834764831845f;
constexpr size_t MiB = 1u << 20;
constexpr size_t WS_CTL = 0, CTL_ZERO_BYTES = 1 * MiB;
constexpr size_t WS_MOD = 1 * MiB;
constexpr size_t WS_MODKV = WS_MOD + (size_t)2 * 8 * 6144 * 4;
constexpr size_t WS_RT_E = 2 * MiB, WS_RT_POS = WS_RT_E + 256 * 1024, WS_RT_W = WS_RT_POS + 256 * 1024;
constexpr size_t WS_COS = 4 * MiB;
constexpr size_t WS_WAD = 12 * MiB, WS_WUQ = 14 * MiB, WS_WUKV = 16 * MiB, WS_WOA = 18 * MiB, WS_WKVSB = 20 * MiB, WS_WQSB = 24 * MiB, WS_WOSB = 26 * MiB;
constexpr size_t WS_WDN = 28 * MiB, WS_WGU = 36 * MiB, WS_WEGU = 50 * MiB, WS_WEDN = 162 * MiB;
constexpr size_t WS_HB0 = 224 * MiB, WS_LAT = 288 * MiB, WS_CQ = 384 * MiB, WS_CKV = 416 * MiB, WS_KROT = 720 * MiB, WS_Q = 432 * MiB, WS_KV = 528 * MiB, WS_AO = 656 * MiB;
constexpr size_t WS_ACT = 288 * MiB;
constexpr size_t WS_HB1 = 288 * MiB, WS_KVSB = 352 * MiB, WS_QSB = 480 * MiB;
constexpr size_t WS_HS = 224 * MiB, WS_ACT2 = 356 * MiB, WS_Y = 224 * MiB;
constexpr size_t WS_SLAB = WS_WEGU;
constexpr int MOE_MAIN_TILES = 256;
constexpr size_t WS_END = 818 * MiB;
static_assert(WS_ACT2 + (size_t)MOE_ROWS * DFF * 2 <= WS_END && WS_HS + (size_t)MOE_ROWS * DM * 2 <= WS_ACT2 && WS_WEDN + (size_t)NEXP * DM * DFF * 2 <= WS_HB0, "d_ws map");
constexpr int CW_TMO = 0, CW_CODE = 1;
constexpr int CW_BAR = 4096;
constexpr int CW_CNT = 16384;
constexpr int CW_CHK = 20480;
constexpr int CW_STAMP = 28672;
constexpr int CW_TRQ = 24576;
constexpr int RING_OFF = 0, RING_BYTES = 131072;
constexpr int LDSCTL_OFF = RING_BYTES, MISC_OFF = LDSCTL_OFF + 320;
constexpr int LDS_BYTES = 147456;
static_assert(MISC_OFF + 128 <= LDS_BYTES && att::LDS_BYTES <= RING_BYTES, "LDS map");

#define GAS __attribute__((address_space(1)))
#define LAS __attribute__((address_space(3)))
typedef unsigned short bf16;
typedef unsigned v4u __attribute__((ext_vector_type(4)));
typedef unsigned v2u __attribute__((ext_vector_type(2)));
typedef float f32x4 __attribute__((ext_vector_type(4)));
typedef float f32x2 __attribute__((ext_vector_type(2)));
typedef GAS unsigned gu32;
#define RLX_AGENT __ATOMIC_RELAXED, __HIP_MEMORY_SCOPE_AGENT
#define LDS_WAIT() asm volatile("s_waitcnt lgkmcnt(0)" ::: "memory")
#define VM_WAIT() asm volatile("s_waitcnt vmcnt(0)" ::: "memory")
__device__ __forceinline__ unsigned f2bf(float f) { unsigned u = __builtin_bit_cast(unsigned, f); return (u + 0x7fffu + ((u >> 16) & 1u)) >> 16; }
__device__ __forceinline__ unsigned pk2(float lo, float hi) { return f2bf(lo) | (f2bf(hi) << 16); }
__device__ __forceinline__ float bf2f(unsigned short h) { return __builtin_bit_cast(float, (unsigned)h << 16); }


#define XB_TMO      128
#define XB_XCNT(j)  (256  + 64 * (j))
#define XB_XSUB(j)  (1280 + 64 * (j))
#define XB_XGEN(j)  (2304 + 64 * (j))
#define XB_TOP      3328
#define XB_TOPGEN   3392
#define XCD_BAR_WORDS 3456
#define XB_SPIN_CAP (1u << 18)

__device__ __forceinline__ unsigned xb_ld(unsigned* p)              { return __hip_atomic_load(p, __ATOMIC_RELAXED, __HIP_MEMORY_SCOPE_AGENT); }
__device__ __forceinline__ unsigned xb_add(unsigned* p, unsigned v) { return __hip_atomic_fetch_add(p, v, __ATOMIC_RELAXED, __HIP_MEMORY_SCOPE_AGENT); }
__device__ __forceinline__ unsigned xb_xcc_id() { return (unsigned)__builtin_amdgcn_s_getreg((3 << 11) | 20) & 0xFu; }
#define XB_SPIN(cond, bar) do { unsigned _sp = 0; while (cond) { __builtin_amdgcn_s_sleep(1); \
    if ((++_sp & 255u) == 0u) { if (xb_ld(&(bar)[XB_TMO])) break; if (_sp > XB_SPIN_CAP) { atomicAdd(&(bar)[XB_TMO], 1u); break; } } } } while (0)

struct XcdBarrier {
    unsigned* bar; unsigned x;
    int w0;
    volatile LAS unsigned* st;
};

__device__ __forceinline__ XcdBarrier xcd_barrier_post(unsigned* bar, volatile LAS unsigned* st) {
    XcdBarrier b; b.bar = bar; b.x = xb_xcc_id(); b.st = st; b.w0 = __builtin_amdgcn_readfirstlane((int)(threadIdx.x >> 6));
    if (threadIdx.x == 0) (void)xb_add(&bar[XB_XCNT(b.x)], 1u);
    return b;
}
__device__ __forceinline__ void xcd_barrier_complete(unsigned* bar, unsigned x, unsigned& nloc, unsigned& nx) {
    const unsigned G = gridDim.x * gridDim.y * gridDim.z;
    unsigned sum, cnt, mine, sp = 0u;
    for (;;) {
        sum = 0u; cnt = 0u; mine = 0u;
#pragma unroll
        for (unsigned j = 0; j < 16; ++j) { const unsigned c = xb_ld(&bar[XB_XCNT(j)]); sum += c; cnt += (c > 0u) ? 1u : 0u; mine = (j == x) ? c : mine; }
        if (sum == G) break;
        __builtin_amdgcn_s_sleep(1);
        if ((++sp & 255u) == 0u) { if (xb_ld(&bar[XB_TMO])) break; if (sp > XB_SPIN_CAP) { atomicAdd(&bar[XB_TMO], 1u); break; } }
    }
    nloc = mine > 0u ? mine : 1u; nx = cnt > 0u ? cnt : 1u;
}

__device__ __forceinline__ void xcd_barrier(const XcdBarrier& b) {
    asm volatile("s_waitcnt vmcnt(0)" ::: "memory");
    __syncthreads();
    if (b.w0 == 0 && __builtin_amdgcn_mbcnt_hi(~0u, __builtin_amdgcn_mbcnt_lo(~0u, 0u)) == 0u) {
        unsigned* bar = b.bar;
        __builtin_amdgcn_s_waitcnt(0);
        unsigned nloc = b.st[0], nx = b.st[1];
        if (nloc == 0u) { xcd_barrier_complete(bar, b.x, nloc, nx); b.st[0] = nloc; b.st[1] = nx; }
        const unsigned old = xb_add(&bar[XB_XSUB(b.x)], 1u);
        const unsigned gen = old / nloc;
        if (old + 1u == (gen + 1u) * nloc) {
            __builtin_amdgcn_fence(__ATOMIC_RELEASE, "agent");
            asm volatile("s_waitcnt vmcnt(0)" ::: "memory");
            const unsigned og = xb_add(&bar[XB_TOP], 1u);
            const unsigned tg = og / nx;
            if (og + 1u == (tg + 1u) * nx) xb_add(&bar[XB_TOPGEN], 1u);
            else XB_SPIN(xb_ld(&bar[XB_TOPGEN]) == tg, bar);
            __builtin_amdgcn_fence(__ATOMIC_ACQUIRE, "agent");
            xb_add(&bar[XB_XGEN(b.x)], 1u);
            asm volatile("s_waitcnt vmcnt(0)" ::: "memory");
        } else {
            XB_SPIN(xb_ld(&bar[XB_XGEN(b.x)]) == gen, bar);
            __builtin_amdgcn_fence(__ATOMIC_ACQUIRE, "agent");
            asm volatile("s_waitcnt vmcnt(0)" ::: "memory");
        }
    }
    __syncthreads();
}


struct Frame {
    LAS unsigned char* lds;
    volatile LAS unsigned* MISC;
    gu32* ctl;
    int tid, lane, wave;
    int vcu, G;
    unsigned char* ws;
};
struct Args { const float* in[26]; float* out; unsigned char* ws; float inv[32]; int ph_lo, ph_hi, li, pad; };

#define WS_DPP(v, ctrl) __builtin_bit_cast(float, __builtin_amdgcn_update_dpp(0, __builtin_bit_cast(int, (v)), (ctrl), 0xf, 0xf, true))
__device__ __forceinline__ float wave_sum(float v) {
    v += WS_DPP(v, 0xB1); v += WS_DPP(v, 0x4E);
    v += WS_DPP(v, 0x141); v += WS_DPP(v, 0x140);
    { auto rr = __builtin_amdgcn_permlane16_swap(__float_as_uint(v), __float_as_uint(v), false, false); v = __uint_as_float(rr[0]) + __uint_as_float(rr[1]); }
    { auto rr = __builtin_amdgcn_permlane32_swap(__float_as_uint(v), __float_as_uint(v), false, false); v = __uint_as_float(rr[0]) + __uint_as_float(rr[1]); }
    return v;
}
__device__ __forceinline__ int rope_src(int p) { const int g = p >> 3, jj = p & 7; return jj < 4 ? 4 * g + jj : 32 + 4 * g + (jj - 4); }
__device__ __forceinline__ int src_col(int kind, int rho) {
    if (kind == 1) return rho < 640 ? rho : (rho < 704 ? 640 + rope_src(rho - 640) : -1);
    if (kind == 2) { if (rho < 1024) return (rho >> 7) * 192 + (rho & 127); const int r = rho - 1024; return (r >> 6) * 192 + 128 + rope_src(r & 63); }
    if (kind == 3) { const int t = rho >> 8, r = rho & 255; return r < 128 ? t * 128 + r : DFF + t * 128 + (r - 128); }
    return rho;
}
#ifndef TR_BATCH
#define TR_BATCH 1
#endif
#ifndef TR_NTST
#define TR_NTST 1
#endif
#ifndef TR_KFAST
#define TR_KFAST 0
#endif
struct TrItem { f32x4 v[16]; };
__device__ __forceinline__ void tr_load(TrItem& t, const float* W, int K, int N, int kind, int item, int nblk, int lane, int nkb) {
    const int kb = TR_KFAST ? item % nkb : item / nblk, nb = TR_KFAST ? item / nkb : item % nblk, k0 = 128 * kb, n0 = 32 * nb, kq = lane >> 3, nq = lane & 7;
    const int sc = src_col(kind, n0 + 4 * nq);
#pragma unroll
    for (int i = 0; i < 8; ++i) { const int k = k0 + 16 * i + 2 * kq;
        const bool ok = sc >= 0 && k < K;
        t.v[2 * i] = ok ? __builtin_nontemporal_load((const f32x4*)(W + (size_t)k * N + sc)) : (f32x4){0.f, 0.f, 0.f, 0.f};
        t.v[2 * i + 1] = ok ? __builtin_nontemporal_load((const f32x4*)(W + (size_t)(k + 1) * N + sc)) : (f32x4){0.f, 0.f, 0.f, 0.f}; }
}
__device__ __forceinline__ void tr_store(const TrItem& t, bf16* WT, int Kd, LAS unsigned* T, int item, int nblk, int lane, int pexp = 0) {
    const int nkb = Kd / 128; const int kb = TR_KFAST ? item % nkb : item / nblk, nb = TR_KFAST ? item / nkb : item % nblk, k0 = 128 * kb, n0 = 32 * nb, kq = lane >> 3, nq = lane & 7;
#pragma unroll
    for (int i = 0; i < 8; ++i) { const f32x4 a = t.v[2 * i], b = t.v[2 * i + 1]; LAS unsigned* p = T + (4 * nq) * 65 + 8 * i + kq;
        p[0] = pg8::cvt_pk_bf16(a.x, b.x); p[65] = pg8::cvt_pk_bf16(a.y, b.y); p[130] = pg8::cvt_pk_bf16(a.z, b.z); p[195] = pg8::cvt_pk_bf16(a.w, b.w); }
    LDS_WAIT(); asm volatile("" ::: "memory");
    const int c = lane & 15, nl = lane >> 4;
#pragma unroll
    for (int j = 0; j < 8; ++j) { const int n = nl + 4 * j; const LAS unsigned* s = T + n * 65 + 4 * c;
        v4u o; o.x = s[0]; o.y = s[1]; o.z = s[2]; o.w = s[3];
        if (!(pexp & 8) || o.x == 0x12345678u) { if (TR_NTST) __builtin_nontemporal_store(o, (GAS v4u*)(WT + (size_t)(n0 + n) * Kd + k0 + 8 * c)); else *(GAS v4u*)(WT + (size_t)(n0 + n) * Kd + k0 + 8 * c) = o; } }
    LDS_WAIT(); asm volatile("" ::: "memory");
}
struct TrDesc { const float* W; bf16* WT; int K, N, Kd, kind, nblk; };
constexpr int TR_NITEMS = NEXP * (DM / 64) * (NGU / 64) + NEXP * (DFF / 64) * (DM / 64) + (DM / 64) * (NGU / 64) + (DFF / 64) * (DM / 64) + (DM / 64) * (NLATP / 64) + (QLP / 64) * (NQ / 64) + (KVLORA / 64) * (NKV / 64) + 3 * (DM / 64) * (DM / 64) + (DM / 64) * (2048 / 64);
__device__ __forceinline__ bool tr_decode(Frame& F, const Args& a, int it, TrDesc& d, int& r) {
    constexpr int I_EGU = (DM / 64) * (NGU / 64), I_EDN = (DFF / 64) * (DM / 64);
    constexpr int I_GU = I_EGU, I_DN = I_EDN, I_AD = (DM / 64) * (NLATP / 64), I_UQ = (QLP / 64) * (NQ / 64), I_UKV = (KVLORA / 64) * (NKV / 64);
    constexpr int I_SQ = (DM / 64) * (DM / 64), I_KVSB = (DM / 64) * (2048 / 64);
    constexpr int NITEMS = NEXP * I_EGU + NEXP * I_EDN + I_GU + I_DN + I_AD + I_UQ + I_UKV + 3 * I_SQ + I_KVSB;
    static_assert(NITEMS == TR_NITEMS, "item count"); if (it >= NITEMS) return false;
    r = it;
    if (r < NEXP * I_EGU) { const int e = r / I_EGU; r -= e * I_EGU; d = TrDesc{a.in[23] + (size_t)e * DM * NGU, (bf16*)(F.ws + WS_WEGU) + (size_t)e * NGU * DM, DM, NGU, DM, 3, NGU / 32}; return true; } r -= NEXP * I_EGU;
    if (r < NEXP * I_EDN) { const int e = r / I_EDN; r -= e * I_EDN; d = TrDesc{a.in[24] + (size_t)e * DFF * DM, (bf16*)(F.ws + WS_WEDN) + (size_t)e * DM * DFF, DFF, DM, DFF, 0, DM / 32}; return true; } r -= NEXP * I_EDN;
    if (r < I_GU) { d = TrDesc{a.in[19], (bf16*)(F.ws + WS_WGU), DM, NGU, DM, 3, NGU / 32}; return true; } r -= I_GU;
    if (r < I_DN) { d = TrDesc{a.in[20], (bf16*)(F.ws + WS_WDN), DFF, DM, DFF, 0, DM / 32}; return true; } r -= I_DN;
    if (r < I_SQ) { d = TrDesc{a.in[12], (bf16*)(F.ws + WS_WOA), DM, DM, DM, 0, DM / 32}; return true; } r -= I_SQ;
    if (r < I_SQ) { d = TrDesc{a.in[17], (bf16*)(F.ws + WS_WQSB), DM, DM, DM, 0, DM / 32}; return true; } r -= I_SQ;
    if (r < I_SQ) { d = TrDesc{a.in[18], (bf16*)(F.ws + WS_WOSB), DM, DM, DM, 0, DM / 32}; return true; } r -= I_SQ;
    if (r < I_KVSB) { d = TrDesc{a.in[16], (bf16*)(F.ws + WS_WKVSB), DM, 2048, DM, 0, 2048 / 32}; return true; } r -= I_KVSB;
    if (r < I_AD) { d = TrDesc{a.in[7], (bf16*)(F.ws + WS_WAD), DM, NLAT, DM, 1, NLATP / 32}; return true; } r -= I_AD;
    if (r < I_UQ) { d = TrDesc{a.in[10], (bf16*)(F.ws + WS_WUQ), QLORA, NQ, QLP, 2, NQ / 32}; return true; } r -= I_UQ;
    d = TrDesc{a.in[11], (bf16*)(F.ws + WS_WUKV), KVLORA, NKV, KVLORA, 0, NKV / 32}; return true;
}
constexpr int TR_EARLY0 = TR_NITEMS - ((DM / 64) * (NLATP / 64) + (QLP / 64) * (NQ / 64) + (KVLORA / 64) * (NKV / 64));
template <int BATCH = TR_BATCH>
__device__ __forceinline__ void tr_run(Frame& F, const Args& a, int qbase, int lo, int hi, int pexp = 0) {
    LAS unsigned* T = (LAS unsigned*)(F.lds + RING_OFF + F.wave * 8448);
    const int q0 = (int)(xb_xcc_id() & 7u);
    int qd = 0;
    TrItem cur, nxt; TrDesc dc, dn; int rc = 0, rn = 0;
    int bq = 0, bl = 0, bqq = 0;
#define TR_NEXT(itv) do { itv = -1; \
        while (bl == 0 && qd < 8) { const int qq_ = (q0 + qd) & 7; gu32* head_ = F.ctl + CW_TRQ + qbase + 64 * qq_; const int nq_ = (hi - lo - qq_ + 7) >> 3; \
            int c_ = nq_; if (qd == 0 || (int)__hip_atomic_load(head_, RLX_AGENT) < nq_) { c_ = 0; if (F.lane == 0) c_ = (int)__hip_atomic_fetch_add(head_, (unsigned)BATCH, RLX_AGENT); c_ = __builtin_amdgcn_readfirstlane(c_); } \
            if (c_ < nq_) { bq = c_; bl = (nq_ - c_ < BATCH) ? nq_ - c_ : BATCH; bqq = qq_; } else ++qd; } \
        if (bl > 0) { itv = lo + bq * 8 + bqq; ++bq; --bl; } } while (0)
    int it; TR_NEXT(it);
    bool have = it >= 0 && tr_decode(F, a, it, dc, rc);
    if (have) tr_load(cur, dc.W, dc.K, dc.N, dc.kind, rc, dc.nblk, F.lane, dc.Kd / 128);
    while (have) {
        int itn; TR_NEXT(itn);
        const bool haven = itn >= 0 && tr_decode(F, a, itn, dn, rn);
        if (haven) tr_load(nxt, dn.W, dn.K, dn.N, dn.kind, rn, dn.nblk, F.lane, dn.Kd / 128);
        tr_store(cur, dc.WT, dc.Kd, T, rc, dc.nblk, F.lane, pexp);
        cur = nxt; dc = dn; rc = rn; have = haven;
    }
#undef TR_NEXT
}

__device__ __forceinline__ void p0_prologue(Frame& F, const Args& a, int qbase = 0, int pexp = 0) {
    if (!(pexp & 1)) {
        LAS float* sl = (LAS float*)(F.lds + RING_OFF);
        LAS float* red = (LAS float*)(F.lds + RING_OFF + 32768);
        float* MOD = (float*)(F.ws + WS_MOD); float* MODKV = (float*)(F.ws + WS_MODKV);
        const int bxg = (int)blockIdx.x;
        if (bxg < 112) {
            for (int i = F.tid; i < 8192; i += NWAVES * 64) { const float c = a.in[1][i]; sl[i] = c / (1.0f + __expf(-c)); }
            __syncthreads();
        }
        for (int cg = bxg; cg < 112; cg += F.G) {
            const float* W; const float* bias; float* out; int ldw, ldo, col0;
            if (cg < 48) { W = a.in[3]; bias = a.in[4]; out = MOD; ldw = 6144; ldo = 6144; col0 = cg * 128; }
            else if (cg < 96) { W = a.in[3] + (size_t)DM * 6144; bias = a.in[4] + 6144; out = MOD + 8 * 6144; ldw = 6144; ldo = 6144; col0 = (cg - 48) * 128; }
            else { W = a.in[13]; bias = a.in[14]; out = MODKV; ldw = 2048; ldo = 2048; col0 = (cg - 96) * 128; }
            f32x4 acc[8];
#pragma unroll
            for (int b = 0; b < 8; ++b) acc[b] = (f32x4){0.f, 0.f, 0.f, 0.f};
            const int half = F.lane >> 5, l32 = F.lane & 31;
            const float* wp = W + (size_t)(F.wave * 128 + half) * ldw + col0 + 4 * l32;
            for (int k8 = 0; k8 < 64; k8 += 8) {
                f32x4 wv[8];
#pragma unroll
                for (int u = 0; u < 8; ++u) wv[u] = __builtin_nontemporal_load((const f32x4*)(wp + (size_t)(2 * (k8 + u)) * ldw));
#pragma unroll
                for (int u = 0; u < 8; ++u) {
#pragma unroll
                    for (int b = 0; b < 8; ++b) { const float s = sl[b * 1024 + F.wave * 128 + 2 * (k8 + u) + half]; acc[b] += wv[u] * s; } }
            }
#pragma unroll
            for (int b = 0; b < 8; ++b) *(LAS f32x4*)(red + ((F.wave * 2 + half) * 8 + b) * 128 + 4 * l32) = acc[b];
            __syncthreads();
            for (int idx = F.tid; idx < 1024; idx += NWAVES * 64) { const int b = idx >> 7, col = idx & 127; float s = bias[col0 + col];
#pragma unroll
                for (int w = 0; w < 16; ++w) s += red[(w * 8 + b) * 128 + col];
                out[(size_t)b * ldo + col0 + col] = s; }
            __syncthreads();
        }
        __syncthreads();
    }
    if (!(pexp & 2)) {
        float* CS = (float*)(F.ws + WS_COS); const int* pos = (const int*)a.in[2];
        for (int idx = (F.vcu * NWAVES * 64) + F.tid; idx < NTOK * 32; idx += F.G * NWAVES * 64) {
            const int t = idx >> 5, i = idx & 31;
            const double rev = (double)pos[t] * (double)a.inv[i] * 0.15915494309189535;
            const float fr = (float)(rev - __builtin_rint(rev));
            CS[t * 64 + i] = __builtin_amdgcn_cosf(fr); CS[t * 64 + 32 + i] = __builtin_amdgcn_sinf(fr);
        }
    }
    if (!(pexp & 4)) tr_run(F, a, qbase, TR_EARLY0, TR_NITEMS, pexp);
    __syncthreads();
}

template <bool TWO, bool INB = false  >
__device__ __forceinline__ void norm_phase(Frame& F, const float* X, const float* g0, const float* sc0, const float* sh0, int st0, bf16* H0,
                                           const float* g1, const float* sc1, const float* sh1, int st1, bf16* H1) {
    const int gw = F.vcu * NWAVES + F.wave, NGW = F.G * NWAVES;
    for (int c = gw; c < NTOK / 16; c += NGW) {
        const int row0 = c * 16, b = row0 / SEQ;
        f32x4 A0[4], B0[4], A1[4], B1[4];
#pragma unroll
        for (int j = 0; j < 4; ++j) { const int col = 4 * F.lane + 256 * j;
            A0[j] = *(const f32x4*)(g0 + col) * (*(const f32x4*)(sc0 + (size_t)b * st0 + col) + 1.0f); B0[j] = *(const f32x4*)(sh0 + (size_t)b * st0 + col);
            if (TWO) { A1[j] = *(const f32x4*)(g1 + col) * (*(const f32x4*)(sc1 + (size_t)b * st1 + col) + 1.0f); B1[j] = *(const f32x4*)(sh1 + (size_t)b * st1 + col); } }
#pragma unroll 4
        for (int r = 0; r < 16; ++r) {
            const GAS f32x4* xr = (const GAS f32x4*)(X + (size_t)(row0 + r) * DM) + F.lane; const GAS v2u* xb = (const GAS v2u*)((const bf16*)X + (size_t)(row0 + r) * XSP) + F.lane;
            f32x4 v[4]; float s2 = 0.f;
#pragma unroll
            for (int j = 0; j < 4; ++j) { if (INB) { const v2u w = xb[64 * j]; v[j] = (f32x4){__uint_as_float(w.x << 16), __uint_as_float(w.x & 0xffff0000u), __uint_as_float(w.y << 16), __uint_as_float(w.y & 0xffff0000u)}; } else v[j] = xr[64 * j]; s2 += (v[j].x * v[j].x + v[j].y * v[j].y) + (v[j].z * v[j].z + v[j].w * v[j].w); }
            const float rstd = 1.0f / sqrtf(wave_sum(s2) * (1.0f / DM) + EPSN);
            GAS unsigned long long* o0 = (GAS unsigned long long*)(H0 + (size_t)(row0 + r) * DM) + F.lane;
#pragma unroll
            for (int j = 0; j < 4; ++j) { const f32x4 y = v[j] * rstd * A0[j] + B0[j]; o0[64 * j] = (unsigned long long)pk2(y.x, y.y) | ((unsigned long long)pk2(y.z, y.w) << 32); }
            if (TWO) { GAS unsigned long long* o1 = (GAS unsigned long long*)(H1 + (size_t)(row0 + r) * DM) + F.lane;
#pragma unroll
                for (int j = 0; j < 4; ++j) { const f32x4 y = v[j] * rstd * A1[j] + B1[j]; o1[64 * j] = (unsigned long long)pk2(y.x, y.y) | ((unsigned long long)pk2(y.z, y.w) << 32); } }
        }
    }
}

__device__ __forceinline__ void lat_phase(Frame& F, const Args& a) {
    const int gw = F.vcu * NWAVES + F.wave, NGW = F.G * NWAVES, l = F.lane;
    const float* LAT = (const float*)(F.ws + WS_LAT); const float* CS = (const float*)(F.ws + WS_COS);
    bf16* CQ = (bf16*)(F.ws + WS_CQ); bf16* CKV = (bf16*)(F.ws + WS_CKV); bf16* KR = (bf16*)(F.ws + WS_KROT);
    const f32x4 G0 = *(const f32x4*)(a.in[8] + 4 * l);
    const f32x4 G1 = l < 32 ? *(const f32x4*)(a.in[8] + 256 + 4 * l) : *(const f32x4*)(a.in[9] + 4 * (l - 32));
    const f32x4 G2 = l < 32 ? *(const f32x4*)(a.in[9] + 128 + 4 * l) : (f32x4){0.f, 0.f, 0.f, 0.f};
    for (int row = gw; row < NTOK; row += NGW) {
        const GAS v2u* xr = (const GAS v2u*)((const bf16*)LAT + (size_t)row * NLATP) + l;
        const v2u w0 = xr[0], w1 = xr[64], w2 = xr[128];
        const f32x4 v0 = (f32x4){__uint_as_float(w0.x << 16), __uint_as_float(w0.x & 0xffff0000u), __uint_as_float(w0.y << 16), __uint_as_float(w0.y & 0xffff0000u)};
        const f32x4 v1 = (f32x4){__uint_as_float(w1.x << 16), __uint_as_float(w1.x & 0xffff0000u), __uint_as_float(w1.y << 16), __uint_as_float(w1.y & 0xffff0000u)};
        const f32x4 v2 = (f32x4){__uint_as_float(w2.x << 16), __uint_as_float(w2.x & 0xffff0000u), __uint_as_float(w2.y << 16), __uint_as_float(w2.y & 0xffff0000u)};
        const float q0 = (v0.x * v0.x + v0.y * v0.y) + (v0.z * v0.z + v0.w * v0.w), q1 = (v1.x * v1.x + v1.y * v1.y) + (v1.z * v1.z + v1.w * v1.w), q2 = (v2.x * v2.x + v2.y * v2.y) + (v2.z * v2.z + v2.w * v2.w);
        const float sq = wave_sum(q0 + (l < 32 ? q1 : 0.f)), skv = wave_sum((l < 32 ? q2 : q1));
        const float rq = 1.0f / sqrtf(sq * (1.0f / QLORA) + EPSN), rkv = 1.0f / sqrtf(skv * (1.0f / KVLORA) + EPSN);
        { const f32x4 y = v0 * rq * G0; *(GAS unsigned long long*)(CQ + (size_t)row * QLP + 4 * l) = (unsigned long long)pk2(y.x, y.y) | ((unsigned long long)pk2(y.z, y.w) << 32); }
        { const f32x4 y = v1 * (l < 32 ? rq : rkv) * G1; bf16* dst = l < 32 ? CQ + (size_t)row * QLP + 256 + 4 * l : CKV + (size_t)row * KVLORA + 4 * (l - 32);
          *(GAS unsigned long long*)dst = (unsigned long long)pk2(y.x, y.y) | ((unsigned long long)pk2(y.z, y.w) << 32); }
        const int u = l - 32, g = (u >> 1) & 7;
        f32x4 pr; pr.x = __shfl_xor(v2.x, 1); pr.y = __shfl_xor(v2.y, 1); pr.z = __shfl_xor(v2.z, 1); pr.w = __shfl_xor(v2.w, 1);
        if (l < 32) { const f32x4 y = v2 * rkv * G2; *(GAS unsigned long long*)(CKV + (size_t)row * KVLORA + 128 + 4 * l) = (unsigned long long)pk2(y.x, y.y) | ((unsigned long long)pk2(y.z, y.w) << 32); }
        else { *(GAS unsigned long long*)(CQ + (size_t)row * QLP + QLORA + 4 * (l - 32)) = 0ull; }
        if (l >= 32 && l < 48) { const f32x4 cs = *(const f32x4*)(CS + (size_t)row * 64 + 4 * g), sn = *(const f32x4*)(CS + (size_t)row * 64 + 32 + 4 * g);
            const f32x4 y = (u & 1) ? (pr * sn + v2 * cs) : (v2 * cs - pr * sn);
            *(GAS unsigned long long*)(KR + (size_t)row * ROPE + 4 * u) = (unsigned long long)pk2(y.x, y.y) | ((unsigned long long)pk2(y.z, y.w) << 32); }
    }
}


__device__ __forceinline__ float rt_red32(float a, float b) { auto rr = __builtin_amdgcn_permlane32_swap(__float_as_uint(a), __float_as_uint(b), false, false); return __uint_as_float(rr[0]) + __uint_as_float(rr[1]); }
__device__ __forceinline__ float rt_red16(float a, float b) { auto rr = __builtin_amdgcn_permlane16_swap(__float_as_uint(a), __float_as_uint(b), false, false); return __uint_as_float(rr[0]) + __uint_as_float(rr[1]); }
__device__ __forceinline__ float rt_red8(const f32x4& lo, const f32x4& hi, bool bit3) {
    const float r0 = rt_red16(rt_red32(lo.x, lo.y), rt_red32(lo.z, lo.w)), r1 = rt_red16(rt_red32(hi.x, hi.y), rt_red32(hi.z, hi.w));
    float t = (bit3 ? r1 : r0) + WS_DPP(bit3 ? r0 : r1, 0x128);
    t += WS_DPP(t, 0x141); t += WS_DPP(t, 0xB1); t += WS_DPP(t, 0x4E);
    return t;
}
__device__ __forceinline__ void router_phase(Frame& F, const Args& a) {
    const int gw = F.vcu * NWAVES + F.wave, NGW = F.G * NWAVES, l = F.lane;
    const float* X = a.out; const float* MOD1 = (const float*)(F.ws + WS_MOD) + 8 * 6144;
    int* RT_E = (int*)(F.ws + WS_RT_E); int* RT_POS = (int*)(F.ws + WS_RT_POS); float* RT_W = (float*)(F.ws + WS_RT_W);
    LAS float* LG = (LAS float*)(F.lds + RING_OFF) + F.wave * 128;
    f32x4 wr[4][4][2];
#pragma unroll
    for (int j = 0; j < 4; ++j)
#pragma unroll
        for (int i = 0; i < 4; ++i) { const float* p = a.in[21] + (size_t)(4 * l + 256 * j + i) * 8; wr[j][i][0] = *(const f32x4*)p; wr[j][i][1] = *(const f32x4*)(p + 4); }
    const bool bit3 = (l & 8) != 0;
    const int my_exp = (int)((__float_as_uint(rt_red8((f32x4){1.f, 2.f, 4.f, 8.f}, (f32x4){16.f, 32.f, 64.f, 128.f}, bit3)) >> 23) & 0xffu) - 133;
    for (int c = gw; c < NTOK / 16; c += NGW) {
        const int row0 = c * 16, b = row0 / SEQ;
        f32x4 A0[4], B0[4];
#pragma unroll
        for (int j = 0; j < 4; ++j) { const int col = 4 * l + 256 * j;
            A0[j] = *(const f32x4*)(a.in[6] + DM + col) * (*(const f32x4*)(MOD1 + (size_t)b * 6144 + 4096 + col) + 1.0f); B0[j] = *(const f32x4*)(MOD1 + (size_t)b * 6144 + 3072 + col); }
        const GAS v2u* xr = (const GAS v2u*)((const bf16*)X + (size_t)row0 * XSP) + l;
        v2u wn[4];
#pragma unroll
        for (int j = 0; j < 4; ++j) wn[j] = xr[64 * j];
        for (int r = 0; r < 16; ++r) {
            v2u w[4];
#pragma unroll
            for (int j = 0; j < 4; ++j) w[j] = wn[j];
            const GAS v2u* xn = xr + (size_t)(r < 15 ? r + 1 : r) * (XSP / 4);
#pragma unroll
            for (int j = 0; j < 4; ++j) wn[j] = xn[64 * j];
            f32x4 v[4]; float s2 = 0.f;
#pragma unroll
            for (int j = 0; j < 4; ++j) { v[j] = (f32x4){__uint_as_float(w[j].x << 16), __uint_as_float(w[j].x & 0xffff0000u), __uint_as_float(w[j].y << 16), __uint_as_float(w[j].y & 0xffff0000u)}; s2 += (v[j].x * v[j].x + v[j].y * v[j].y) + (v[j].z * v[j].z + v[j].w * v[j].w); }
            const float rstd = 1.0f / sqrtf(wave_sum(s2) * (1.0f / DM) + EPSN);
            f32x4 lo = (f32x4){0.f, 0.f, 0.f, 0.f}, hi = (f32x4){0.f, 0.f, 0.f, 0.f};
#pragma unroll
            for (int j = 0; j < 4; ++j) { const f32x4 y = v[j] * rstd * A0[j] + B0[j];
                lo += wr[j][0][0] * y.x + wr[j][1][0] * y.y + wr[j][2][0] * y.z + wr[j][3][0] * y.w;
                hi += wr[j][0][1] * y.x + wr[j][1][1] * y.y + wr[j][2][1] * y.z + wr[j][3][1] * y.w; }
            const float t = rt_red8(lo, hi, bit3);
            if ((l & 7) == 0) LG[r * 8 + my_exp] = t;
        }
        LDS_WAIT(); asm volatile("" ::: "memory");
        int myE = -1, mypos = 0; float myW = 0.f;
        if (l < 32) {
            const f32x4 l0 = *(const LAS f32x4*)(LG + (l & 15) * 8), l1 = *(const LAS f32x4*)(LG + (l & 15) * 8 + 4);
            float lg[8] = {l0.x, l0.y, l0.z, l0.w, l1.x, l1.y, l1.z, l1.w};
#pragma unroll
            for (int e = 0; e < 8; ++e) lg[e] += a.in[22][e];
            int e1 = 0; float v1 = lg[0];
#pragma unroll
            for (int e = 1; e < 8; ++e) if (lg[e] > v1) { v1 = lg[e]; e1 = e; }
            int e2 = -1; float v2 = -__builtin_inff();
#pragma unroll
            for (int e = 0; e < 8; ++e) if (e != e1 && lg[e] > v2) { v2 = lg[e]; e2 = e; }
            const float tt = __expf(v2 - v1), w1 = 1.0f / (1.0f + tt), w2 = tt * w1;
            myE = l < 16 ? e1 : e2; myW = l < 16 ? w1 : w2;
        }
        LDS_WAIT(); asm volatile("" ::: "memory");
#pragma unroll
        for (int e = 0; e < 8; ++e) {
            const unsigned long long m = __ballot(myE == e); const int n = __popcll(m);
            unsigned base = 0;
            if (n > 0 && l == 0) base = __hip_atomic_fetch_add((unsigned*)(F.ctl + CW_CNT + 16 * e), (unsigned)n, RLX_AGENT);
            base = (unsigned)__builtin_amdgcn_readfirstlane((int)base);
            if (myE == e) mypos = (int)base + __popcll(m & ((1ull << l) - 1ull));
        }
        if (l < 32) { const int idx = (row0 + (l & 15)) * 2 + (l >> 4); RT_E[idx] = myE; RT_POS[idx] = mypos; RT_W[idx] = myW; }
    }
}
__device__ __forceinline__ void moe_offsets(Frame& F, unsigned (&cnt)[8], int (&off)[8]) {
    int t = 0;
#pragma unroll
    for (int e = 0; e < 8; ++e) { cnt[e] = __hip_atomic_load((unsigned*)(F.ctl + CW_CNT + 16 * e), RLX_AGENT); off[e] = t; t += (int)((cnt[e] + 255u) & ~255u); }
}
__device__ __forceinline__ void scatter_phase(Frame& F, const Args& a) {
    const int gw = F.vcu * NWAVES + F.wave, NGW = F.G * NWAVES, l = F.lane;
    const float* X = a.out; const float* MOD1 = (const float*)(F.ws + WS_MOD) + 8 * 6144;
    const int* RT_E = (const int*)(F.ws + WS_RT_E); const int* RT_POS = (const int*)(F.ws + WS_RT_POS);
    bf16* HS = (bf16*)(F.ws + WS_HS);
    unsigned cnt[8]; int off[8]; moe_offsets(F, cnt, off);
    for (int c = gw; c < NTOK / 16; c += NGW) {
        const int row0 = c * 16, b = row0 / SEQ;
        f32x4 A0[4], B0[4];
#pragma unroll
        for (int j = 0; j < 4; ++j) { const int col = 4 * l + 256 * j;
            A0[j] = *(const f32x4*)(a.in[6] + DM + col) * (*(const f32x4*)(MOD1 + (size_t)b * 6144 + 4096 + col) + 1.0f); B0[j] = *(const f32x4*)(MOD1 + (size_t)b * 6144 + 3072 + col); }
#pragma unroll 4
        for (int r = 0; r < 16; ++r) {
            const int row = row0 + r;
            const GAS v2u* xr = (const GAS v2u*)((const bf16*)X + (size_t)row * XSP) + l;
            f32x4 v[4]; float s2 = 0.f;
#pragma unroll
            for (int j = 0; j < 4; ++j) { const v2u w = xr[64 * j]; v[j] = (f32x4){__uint_as_float(w.x << 16), __uint_as_float(w.x & 0xffff0000u), __uint_as_float(w.y << 16), __uint_as_float(w.y & 0xffff0000u)}; s2 += (v[j].x * v[j].x + v[j].y * v[j].y) + (v[j].z * v[j].z + v[j].w * v[j].w); }
            const float rstd = 1.0f / sqrtf(wave_sum(s2) * (1.0f / DM) + EPSN);
            const int e1 = RT_E[row * 2], e2 = RT_E[row * 2 + 1], p1 = RT_POS[row * 2], p2 = RT_POS[row * 2 + 1];
            int o1 = 0, o2 = 0;
#pragma unroll
            for (int e = 0; e < 8; ++e) { o1 = (e1 == e) ? off[e] : o1; o2 = (e2 == e) ? off[e] : o2; }
            GAS unsigned long long* d1 = (GAS unsigned long long*)(HS + (size_t)(o1 + p1) * DM) + l; GAS unsigned long long* d2 = (GAS unsigned long long*)(HS + (size_t)(o2 + p2) * DM) + l;
#pragma unroll
            for (int j = 0; j < 4; ++j) { const f32x4 y = v[j] * rstd * A0[j] + B0[j]; const unsigned long long w = (unsigned long long)pk2(y.x, y.y) | ((unsigned long long)pk2(y.z, y.w) << 32); d1[64 * j] = w; d2[64 * j] = w; }
        }
    }
    for (int i = gw; i < 8 * 256; i += NGW) { const int e = i >> 8, r = i & 255; int oe = 0; unsigned ce = 0;
#pragma unroll
        for (int q = 0; q < 8; ++q) { oe = (e == q) ? off[q] : oe; ce = (e == q) ? cnt[q] : ce; }
        if (ce + (unsigned)r < ((ce + 255u) & ~255u)) { GAS unsigned long long* d = (GAS unsigned long long*)(HS + (size_t)(oe + (int)ce + r) * DM) + l;
#pragma unroll
            for (int j = 0; j < 4; ++j) d[64 * j] = 0ull; } }
}
__device__ __forceinline__ void load_yrow(const bf16* Y, int sr, int l, f32x4 (&y)[4]) {
    const GAS v2u* yr = (const GAS v2u*)(Y + (size_t)sr * DM) + l;
#pragma unroll
    for (int j = 0; j < 4; ++j) { const v2u a = yr[64 * j];
        y[j].x = __uint_as_float(a.x << 16); y[j].y = __uint_as_float(a.x & 0xffff0000u); y[j].z = __uint_as_float(a.y << 16); y[j].w = __uint_as_float(a.y & 0xffff0000u); }
}
__device__ __forceinline__ void slab_reduce_phase(Frame& F) {
    const int gw = F.vcu * NWAVES + F.wave, NGW = F.G * NWAVES, l = F.lane;
    bf16* Y = (bf16*)(F.ws + WS_Y); const float* SLAB = (const float*)(F.ws + WS_SLAB);
    unsigned cnt[8]; int off[8]; moe_offsets(F, cnt, off);
    int T = 0;
#pragma unroll
    for (int e = 0; e < 8; ++e) T += (int)((cnt[e] + 255u) >> 8);
    const int nleft = (T > MOE_MAIN_TILES ? T - MOE_MAIN_TILES : 0) * 4, S = (nleft * 14 <= F.G && !MK_FORCE_S7) ? 14 : 7;
    for (int it = gw; it < nleft * 256; it += NGW) { const int u4 = it >> 8, r = it & 255;
        const float* p = SLAB + (size_t)(u4 * S) * 65536 + (size_t)r * 256 + 4 * l;
        f32x4 t[14];
#pragma unroll
        for (int k = 0; k < 14; ++k) t[k] = (k < 7 || S == 14) ? *(const f32x4*)(p + (size_t)k * 65536) : (f32x4){0.f, 0.f, 0.f, 0.f};
        f32x4 s = t[0];
#pragma unroll
        for (int k = 1; k < 14; ++k) s += t[k];
        *(GAS unsigned long long*)(Y + (size_t)((MOE_MAIN_TILES + (u4 >> 2)) * 256 + r) * DM + (u4 & 3) * 256 + 4 * l) = (unsigned long long)pk2(s.x, s.y) | ((unsigned long long)pk2(s.z, s.w) << 32);
    }
}
__device__ __forceinline__ void final_phase(Frame& F, const Args& a) {
    const int gw = F.vcu * NWAVES + F.wave, NGW = F.G * NWAVES, l = F.lane;
    float* X = a.out; const float* MOD1 = (const float*)(F.ws + WS_MOD) + 8 * 6144;
    const int* RT_E = (const int*)(F.ws + WS_RT_E); const int* RT_POS = (const int*)(F.ws + WS_RT_POS); const float* RT_W = (const float*)(F.ws + WS_RT_W);
    const bf16* Y = (const bf16*)(F.ws + WS_Y);
    unsigned cnt[8]; int off[8]; moe_offsets(F, cnt, off);
    for (int c = gw; c < NTOK / 16; c += NGW) {
        const int row0 = c * 16, b = row0 / SEQ;
        f32x4 GT[4], GF[4];
#pragma unroll
        for (int j = 0; j < 4; ++j) { const int col = 4 * l + 256 * j; GT[j] = *(const f32x4*)(MOD1 + (size_t)b * 6144 + 5120 + col); GF[j] = *(const f32x4*)(a.in[25] + col); }
#pragma unroll 4
        for (int r = 0; r < 16; ++r) {
            const int row = row0 + r;
            GAS f32x4* xr = (GAS f32x4*)(X + (size_t)row * DM) + l; const GAS v2u* xs = (const GAS v2u*)((const bf16*)X + (size_t)row * XSP) + l;
            const int e1 = RT_E[row * 2], e2 = RT_E[row * 2 + 1], p1 = RT_POS[row * 2], p2 = RT_POS[row * 2 + 1]; const float w1 = RT_W[row * 2], w2 = RT_W[row * 2 + 1];
            int o1 = 0, o2 = 0;
#pragma unroll
            for (int e = 0; e < 8; ++e) { o1 = (e1 == e) ? off[e] : o1; o2 = (e2 == e) ? off[e] : o2; }
            f32x4 ya[4], yb[4];
            load_yrow(Y, o1 + p1, l, ya); load_yrow(Y, o2 + p2, l, yb);
            f32x4 v[4]; float s2 = 0.f;
#pragma unroll
            for (int j = 0; j < 4; ++j) { const v2u w = xs[64 * j]; const f32x4 x3 = (f32x4){__uint_as_float(w.x << 16), __uint_as_float(w.x & 0xffff0000u), __uint_as_float(w.y << 16), __uint_as_float(w.y & 0xffff0000u)};
                v[j] = x3 + GT[j] * (ya[j] * w1 + yb[j] * w2); s2 += (v[j].x * v[j].x + v[j].y * v[j].y) + (v[j].z * v[j].z + v[j].w * v[j].w); }
            const float rstd = 1.0f / sqrtf(wave_sum(s2) * (1.0f / DM) + EPSN);
#pragma unroll
            for (int j = 0; j < 4; ++j) { f32x4 ov = v[j] * rstd * GF[j];
                if (MK_STAMP_A >= 0) { const unsigned ta = __hip_atomic_load((unsigned*)(F.ctl + CW_STAMP + (MK_STAMP_A < 0 ? 0 : MK_STAMP_A)), RLX_AGENT), tb = __hip_atomic_load((unsigned*)(F.ctl + CW_STAMP + (MK_STAMP_B < 0 ? 0 : MK_STAMP_B)), RLX_AGENT);
                    const float cst = sqrtf((float)(((tb - ta) / MK_STAMP_Q) * MK_STAMP_Q) * 0.01f / MK_STAMP_T0); ov = (f32x4){cst, cst, cst, cst}; }
                xr[64 * j] = ov; }
        }
    }
}
template <int MODE, int EXP = 0>
__device__ __forceinline__ void attn_phase(Frame& F, unsigned qoff, unsigned kvoff, unsigned kroff, unsigned ooff) {
    for (int w = 0; ; ++w) {
        const int it = F.vcu + (w >> 1) * F.G; if (it >= BATCH * NHEAD * 8) break;
        const int bh = it >> 3, s = it & 7, b = bh >> 3, h = bh & 7;
        att::attn_unit<MODE, EXP>(b, h, (w & 1) ? s : 15 - s, (const bf16*)(F.ws + qoff), (const bf16*)(F.ws + kvoff), (const bf16*)(F.ws + kroff), (bf16*)(F.ws + ooff), (LAS char*)(F.lds + RING_OFF), F.wave);
    }
}
#ifndef MK_CONV_BATCH
#define MK_CONV_BATCH 8
#endif
#ifndef MK_CONV_MOD
#define MK_CONV_MOD 8
#endif
constexpr int CW_TRQ5 = CW_TRQ + 512, CW_ATQ = CW_TRQ + 2048;
#ifndef MK_ATQ_PAIRMAJOR
#define MK_ATQ_PAIRMAJOR 1
#endif
#ifndef MK_CONV_XCD
#define MK_CONV_XCD 0
#endif
template <int EXP = 0>
__device__ __forceinline__ void attn_phase_dyn(Frame& F, const Args& a, unsigned qoff, unsigned kvoff, unsigned kroff, unsigned ooff, int qb5 = 0  , int what = 3  ) {
    const int x0 = (F.G % 8 == 0) ? F.vcu / (F.G / 8) : 0;
    const bool conv = MK_CONV_XCD ? (x0 == 7) : (F.vcu % MK_CONV_MOD == 0);
    if ((what & 1) && conv) { tr_run<MK_CONV_BATCH>(F, a, 512 + qb5, 0, TR_EARLY0); }
    __syncthreads();
    constexpr int NQA = MK_CONV_XCD ? 7 : 8;
    const int xs = MK_CONV_XCD ? (conv ? F.vcu % 7 : x0) : x0;
    int qd = 0;
    for (;;) {
        if (F.tid == 0) {
            int item = -1;
            while ((what & 2) && !((what & 8) && conv) && qd < NQA) { const int qq = (xs + qd) % NQA, np = (64 - qq + NQA - 1) / NQA; const unsigned c = __hip_atomic_fetch_add(F.ctl + CW_ATQ + qb5 + 64 * qq, 1u, RLX_AGENT); if (c < 16u * (unsigned)np) { item = qq * 256 + (int)c; break; } ++qd; }
            F.MISC[16] = (unsigned)item;
        }
        __syncthreads();
        const int item = __builtin_amdgcn_readfirstlane((int)F.MISC[16]);
        if (item < 0) break;
        const int qq = item >> 8, j = item & 255, np = (64 - qq + NQA - 1) / NQA, bh = MK_ATQ_PAIRMAJOR ? qq + NQA * (j >> 4) : qq + NQA * (j % np), qb = MK_ATQ_PAIRMAJOR ? 15 - (j & 15) : 15 - j / np, b = bh >> 3, h = bh & 7;
        att::attn_unit<0, EXP>(b, h, qb, (const bf16*)(F.ws + qoff), (const bf16*)(F.ws + kvoff), (const bf16*)(F.ws + kroff), (bf16*)(F.ws + ooff), (LAS char*)(F.lds + RING_OFF), F.wave);
        __syncthreads();
    }
    __syncthreads();
    if ((what & 1) && !(what & 4)) tr_run<MK_CONV_BATCH>(F, a, 512 + qb5, 0, TR_EARLY0);
    __syncthreads();
}


constexpr int NPH = 20;
#ifndef MK_DUP_BAR
#define MK_DUP_BAR 0
#endif
#ifndef MK_ALIGN_SW
#define MK_ALIGN_SW true
#endif
#ifndef MK_WGM_BIG
#define MK_WGM_BIG 4
#define MK_WGM_SMALL 2
#endif
#ifndef MK_ATT_EXP
#define MK_ATT_EXP 0
#endif
#ifndef MK_DUP_MASK
#define MK_DUP_MASK 0
#endif
#ifndef MK_PHMASK
#define MK_PHMASK 0xfffff
#endif
__global__ void __launch_bounds__(NWAVES * 64, 2) yoco_fwd(Args args) {
    extern __shared__ __attribute__((aligned(16))) unsigned char lds[];
    Frame F;
    F.lds = (LAS unsigned char*)lds;
    F.MISC = (volatile LAS unsigned*)(F.lds + MISC_OFF);
    F.tid = threadIdx.x; F.lane = F.tid & 63; F.wave = __builtin_amdgcn_readfirstlane(F.tid >> 6);
    F.G = gridDim.x; { const int bx = blockIdx.x; F.vcu = (F.G % 8 == 0) ? (bx % 8) * (F.G / 8) + bx / 8 : bx; }
    F.ws = args.ws; F.ctl = (gu32*)(args.ws + WS_CTL);
    for (int u = F.tid; u < (LDS_BYTES - LDSCTL_OFF) / 4; u += NWAVES * 64) ((LAS unsigned*)(F.lds + LDSCTL_OFF))[u] = 0u;
    __syncthreads();
    XcdBarrier bar; bar.bar = (unsigned*)(F.ctl + CW_BAR); bar.x = 0; bar.st = nullptr; bar.w0 = F.wave;
    if (!MK_PER_PHASE) bar = xcd_barrier_post((unsigned*)(F.ctl + CW_BAR), F.MISC + 8);
#define GRID_BAR(seam) do { if (MK_PER_PHASE) { if (F.tid == 0) __hip_atomic_store(F.ctl + CW_TMO, 0xBADBA0u | (unsigned)(seam), RLX_AGENT); } else { xcd_barrier(bar); } } while (0)
    const int lo = args.ph_lo, hi = args.ph_hi;
#define IN(k) ((((unsigned)MK_PHMASK >> (k)) & 1u) && lo <= (k) && (k) < hi)
#define REFRESH() do { int l_ = (int)__builtin_amdgcn_mbcnt_hi(~0u, __builtin_amdgcn_mbcnt_lo(~0u, 0u)); asm volatile("" : "+v"(l_)); F.lane = l_; F.tid = F.wave * 64 + l_; \
        { GAS unsigned char* w_ = (GAS unsigned char*)args.ws; asm volatile("" : "+s"(w_)); ws = (unsigned char*)w_; }     \
        F.ws = ws; F.ctl = (gu32*)(ws + WS_CTL); } while (0)
#define STAMP(k) do { if (MK_STAMP_A >= 0 && blockIdx.x == 0 && threadIdx.x == 0) { const unsigned long long t_ = __builtin_amdgcn_s_memrealtime(); __hip_atomic_store((unsigned*)(F.ctl + CW_STAMP + (k)), (unsigned)t_, RLX_AGENT); } } while (0)
#define SEAM(k) do { if (IN(k) && IN((k) + 1)) { GRID_BAR(k); if (MK_DUP_BAR) GRID_BAR(k); } } while (0)
    unsigned char* ws = args.ws;
#define XS (args.out)
#define MOD0 ((const float*)(ws + WS_MOD))
#define MOD1 (MOD0 + 8 * 6144)
#define MODKV ((const float*)(ws + WS_MODKV))
#define HB0 ((bf16*)(ws + WS_HB0))
#define HB1 ((bf16*)(ws + WS_HB1))
#define AO ((bf16*)(ws + WS_AO))
    LAS unsigned char* ring = F.lds + RING_OFF;

    if (IN(0)) for (int rep_ = 0; rep_ < (((MK_DUP_MASK >> 0) & 1) ? 2 : 1); ++rep_) { STAMP(0); REFRESH(); p0_prologue(F, args, rep_ * 1024, rep_ ? MK_ATT_EXP : 0); } SEAM(0);
    if (IN(1)) for (int rep_ = 0; rep_ < (((MK_DUP_MASK >> 1) & 1) ? 2 : 1); ++rep_) { STAMP(1); REFRESH(); norm_phase<false>(F, args.in[0], args.in[5], MOD0 + 1024, MOD0, 6144, HB0, nullptr, nullptr, nullptr, 0, nullptr); } SEAM(1);
    if (IN(2)) for (int rep_ = 0; rep_ < (((MK_DUP_MASK >> 2) & 1) ? 2 : 1); ++rep_) { STAMP(2); REFRESH(); pg8::Gemm g{HB0, (const bf16*)(ws + WS_WAD), NTOK, NLATP, DM, 0, 0}; pg8::StaticOrder S; S.init(NTOK, NLATP, F.G, (int)blockIdx.x, MK_WGM_SMALL);
        pg8::EpiBf16 E{(bf16*)(ws + WS_LAT), NLATP, 1.0f}; pg8::gemm_phase<pg8::EpiBf16, pg8::StaticOrder, true, true>(ring, g, S, E, F.wave); } SEAM(2);
    if (IN(3)) for (int rep_ = 0; rep_ < (((MK_DUP_MASK >> 3) & 1) ? 2 : 1); ++rep_) { STAMP(3); REFRESH(); lat_phase(F, args); } SEAM(3);
    if (IN(4)) for (int rep_ = 0; rep_ < (((MK_DUP_MASK >> 4) & 1) ? 2 : 1); ++rep_) { STAMP(4); REFRESH();
        { pg8::Gemm g{(const bf16*)(ws + WS_CQ), (const bf16*)(ws + WS_WUQ), NTOK, 1024, QLP, 0, 0}; pg8::StaticOrder S; S.init(NTOK, 1024, F.G, (int)blockIdx.x, MK_WGM_SMALL);
          pg8::EpiBf16 E{(bf16*)(ws + WS_Q), NQ, C2_MLA}; pg8::gemm_phase<pg8::EpiBf16, pg8::StaticOrder, true, true>(ring, g, S, E, F.wave); }
        { pg8::Gemm g{(const bf16*)(ws + WS_CQ), (const bf16*)(ws + WS_WUQ) + (size_t)1024 * QLP, NTOK, 512, QLP, 0, 0}; pg8::StaticOrder S; S.init(NTOK, 512, F.G, (int)blockIdx.x, MK_WGM_SMALL);
          pg8::EpiRope E{(bf16*)(ws + WS_Q) + 1024, NQ, C2_MLA, (const float*)(ws + WS_COS)}; pg8::gemm_phase<pg8::EpiRope, pg8::StaticOrder, true, true>(ring, g, S, E, F.wave); }
        { pg8::Gemm g{(const bf16*)(ws + WS_CKV), (const bf16*)(ws + WS_WUKV), NTOK, NKV, KVLORA, 0, 0}; pg8::StaticOrder S; S.init(NTOK, NKV, F.G, (int)blockIdx.x, MK_WGM_SMALL);
          pg8::EpiBf16 E{(bf16*)(ws + WS_KV), NKV, 1.0f}; pg8::gemm_phase<pg8::EpiBf16, pg8::StaticOrder, true, true>(ring, g, S, E, F.wave); }
    } SEAM(4);
    if (IN(5)) for (int rep_ = 0; rep_ < (((MK_DUP_MASK >> 5) & 1) ? 2 : 1); ++rep_) { STAMP(5); REFRESH(); if (rep_ == 0) attn_phase_dyn<0>(F, args, (unsigned)WS_Q, (unsigned)WS_KV, (unsigned)WS_KROT, (unsigned)WS_AO); else attn_phase_dyn<0>(F, args, (unsigned)WS_Q, (unsigned)WS_KV, (unsigned)WS_KROT, (unsigned)WS_HB0, 1024, MK_ATT_EXP); } SEAM(5);
    if (IN(6)) for (int rep_ = 0; rep_ < (((MK_DUP_MASK >> 6) & 1) ? 2 : 1); ++rep_) { STAMP(6); REFRESH(); pg8::Gemm g{AO, (const bf16*)(ws + WS_WOA), NTOK, DM, DM, 0, 0}; pg8::StaticOrder S; S.init(NTOK, DM, F.G, (int)blockIdx.x, MK_WGM_SMALL);
        pg8::EpiResidB<true> E{args.in[0], (bf16*)XS, MOD0 + 2048, 6144, XSP}; pg8::gemm_phase<pg8::EpiResidB<true>, pg8::StaticOrder, true, true>(ring, g, S, E, F.wave); } SEAM(6);
    if (IN(7)) for (int rep_ = 0; rep_ < (((MK_DUP_MASK >> 7) & 1) ? 2 : 1); ++rep_) { STAMP(7); REFRESH(); norm_phase<false, true>(F, XS, args.in[6], MOD0 + 4096, MOD0 + 3072, 6144, HB0, nullptr, nullptr, nullptr, 0, nullptr); } SEAM(7);
    if (IN(8)) for (int rep_ = 0; rep_ < (((MK_DUP_MASK >> 8) & 1) ? 2 : 1); ++rep_) { STAMP(8); REFRESH(); pg8::Gemm g{HB0, (const bf16*)(ws + WS_WGU), NTOK, NGU, DM, 0, 0}; pg8::StaticOrder S; S.init(NTOK, NGU, F.G, (int)blockIdx.x, MK_WGM_BIG);
        pg8::EpiSwiglu E{(bf16*)(ws + WS_ACT), DFF}; if (rep_ == 0) pg8::gemm_phase<pg8::EpiSwiglu, pg8::StaticOrder, MK_ALIGN_SW, true>(ring, g, S, E, F.wave); else pg8::gemm_phase<pg8::EpiSwiglu, pg8::StaticOrder, true, true, MK_ATT_EXP>(ring, g, S, E, F.wave); } SEAM(8);
    if (IN(9)) for (int rep_ = 0; rep_ < (((MK_DUP_MASK >> 9) & 1) ? 2 : 1); ++rep_) { STAMP(9); REFRESH(); pg8::Gemm g{(const bf16*)(ws + WS_ACT), (const bf16*)(ws + WS_WDN), NTOK, DM, DFF, 0, 0}; pg8::StaticOrder S; S.init(NTOK, DM, F.G, (int)blockIdx.x, MK_WGM_SMALL);
        pg8::EpiResidB<false> E{XS, (bf16*)XS, MOD0 + 5120, 6144, XSP}; pg8::gemm_phase<pg8::EpiResidB<false>, pg8::StaticOrder, true, true>(ring, g, S, E, F.wave); } SEAM(9);
    if (IN(10)) for (int rep_ = 0; rep_ < (((MK_DUP_MASK >> 10) & 1) ? 2 : 1); ++rep_) { STAMP(10); REFRESH(); norm_phase<true, true>(F, XS, args.in[15], MODKV + 1024, MODKV, 2048, HB0, args.in[5] + DM, MOD1 + 1024, MOD1, 6144, HB1); } SEAM(10);
    if (IN(11)) for (int rep_ = 0; rep_ < (((MK_DUP_MASK >> 11) & 1) ? 2 : 1); ++rep_) { STAMP(11); REFRESH();
        { pg8::Gemm g{HB0, (const bf16*)(ws + WS_WKVSB), NTOK, 2048, DM, 0, 0}; pg8::StaticOrder S; S.init(NTOK, 2048, F.G, (int)blockIdx.x, MK_WGM_SMALL);
          pg8::EpiBf16 E{(bf16*)(ws + WS_KVSB), 2048, 1.0f}; pg8::gemm_phase<pg8::EpiBf16, pg8::StaticOrder, true, true>(ring, g, S, E, F.wave); }
        { pg8::Gemm g{HB1, (const bf16*)(ws + WS_WQSB), NTOK, DM, DM, 0, 0}; pg8::StaticOrder S; S.init(NTOK, DM, F.G, (int)blockIdx.x, MK_WGM_SMALL);
          pg8::EpiBf16 E{(bf16*)(ws + WS_QSB), DM, C2_SB}; pg8::gemm_phase<pg8::EpiBf16, pg8::StaticOrder, true, true>(ring, g, S, E, F.wave); }
    } SEAM(11);
    if (IN(12)) for (int rep_ = 0; rep_ < (((MK_DUP_MASK >> 12) & 1) ? 2 : 1); ++rep_) { STAMP(12); REFRESH(); if (rep_ == 0) attn_phase<1>(F, (unsigned)WS_QSB, (unsigned)WS_KVSB, 0u, (unsigned)WS_AO); else attn_phase<1, MK_ATT_EXP>(F, (unsigned)WS_QSB, (unsigned)WS_KVSB, 0u, (unsigned)WS_LAT); } SEAM(12);
    if (IN(13)) for (int rep_ = 0; rep_ < (((MK_DUP_MASK >> 13) & 1) ? 2 : 1); ++rep_) { STAMP(13); REFRESH(); pg8::Gemm g{AO, (const bf16*)(ws + WS_WOSB), NTOK, DM, DM, 0, 0}; pg8::StaticOrder S; S.init(NTOK, DM, F.G, (int)blockIdx.x, MK_WGM_SMALL);
        pg8::EpiResidB<false> E{XS, (bf16*)XS, MOD1 + 2048, 6144, XSP}; pg8::gemm_phase<pg8::EpiResidB<false>, pg8::StaticOrder, true, true>(ring, g, S, E, F.wave); } SEAM(13);
    if (IN(14)) for (int rep_ = 0; rep_ < (((MK_DUP_MASK >> 14) & 1) ? 2 : 1); ++rep_) { STAMP(14); REFRESH(); router_phase(F, args); } SEAM(14);
    if (IN(15)) for (int rep_ = 0; rep_ < (((MK_DUP_MASK >> 15) & 1) ? 2 : 1); ++rep_) { STAMP(15); REFRESH(); scatter_phase(F, args); } SEAM(15);
    if (IN(16)) for (int rep_ = 0; rep_ < (((MK_DUP_MASK >> 16) & 1) ? 2 : 1); ++rep_) { STAMP(16); REFRESH(); unsigned cnt[8]; int off[8]; moe_offsets(F, cnt, off);
        pg8::Gemm g{(const bf16*)(ws + WS_HS), (const bf16*)(ws + WS_WEGU), 0, NGU, DM, (size_t)NGU * DM * 2, 0}; pg8::MoeOrder S; S.init(cnt, NGU, F.G, (int)blockIdx.x, 1 << 20, MK_WGM_BIG);
        pg8::EpiSwiglu E{(bf16*)(ws + WS_ACT2), DFF}; pg8::gemm_phase<pg8::EpiSwiglu, pg8::MoeOrder, MK_ALIGN_SW, true>(ring, g, S, E, F.wave); } SEAM(16);
    if (IN(17)) for (int rep_ = 0; rep_ < (((MK_DUP_MASK >> 17) & 1) ? 2 : 1); ++rep_) { STAMP(17); REFRESH(); unsigned cnt[8]; int off[8]; moe_offsets(F, cnt, off);
        { pg8::Gemm g{(const bf16*)(ws + WS_ACT2), (const bf16*)(ws + WS_WEDN), 0, DM, DFF, (size_t)DM * DFF * 2, 0}; pg8::MoeOrder S; S.init(cnt, DM, F.G, (int)blockIdx.x, MOE_MAIN_TILES, MK_WGM_SMALL);
          pg8::EpiBf16 E{(bf16*)(ws + WS_Y), DM, 1.0f}; pg8::gemm_phase<pg8::EpiBf16, pg8::MoeOrder, true, true>(ring, g, S, E, F.wave); }
        { pg8::LeftOrder S; S.init(cnt, DFF, F.G, (int)blockIdx.x, MOE_MAIN_TILES);
          pg8::Gemm g{(const bf16*)(ws + WS_ACT2), (const bf16*)(ws + WS_WEDN), 0, DM, DFF, (size_t)DM * DFF * 2, S.Kc};
          pg8::EpiSlab E{(float*)(ws + WS_SLAB), MOE_MAIN_TILES, S.S, S.Kc}; pg8::gemm_phase<pg8::EpiSlab, pg8::LeftOrder, true, true>(ring, g, S, E, F.wave); }
    } SEAM(17);
    if (IN(18)) for (int rep_ = 0; rep_ < (((MK_DUP_MASK >> 18) & 1) ? 2 : 1); ++rep_) { STAMP(18); REFRESH(); slab_reduce_phase(F); } SEAM(18);
    if (IN(19)) { STAMP(19); REFRESH(); final_phase(F, args); }
#undef IN
#undef SEAM
#undef STAMP
#undef REFRESH
#undef MOD0
#undef MOD1
#undef MODKV
#undef HB0
#undef HB1
#undef AO
#undef XS
#undef GRID_BAR
}

extern "C" void kernel_launch(void* const* d_in, const int* in_sizes, int n_in, void* d_out, int out_size, void* d_ws, size_t ws_size, hipStream_t stream) {
    static int grid = 0;
    if (grid == 0) {
        if (n_in != 26 || in_sizes[0] != NTOK * DM || out_size != NTOK * DM || ws_size < WS_END) { fprintf(stderr, "kernel_launch: shape/workspace mismatch (n_in %d, in0 %d, out %d, ws %zu, need %zu)\n", n_in, n_in > 0 ? in_sizes[0] : -1, out_size, ws_size, (size_t)WS_END); grid = -1; return; }
        int dev = 0, cus = 0, per_cu = 0;
        if (hipGetDevice(&dev) != hipSuccess || hipDeviceGetAttribute(&cus, hipDeviceAttributeMultiprocessorCount, dev) != hipSuccess) { grid = -1; return; }
        if (hipFuncSetAttribute((const void*)yoco_fwd, hipFuncAttributeMaxDynamicSharedMemorySize, LDS_BYTES) != hipSuccess) { fprintf(stderr, "kernel_launch: hipFuncSetAttribute failed\n"); grid = -1; return; }
        if (hipOccupancyMaxActiveBlocksPerMultiprocessor(&per_cu, (const void*)yoco_fwd, NWAVES * 64, LDS_BYTES) != hipSuccess || per_cu < 1) { fprintf(stderr, "kernel_launch: occupancy query reports %d\n", per_cu); }
        (void)hipGetLastError();
        grid = cus;
    }
    if (grid < 0) return;
    if (hipMemsetAsync((char*)d_ws + WS_CTL, 0, CTL_ZERO_BYTES, stream) != hipSuccess) return;
    Args a{};
    for (int i = 0; i < 26; ++i) a.in[i] = (const float*)d_in[i];
    a.out = (float*)d_out; a.ws = (unsigned char*)d_ws;
    for (int i = 0; i < 32; ++i) a.inv[i] = (float)pow(10000.0, -(double)i / 32.0);
#if MK_PER_PHASE
    for (int p = 0; p < NPH; ++p) { a.ph_lo = p; a.ph_hi = p + 1; a.li = p; hipLaunchKernelGGL(yoco_fwd, dim3(grid), dim3(NWAVES * 64), LDS_BYTES, stream, a); }
#else
    a.ph_lo = 0; a.ph_hi = NPH; a.li = 0;
    hipLaunchKernelGGL(yoco_fwd, dim3(grid), dim3(NWAVES * 64), LDS_BYTES, stream, a);
#endif
    const hipError_t le = hipPeekAtLastError();
    if (le != hipSuccess) fprintf(stderr, "kernel_launch: launch failed: %s\n", hipGetErrorName(le));
}
```

```cpp
#include <hip/hip_runtime.h>
#include <cstdio>
#include <cstdint>
#include <cmath>
#ifndef MK_FORCE_S7
#define MK_FORCE_S7 0
#endif

namespace pg8 {
#define PG8_LAS __attribute__((address_space(3)))
typedef unsigned short bf16_t;
typedef short bf16x8 __attribute__((ext_vector_type(8)));
typedef float f32x4 __attribute__((ext_vector_type(4)));
typedef unsigned u32x4 __attribute__((ext_vector_type(4)));
constexpr int BM = 256, BK = 64, HALF = 128, HTB = HALF * BK * 2  , STAGE_BYTES = 8 * HTB, NXCD = 8, WGM = 4;

__host__ __device__ __forceinline__ int lds_byte(int r, int c) { const int st = (r >> 4) * 2 + (c >> 5), rr = r & 15, cc = c & 31, ob = rr * 64 + cc * 2; return st * 1024 + (ob ^ (((ob >> 9) & 1) << 5)); }
__host__ __device__ __forceinline__ void stage_rc(int b, int& R, int& C) { const int st = b / 1024, sb = b % 1024, swz = sb ^ (((sb >> 9) & 1) << 5); R = (st >> 1) * 16 + swz / 64; C = (st & 1) * 32 + (swz % 64) / 2; }
__host__ __device__ __forceinline__ int perm32(int rho) { const int n = rho >> 4, i = rho & 15; return 8 * (i >> 2) + 4 * n + (i & 3); }

struct Unit { int pm, pn, eb, k0; };
struct Gemm { const bf16_t* A; const bf16_t* Bt; int M, N, K; size_t bstride; int Kloop; };

struct StaticOrder {
    int nM, nN, nwg, G, c, wgm;
    __host__ __device__ void init(int M, int N, int G_, int c_, int wgm_ = WGM) { nM = M / BM; nN = N / BM; nwg = nM * nN; G = G_; c = c_; wgm = wgm_; }
    __host__ __device__ bool next(int i, Unit& u) const {
        const long L = (long)i * G + c; if (L >= nwg) return false;
        int wgid = (int)L; { const int q = nwg / NXCD, r = nwg % NXCD, xcd = wgid % NXCD, off = wgid / NXCD; wgid = (xcd < r ? xcd * (q + 1) : r * (q + 1) + (xcd - r) * q) + off; }
        const int nig = wgm * nN, gid = wgid / nig, fm = gid * wgm, gsz = (nM - fm) < wgm ? (nM - fm) : wgm;
        u.pm = fm + ((wgid % nig) % gsz); u.pn = (wgid % nig) / gsz; u.eb = 0; u.k0 = 0; return true;
    }
    __device__ __forceinline__ void a_ready(const Unit&) const {}
    __device__ __forceinline__ void done(const Unit&) const {}
};
struct MoeOrder {
    int nM, nN, nwg, G, c, wgm; int t1, t2, t3, t4, t5, t6, t7;
    __device__ __forceinline__ void init(const unsigned* cnt, int N, int G_, int c_, int maxtiles, int wgm_ = WGM) {
        int t = 0;
        t += (int)((cnt[0] + 255u) >> 8); t1 = t; t += (int)((cnt[1] + 255u) >> 8); t2 = t; t += (int)((cnt[2] + 255u) >> 8); t3 = t; t += (int)((cnt[3] + 255u) >> 8); t4 = t;
        t += (int)((cnt[4] + 255u) >> 8); t5 = t; t += (int)((cnt[5] + 255u) >> 8); t6 = t; t += (int)((cnt[6] + 255u) >> 8); t7 = t; t += (int)((cnt[7] + 255u) >> 8);
        nM = t < maxtiles ? t : maxtiles; nN = N / BM; nwg = nM * nN; G = G_; c = c_; wgm = wgm_; }
    __device__ __forceinline__ bool next(int i, Unit& u) const {
        const long L = (long)i * G + c; if (L >= nwg) return false;
        int wgid = (int)L; { const int q = nwg / NXCD, r = nwg % NXCD, xcd = wgid % NXCD, off = wgid / NXCD; wgid = (xcd < r ? xcd * (q + 1) : r * (q + 1) + (xcd - r) * q) + off; }
        const int nig = wgm * nN, gid = wgid / nig, fm = gid * wgm, gsz = (nM - fm) < wgm ? (nM - fm) : wgm;
        u.pm = fm + ((wgid % nig) % gsz); u.pn = (wgid % nig) / gsz;
        u.eb = (u.pm >= t1) + (u.pm >= t2) + (u.pm >= t3) + (u.pm >= t4) + (u.pm >= t5) + (u.pm >= t6) + (u.pm >= t7); u.k0 = 0; return true;
    }
    __device__ __forceinline__ void a_ready(const Unit&) const {}
    __device__ __forceinline__ void done(const Unit&) const {}
};

struct LeftOrder {
    int nitems, S, Kc, G, c, base; int t1, t2, t3, t4, t5, t6, t7;
    __device__ __forceinline__ void init(const unsigned* cnt, int K, int G_, int c_, int base_) {
        int t = 0;
        t += (int)((cnt[0] + 255u) >> 8); t1 = t; t += (int)((cnt[1] + 255u) >> 8); t2 = t; t += (int)((cnt[2] + 255u) >> 8); t3 = t; t += (int)((cnt[3] + 255u) >> 8); t4 = t;
        t += (int)((cnt[4] + 255u) >> 8); t5 = t; t += (int)((cnt[5] + 255u) >> 8); t6 = t; t += (int)((cnt[6] + 255u) >> 8); t7 = t; t += (int)((cnt[7] + 255u) >> 8);
        const int nleft = (t > base_ ? t - base_ : 0) * 4;
        S = (nleft * 14 <= G_ && !MK_FORCE_S7) ? 14 : 7; Kc = K / S; nitems = nleft * S; G = G_; c = c_; base = base_; }
    __device__ __forceinline__ bool next(int i, Unit& u) const {
        const long L = (long)i * G + c; if (L >= nitems) return false;
        const int it = (int)L, un = it / S, ks = it - un * S;
        u.pm = base + (un >> 2); u.pn = un & 3; u.k0 = ks * Kc;
        u.eb = (u.pm >= t1) + (u.pm >= t2) + (u.pm >= t3) + (u.pm >= t4) + (u.pm >= t5) + (u.pm >= t6) + (u.pm >= t7); return true;
    }
    __device__ __forceinline__ void a_ready(const Unit&) const {}
    __device__ __forceinline__ void done(const Unit&) const {}
};

__device__ __forceinline__ unsigned cvt_pk_bf16(float lo, float hi) { unsigned r; asm volatile("v_cvt_pk_bf16_f32 %0, %1, %2" : "=v"(r) : "v"(lo), "v"(hi)); return r; }

struct EpiF32 {
    static constexpr bool PERM = false, AFTER_DRAIN = false;
    float* C; int ldc;
    __device__ __forceinline__ void operator()(const f32x4 (&acc)[2][2][4][2], const Unit& u, int wr, int wc, int fr, int fq) const {
        asm volatile("" : "+v"(fr), "+v"(fq));
        const int row0 = u.pm * BM + wr * 64 + fr, col0 = u.pn * BM + wc * 32 + 4 * fq;
#pragma unroll
        for (int ai = 0; ai < 2; ++ai)
#pragma unroll
            for (int m = 0; m < 4; ++m) { float* rowp = C + (size_t)(row0 + ai * HALF + m * 16) * ldc + col0;
#pragma unroll
                for (int bj = 0; bj < 2; ++bj)
#pragma unroll
                    for (int n = 0; n < 2; ++n) *(f32x4*)(rowp + bj * HALF + n * 16) = acc[ai][bj][m][n]; }
    }
};
struct EpiSlab {
    static constexpr bool PERM = false, AFTER_DRAIN = false;
    float* slab; int base, S, Kc;
    __device__ __forceinline__ void operator()(const f32x4 (&acc)[2][2][4][2], const Unit& u, int wr, int wc, int fr, int fq) const {
        asm volatile("" : "+v"(fr), "+v"(fq));
        float* C = slab + (size_t)((((u.pm - base) * 4 + u.pn) * S) + u.k0 / Kc) * 65536;
        const int row0 = wr * 64 + fr, col0 = wc * 32 + 4 * fq;
#pragma unroll
        for (int ai = 0; ai < 2; ++ai)
#pragma unroll
            for (int m = 0; m < 4; ++m) { float* rowp = C + (size_t)(row0 + ai * HALF + m * 16) * 256 + col0;
#pragma unroll
                for (int bj = 0; bj < 2; ++bj)
#pragma unroll
                    for (int n = 0; n < 2; ++n) *(f32x4*)(rowp + bj * HALF + n * 16) = acc[ai][bj][m][n]; }
    }
};
struct EpiBf16 {
    static constexpr bool PERM = true, AFTER_DRAIN = false;
    bf16_t* O; int ldc; float scale;
    __device__ __forceinline__ void operator()(const f32x4 (&acc)[2][2][4][2], const Unit& u, int wr, int wc, int fr, int fq) const {
        asm volatile("" : "+v"(fr), "+v"(fq));
        const int row0 = u.pm * BM + wr * 64 + fr; const int col0 = u.pn * BM + wc * 32 + 8 * fq; const float sc = scale;
#pragma unroll
        for (int ai = 0; ai < 2; ++ai)
#pragma unroll
            for (int m = 0; m < 4; ++m) { bf16_t* rowp = O + (size_t)(row0 + ai * HALF + m * 16) * ldc + col0;
#pragma unroll
                for (int bj = 0; bj < 2; ++bj) { f32x4 v0 = acc[ai][bj][m][0] * sc, v1 = acc[ai][bj][m][1] * sc;
                    u32x4 w; w.x = cvt_pk_bf16(v0[0], v0[1]); w.y = cvt_pk_bf16(v0[2], v0[3]); w.z = cvt_pk_bf16(v1[0], v1[1]); w.w = cvt_pk_bf16(v1[2], v1[3]);
                    *(u32x4*)(rowp + bj * HALF) = w; } }
    }
};
struct EpiRope {
    static constexpr bool PERM = true, AFTER_DRAIN = false;
    bf16_t* O; int ldc; float scale; const float* CS;
    __device__ __forceinline__ void operator()(const f32x4 (&acc)[2][2][4][2], const Unit& u, int wr, int wc, int fr, int fq) const {
        asm volatile("" : "+v"(fr), "+v"(fq));
        const int row0 = u.pm * BM + wr * 64 + fr; const int col0 = u.pn * BM + wc * 32 + 8 * fq; const float sc = scale;
        const int g4 = ((wc & 1) * 4 + fq) * 4;
#pragma unroll
        for (int ai = 0; ai < 2; ++ai)
#pragma unroll
            for (int m = 0; m < 4; ++m) { int ro = ai * HALF + m * 16; asm volatile("" : "+s"(ro)); const int row = row0 + ro; bf16_t* rowp = O + (size_t)row * ldc + col0;
                const f32x4 cs = *(const f32x4*)(CS + (size_t)row * 64 + g4) * sc, sn = *(const f32x4*)(CS + (size_t)row * 64 + 32 + g4) * sc;
#pragma unroll
                for (int bj = 0; bj < 2; ++bj) { const f32x4 x1 = acc[ai][bj][m][0], x2 = acc[ai][bj][m][1];
                    const f32x4 v0 = x1 * cs - x2 * sn, v1 = x1 * sn + x2 * cs;
                    u32x4 w; w.x = cvt_pk_bf16(v0[0], v0[1]); w.y = cvt_pk_bf16(v0[2], v0[3]); w.z = cvt_pk_bf16(v1[0], v1[1]); w.w = cvt_pk_bf16(v1[2], v1[3]);
                    *(u32x4*)(rowp + bj * HALF) = w; }
                asm volatile("" ::: "memory"); }
    }
};
struct EpiResid {
    static constexpr bool PERM = false, AFTER_DRAIN = false;
    const float* base; float* out; const float* gate; int gstride;
    __device__ __forceinline__ void operator()(const f32x4 (&acc)[2][2][4][2], const Unit& u, int wr, int wc, int fr, int fq) const {
        asm volatile("" : "+v"(fr), "+v"(fq));
        const int row0 = u.pm * BM + wr * 64 + fr, col0 = u.pn * BM + wc * 32 + 4 * fq; const int b = u.pm >> 4;
        f32x4 gv[2][2];
#pragma unroll
        for (int bj = 0; bj < 2; ++bj)
#pragma unroll
            for (int n = 0; n < 2; ++n) gv[bj][n] = *(const f32x4*)(gate + (size_t)b * gstride + col0 + bj * HALF + n * 16);
#pragma unroll
        for (int ai = 0; ai < 2; ++ai)
#pragma unroll
            for (int m = 0; m < 4; ++m) { const size_t off = (size_t)(row0 + ai * HALF + m * 16) * 1024 + col0;
#pragma unroll
                for (int bj = 0; bj < 2; ++bj)
#pragma unroll
                    for (int n = 0; n < 2; ++n) { const f32x4 bs = *(const f32x4*)(base + off + bj * HALF + n * 16); *(f32x4*)(out + off + bj * HALF + n * 16) = bs + gv[bj][n] * acc[ai][bj][m][n]; }
                if (m & 1) asm volatile("" ::: "memory"); }
    }
};
template <bool BASE_F32>
struct EpiResidB {
    static constexpr bool PERM = true, AFTER_DRAIN = false;
    const void* base; bf16_t* out; const float* gate; int gstride; int XP;
    __device__ __forceinline__ void operator()(const f32x4 (&acc)[2][2][4][2], const Unit& u, int wr, int wc, int fr, int fq) const {
        asm volatile("" : "+v"(fr), "+v"(fq));
        const int row0 = u.pm * BM + wr * 64 + fr, col0 = u.pn * BM + wc * 32 + 8 * fq; const int b = u.pm >> 4;
        f32x4 gv[2][2];
#pragma unroll
        for (int bj = 0; bj < 2; ++bj)
#pragma unroll
            for (int n = 0; n < 2; ++n) gv[bj][n] = *(const f32x4*)(gate + (size_t)b * gstride + col0 + bj * HALF + 4 * n);
#pragma unroll
        for (int ai = 0; ai < 2; ++ai)
#pragma unroll
            for (int m = 0; m < 4; ++m) { const int row = row0 + ai * HALF + m * 16;
#pragma unroll
                for (int bj = 0; bj < 2; ++bj) { f32x4 b0, b1;
                    if (BASE_F32) { const float* bp = (const float*)base + (size_t)row * 1024 + col0 + bj * HALF; b0 = *(const f32x4*)bp; b1 = *(const f32x4*)(bp + 4); }
                    else { const u32x4 w = *(const u32x4*)((const bf16_t*)base + (size_t)row * XP + col0 + bj * HALF);
                        b0 = (f32x4){__uint_as_float(w.x << 16), __uint_as_float(w.x & 0xffff0000u), __uint_as_float(w.y << 16), __uint_as_float(w.y & 0xffff0000u)};
                        b1 = (f32x4){__uint_as_float(w.z << 16), __uint_as_float(w.z & 0xffff0000u), __uint_as_float(w.w << 16), __uint_as_float(w.w & 0xffff0000u)}; }
                    const f32x4 v0 = b0 + gv[bj][0] * acc[ai][bj][m][0], v1 = b1 + gv[bj][1] * acc[ai][bj][m][1];
                    u32x4 o; o.x = cvt_pk_bf16(v0[0], v0[1]); o.y = cvt_pk_bf16(v0[2], v0[3]); o.z = cvt_pk_bf16(v1[0], v1[1]); o.w = cvt_pk_bf16(v1[2], v1[3]);
                    *(u32x4*)(out + (size_t)row * XP + col0 + bj * HALF) = o; }
                if (m & 1) asm volatile("" ::: "memory"); }
    }
};
#ifndef PG8_SWIGLU_NT
#define PG8_SWIGLU_NT 0
#endif
struct EpiSwiglu {
    static constexpr bool PERM = true, AFTER_DRAIN = false;
    bf16_t* O; int ldc;
    __device__ __forceinline__ static float act(float g, float up) { const float e = __builtin_amdgcn_exp2f(g * -1.4426950408889634f); return g * __builtin_amdgcn_rcpf(1.0f + e) * up; }
    __device__ __forceinline__ void operator()(const f32x4 (&acc)[2][2][4][2], const Unit& u, int wr, int wc, int fr, int fq) const {
        asm volatile("" : "+v"(fr), "+v"(fq));
        const int row0 = u.pm * BM + wr * 64 + fr; const int col0 = u.pn * HALF + wc * 32 + 8 * fq;
#pragma unroll
        for (int ai = 0; ai < 2; ++ai)
#pragma unroll
            for (int m = 0; m < 4; ++m) { bf16_t* rowp = O + (size_t)(row0 + ai * HALF + m * 16) * ldc + col0;
                const f32x4 g0 = acc[ai][0][m][0], g1 = acc[ai][0][m][1], u0 = acc[ai][1][m][0], u1 = acc[ai][1][m][1];
                u32x4 w; w.x = cvt_pk_bf16(act(g0[0], u0[0]), act(g0[1], u0[1])); w.y = cvt_pk_bf16(act(g0[2], u0[2]), act(g0[3], u0[3]));
                w.z = cvt_pk_bf16(act(g1[0], u1[0]), act(g1[1], u1[1])); w.w = cvt_pk_bf16(act(g1[2], u1[2]), act(g1[3], u1[3]));
                if (PG8_SWIGLU_NT) __builtin_nontemporal_store(w, (u32x4*)rowp); else *(u32x4*)rowp = w; }
    }
};

template <class Epi, class Sched, bool ALIGN_EPI = false, bool SP2 = false, int GEXP = 0  >
__device__ __forceinline__ void gemm_phase(PG8_LAS unsigned char* lds, const Gemm g, const Sched& S, const Epi& E, int wave_id) {
    int tid_ = (int)__builtin_amdgcn_mbcnt_hi(~0u, __builtin_amdgcn_mbcnt_lo(~0u, 0u)); asm volatile("" : "+v"(tid_)); tid_ += wave_id * 64;
    const int tid = tid_, wid = __builtin_amdgcn_readfirstlane(tid >> 6), lane = tid & 63, wr = wid >> 2, wc = wid & 3, fr = lane & 15, fq = lane >> 4;
    const int K = g.K, nt = (g.Kloop ? g.Kloop : K) / BK;
    unsigned voffA[2], voffB[2];
#pragma unroll
    for (int i = 0; i < 2; ++i) { int R, C; stage_rc(tid * 16 + i * 8192, R, C); const int Rb = Epi::PERM ? ((R & ~31) + perm32(R & 31)) : R;
        voffA[i] = (unsigned)(R * K + C) * 2u; voffB[i] = (unsigned)(Rb * K + C) * 2u; }
    const size_t kstep = (size_t)(BK * 2);
    const size_t hstep = (size_t)HALF * K * 2;
    const size_t tstep = 2 * hstep;
    const unsigned ldsw = (unsigned)wid * 1024u;
    const int aoff = lds_byte(wr * 64 + fr, fq * 8), boff = lds_byte(wc * 32 + fr, fq * 8);
#define PG8_SA(b, h) (((b) * 2 + (h)) * HTB)
#define PG8_SB(b, h) ((4 + (b) * 2 + (h)) * HTB)
#define PG8_STAGE(bufoff, gbase, voff) do { _Pragma("unroll") for (int _i = 0; _i < 2; ++_i) \
        __builtin_amdgcn_global_load_lds((const unsigned*)((const char*)(gbase) + (voff)[_i]), (PG8_LAS unsigned*)(lds + (bufoff) + ldsw + _i * 8192), 16, 0, 0); } while (0)
#define PG8_LDA(dst, b, h) do { _Pragma("unroll") for (int m = 0; m < 4; ++m) _Pragma("unroll") for (int k = 0; k < 2; ++k) dst[m][k] = *(const PG8_LAS bf16x8*)(lds + PG8_SA(b, h) + aoff + m * 2048 + k * 1024); } while (0)
#define PG8_LDB(dst, b, h) do { _Pragma("unroll") for (int n = 0; n < 2; ++n) _Pragma("unroll") for (int k = 0; k < 2; ++k) dst[n][k] = *(const PG8_LAS bf16x8*)(lds + PG8_SB(b, h) + boff + n * 2048 + k * 1024); } while (0)
#define PG8_MMA(ai, bj, At, Bt) do { __builtin_amdgcn_s_setprio(1); _Pragma("unroll") for (int m = 0; m < 4; ++m) _Pragma("unroll") for (int n = 0; n < 2; ++n) _Pragma("unroll") for (int k = 0; k < 2; ++k) \
        acc[ai][bj][m][n] = __builtin_amdgcn_mfma_f32_16x16x32_bf16(Bt[n][k], At[m][k], acc[ai][bj][m][n], 0, 0, 0); __builtin_amdgcn_s_setprio(0); } while (0)
#define PG8_WAIT_V(n) asm volatile("s_waitcnt vmcnt(" #n ")" ::: "memory")
#define PG8_WAIT_L(n) asm volatile("s_waitcnt lgkmcnt(" #n ")" ::: "memory")
#define PG8_BAR __builtin_amdgcn_s_barrier()
#define PG8_SCHED __builtin_amdgcn_sched_barrier(0)
    Unit cur, nxt; int ui = 0;
    if (!S.next(0, cur)) return;
    f32x4 acc[2][2][4][2];
#pragma unroll
    for (int a = 0; a < 2; ++a)
#pragma unroll
        for (int b = 0; b < 2; ++b)
#pragma unroll
            for (int m = 0; m < 4; ++m)
#pragma unroll
                for (int n = 0; n < 2; ++n) acc[a][b][m][n] = (f32x4){0.f, 0.f, 0.f, 0.f};
    bf16x8 At[4][2], B0[2][2], B1[2][2];
    const char* cA = (const char*)g.A + (size_t)cur.pm * tstep + (size_t)cur.k0 * 2; const char* cB = (const char*)g.Bt + (size_t)cur.pn * tstep + (size_t)cur.eb * g.bstride + (size_t)cur.k0 * 2;
    S.a_ready(cur);
    if constexpr (SP2) {
        PG8_STAGE(PG8_SB(0, 0), cB, voffB); PG8_STAGE(PG8_SB(0, 1), cB + hstep, voffB); PG8_STAGE(PG8_SA(0, 0), cA, voffA); PG8_STAGE(PG8_SA(0, 1), cA + hstep, voffA);
        if (wr == 1) PG8_BAR;
        PG8_WAIT_V(2); PG8_BAR;
        PG8_STAGE(PG8_SB(1, 0), cB + kstep, voffB); PG8_STAGE(PG8_SA(1, 0), cA + kstep, voffA); PG8_STAGE(PG8_SB(1, 1), cB + hstep + kstep, voffB);
        PG8_WAIT_V(6); PG8_BAR;
    } else {
        PG8_STAGE(PG8_SB(0, 0), cB, voffB); PG8_STAGE(PG8_SA(0, 0), cA, voffA); PG8_STAGE(PG8_SB(0, 1), cB + hstep, voffB); PG8_STAGE(PG8_SA(0, 1), cA + hstep, voffA);
        if (wr == 1) PG8_BAR;
        PG8_WAIT_V(4); PG8_BAR;
        PG8_STAGE(PG8_SB(1, 0), cB + kstep, voffB); PG8_STAGE(PG8_SA(1, 0), cA + kstep, voffA); PG8_STAGE(PG8_SB(1, 1), cB + hstep + kstep, voffB);
        PG8_WAIT_V(6); PG8_BAR;
    }
    for (;;) {
        const bool has_next = S.next(ui + 1, nxt);
        const char* nA = has_next ? (const char*)g.A + (size_t)nxt.pm * tstep + (size_t)nxt.k0 * 2 : cA; const char* nB = has_next ? (const char*)g.Bt + (size_t)nxt.pn * tstep + (size_t)nxt.eb * g.bstride + (size_t)nxt.k0 * 2 : cB;
        for (int t = 0; t < nt; t += 2) {
            const bool last = (t == nt - 2);
            const char* a1 = cA + (size_t)(t + 1) * kstep;
            const char* a2 = last ? nA : cA + (size_t)(t + 2) * kstep; const char* b2 = last ? nB : cB + (size_t)(t + 2) * kstep;
            const char* a3 = a2 + kstep; const char* b3 = b2 + kstep;
            if (last && has_next) S.a_ready(nxt);
            if constexpr (SP2) {
            PG8_LDB(B0, 0, 0); PG8_LDB(B1, 0, 1); PG8_SCHED; PG8_LDA(At, 0, 0); PG8_STAGE(PG8_SA(1, 1), a1 + hstep, voffA);
            PG8_WAIT_V(8); PG8_WAIT_L(0); PG8_BAR; PG8_MMA(0, 0, At, B0); PG8_MMA(0, 1, At, B1); PG8_BAR; PG8_SCHED;
            PG8_LDA(At, 0, 1); PG8_STAGE(PG8_SB(0, 0), b2, voffB); PG8_STAGE(PG8_SB(0, 1), b2 + hstep, voffB); PG8_STAGE(PG8_SA(0, 0), a2, voffA);
            PG8_WAIT_V(8); PG8_WAIT_L(0); PG8_BAR; PG8_MMA(1, 0, At, B0); PG8_MMA(1, 1, At, B1); PG8_BAR; PG8_SCHED;
            PG8_LDB(B0, 1, 0); PG8_LDB(B1, 1, 1); PG8_SCHED; PG8_LDA(At, 1, 0); PG8_STAGE(PG8_SA(0, 1), a2 + hstep, voffA);
            PG8_WAIT_V(8); PG8_WAIT_L(0); PG8_BAR; PG8_MMA(0, 0, At, B0); PG8_MMA(0, 1, At, B1); PG8_BAR; PG8_SCHED;
            PG8_LDA(At, 1, 1); PG8_STAGE(PG8_SB(1, 0), b3, voffB); PG8_STAGE(PG8_SB(1, 1), b3 + hstep, voffB); PG8_STAGE(PG8_SA(1, 0), a3, voffA);
            PG8_WAIT_V(8); PG8_WAIT_L(0); PG8_BAR; PG8_MMA(1, 0, At, B0); PG8_MMA(1, 1, At, B1); PG8_BAR; PG8_SCHED;
            } else {
            PG8_LDB(B0, 0, 0); PG8_SCHED; PG8_LDA(At, 0, 0); PG8_STAGE(PG8_SA(1, 1), a1 + hstep, voffA);
            PG8_WAIT_L(8); PG8_BAR; PG8_WAIT_L(0); PG8_MMA(0, 0, At, B0); PG8_BAR; PG8_SCHED;
            PG8_LDB(B1, 0, 1); PG8_STAGE(PG8_SB(0, 0), b2, voffB);
            PG8_BAR; PG8_WAIT_L(0); PG8_MMA(0, 1, At, B1); PG8_BAR;
            PG8_LDA(At, 0, 1); PG8_STAGE(PG8_SA(0, 0), a2, voffA);
            PG8_BAR; PG8_WAIT_L(0); PG8_MMA(1, 0, At, B0); PG8_BAR; PG8_SCHED;
            PG8_STAGE(PG8_SB(0, 1), b2 + hstep, voffB);
            PG8_WAIT_V(6); PG8_BAR; PG8_MMA(1, 1, At, B1); PG8_BAR;
            PG8_LDB(B0, 1, 0); PG8_SCHED; PG8_LDA(At, 1, 0); PG8_STAGE(PG8_SA(0, 1), a2 + hstep, voffA);
            PG8_WAIT_L(8); PG8_BAR; PG8_WAIT_L(0); PG8_MMA(0, 0, At, B0); PG8_BAR; PG8_SCHED;
            PG8_LDB(B1, 1, 1); PG8_STAGE(PG8_SB(1, 0), b3, voffB);
            PG8_BAR; PG8_WAIT_L(0); PG8_MMA(0, 1, At, B1); PG8_BAR;
            PG8_LDA(At, 1, 1); PG8_STAGE(PG8_SA(1, 0), a3, voffA);
            PG8_BAR; PG8_WAIT_L(0); PG8_MMA(1, 0, At, B0); PG8_BAR; PG8_SCHED;
            PG8_STAGE(PG8_SB(1, 1), b3 + hstep, voffB);
            PG8_WAIT_V(6); PG8_BAR; PG8_MMA(1, 1, At, B1); PG8_BAR;
            }
        }
        if constexpr (ALIGN_EPI) { if (wr == 0) PG8_BAR; }
        if constexpr (!Epi::AFTER_DRAIN) { if (!(GEXP & 1)) E(acc, cur, wr, wc, fr, fq); else { float z_ = 0.f; _Pragma("unroll") for (int a_ = 0; a_ < 2; ++a_) _Pragma("unroll") for (int b_ = 0; b_ < 2; ++b_) _Pragma("unroll") for (int m_ = 0; m_ < 4; ++m_) _Pragma("unroll") for (int n_ = 0; n_ < 2; ++n_) z_ += acc[a_][b_][m_][n_][0] + acc[a_][b_][m_][n_][1] + acc[a_][b_][m_][n_][2] + acc[a_][b_][m_][n_][3]; if (z_ == 1.2345e-30f) *(volatile float*)g.A = z_; } S.done(cur); }
        if (!has_next) break;
#pragma unroll
        for (int a = 0; a < 2; ++a)
#pragma unroll
            for (int b = 0; b < 2; ++b)
#pragma unroll
                for (int m = 0; m < 4; ++m)
#pragma unroll
                    for (int n = 0; n < 2; ++n) acc[a][b][m][n] = (f32x4){0.f, 0.f, 0.f, 0.f};
        cur = nxt; cA = nA; cB = nB; ++ui;
        if constexpr (ALIGN_EPI) { if (wr == 1) PG8_BAR; }
    }
    PG8_WAIT_V(0);
    if constexpr (!ALIGN_EPI) { if (wr == 0) PG8_BAR; }
    PG8_BAR;
    if constexpr (Epi::AFTER_DRAIN) { E.fused(acc, cur, wr, wc, fr, fq, lds, wid, lane); S.done(cur); }
#undef PG8_SA
#undef PG8_SB
#undef PG8_STAGE
#undef PG8_LDA
#undef PG8_LDB
#undef PG8_MMA
#undef PG8_WAIT_V
#undef PG8_WAIT_L
#undef PG8_BAR
#undef PG8_SCHED
}
}

namespace att {
typedef unsigned short bf16_t;
typedef short bf16x8 __attribute__((ext_vector_type(8)));
typedef short s16x4 __attribute__((ext_vector_type(4)));
typedef float f32x16 __attribute__((ext_vector_type(16)));
typedef unsigned u32x4 __attribute__((ext_vector_type(4)));
#define ALDS __attribute__((address_space(3)))
#define ASBAR() __builtin_amdgcn_sched_barrier(0)
#ifndef ATT_SPRIO
#define ATT_SPRIO 0
#endif
#ifndef ATT_PRIO
#define ATT_PRIO 0
#endif
#ifndef ATT_SB_SKIP
#define ATT_SB_SKIP 1
#endif
#ifndef ATT_STAGGER
#define ATT_STAGGER 1
#endif
constexpr int SEQ = 4096, KVBLK = 64, QBLK = 32, NW = 8, QB = NW * QBLK;
constexpr int SHM_K = KVBLK * 384, SHM_V = KVBLK * 128 * 2;
constexpr int OFF_V = 0, OFF_K = 3 * SHM_V, OFF_S = OFF_K + 3 * SHM_K, LDS_BYTES = OFF_S + NW * 64 * 4;
#ifndef ATT_RAWBAR
#define ATT_RAWBAR 1
#endif
__device__ __forceinline__ int v_st(int k, int c) { const int kk = (k & ~0xC) | ((k & 4) << 1) | ((k & 8) >> 1); return ((kk >> 3) * 4 + (c >> 5)) * 512 + ((kk & 7) * 32 + (c & 31)) * 2; }
__device__ __forceinline__ int v_rd_base(int lane) { return ((lane & 3) << 3) | (((lane >> 2) & 3) << 6) | (((lane >> 4) & 1) << 5) | (((lane >> 5) & 1) << 8); }
constexpr int v_rd_off(int d0, int ks, int half) { return d0 * 512 + ks * 4096 + half * 2048; }
__device__ __forceinline__ int crow(int r, int hi) { return (r & 3) + 8 * (r >> 2) + 4 * hi; }
__device__ __forceinline__ unsigned cvtpk(float lo, float hi) { unsigned r; asm volatile("v_cvt_pk_bf16_f32 %0, %1, %2" : "=v"(r) : "v"(lo), "v"(hi)); return r; }

typedef short v4i16_t __attribute__((ext_vector_type(4)));
__device__ __forceinline__ s16x4 vtr(const ALDS char* p) { return __builtin_bit_cast(s16x4, __builtin_amdgcn_ds_read_tr16_b64_v4i16((ALDS v4i16_t*)p)); }
__device__ __forceinline__ void pv_tile(f32x16* o, const ALDS char* vp, bf16x8 pa0, bf16x8 pa1, bf16x8 pa2, bf16x8 pa3) {
    s16x4 r[4][4];
#define PV_RD(g) do { constexpr int b_ = v_rd_off((g) >> 1, 0, 0) + ((g) & 1) * 8192; r[(g) & 3][0] = vtr(vp + b_); r[(g) & 3][1] = vtr(vp + b_ + 2048); r[(g) & 3][2] = vtr(vp + b_ + 4096); r[(g) & 3][3] = vtr(vp + b_ + 6144); } while (0)
#define PV_MM(g) do { const s16x4 L0 = r[(g) & 3][0], H0 = r[(g) & 3][1], L1 = r[(g) & 3][2], H1 = r[(g) & 3][3]; \
        o[(g) >> 1] = __builtin_amdgcn_mfma_f32_32x32x16_bf16(((g) & 1) ? pa2 : pa0, (bf16x8){L0[0], L0[1], L0[2], L0[3], H0[0], H0[1], H0[2], H0[3]}, o[(g) >> 1], 0, 0, 0); \
        o[(g) >> 1] = __builtin_amdgcn_mfma_f32_32x32x16_bf16(((g) & 1) ? pa3 : pa1, (bf16x8){L1[0], L1[1], L1[2], L1[3], H1[0], H1[1], H1[2], H1[3]}, o[(g) >> 1], 0, 0, 0); } while (0)
    PV_RD(0); PV_RD(1); PV_RD(2); ASBAR();
    PV_RD(3); PV_MM(0); ASBAR();
    PV_RD(4); PV_MM(1); ASBAR();
    PV_RD(5); PV_MM(2); ASBAR();
    PV_RD(6); PV_MM(3); ASBAR();
    PV_RD(7); PV_MM(4); ASBAR();
    PV_MM(5); ASBAR(); PV_MM(6); ASBAR(); PV_MM(7);
#undef PV_RD
#undef PV_MM
}
__device__ __forceinline__ void pv_tile2(f32x16* o, const ALDS char* vp, bf16x8 pa0, bf16x8 pa1, bf16x8 pa2, bf16x8 pa3) {
    s16x4 r[2][4];
#define PV_RD(g) do { constexpr int b_ = v_rd_off((g) >> 1, 0, 0) + ((g) & 1) * 8192; r[(g) & 1][0] = vtr(vp + b_); r[(g) & 1][1] = vtr(vp + b_ + 2048); r[(g) & 1][2] = vtr(vp + b_ + 4096); r[(g) & 1][3] = vtr(vp + b_ + 6144); } while (0)
#define PV_MM(g) do { const s16x4 L0 = r[(g) & 1][0], H0 = r[(g) & 1][1], L1 = r[(g) & 1][2], H1 = r[(g) & 1][3]; \
        o[(g) >> 1] = __builtin_amdgcn_mfma_f32_32x32x16_bf16(((g) & 1) ? pa2 : pa0, (bf16x8){L0[0], L0[1], L0[2], L0[3], H0[0], H0[1], H0[2], H0[3]}, o[(g) >> 1], 0, 0, 0); \
        o[(g) >> 1] = __builtin_amdgcn_mfma_f32_32x32x16_bf16(((g) & 1) ? pa3 : pa1, (bf16x8){L1[0], L1[1], L1[2], L1[3], H1[0], H1[1], H1[2], H1[3]}, o[(g) >> 1], 0, 0, 0); } while (0)
    PV_RD(0); ASBAR();
    PV_RD(1); PV_MM(0); ASBAR(); PV_RD(2); PV_MM(1); ASBAR(); PV_RD(3); PV_MM(2); ASBAR(); PV_RD(4); PV_MM(3); ASBAR();
    PV_RD(5); PV_MM(4); ASBAR(); PV_RD(6); PV_MM(5); ASBAR(); PV_RD(7); PV_MM(6); ASBAR(); PV_MM(7);
#undef PV_RD
#undef PV_MM
}
__device__ __forceinline__ void pack_p(const f32x16& p0, const f32x16& p1, bf16x8& pa0, bf16x8& pa1, bf16x8& pa2, bf16x8& pa3) {
#define PK4(P, B_, OUT) do { unsigned a0 = cvtpk(P[B_+0], P[B_+1]), a1 = cvtpk(P[B_+2], P[B_+3]);                          \
        unsigned b0 = cvtpk(P[B_+4], P[B_+5]), b1 = cvtpk(P[B_+6], P[B_+7]);                                             \
        auto r0 = __builtin_amdgcn_permlane32_swap(a0, b0, false, false); auto r1 = __builtin_amdgcn_permlane32_swap(a1, b1, false, false); \
        u32x4 w = {r0[0], r1[0], r0[1], r1[1]}; OUT = __builtin_bit_cast(bf16x8, w); } while (0)
    PK4(p0, 0, pa0); PK4(p0, 8, pa1); PK4(p1, 0, pa2); PK4(p1, 8, pa3);
#undef PK4
}
__device__ __forceinline__ float swap_max(float v) { auto rr = __builtin_amdgcn_permlane32_swap(__float_as_uint(v), __float_as_uint(v), false, false); return fmaxf(__uint_as_float(rr[0]), __uint_as_float(rr[1])); }
__device__ __forceinline__ float swap_sum(float v) { auto rr = __builtin_amdgcn_permlane32_swap(__float_as_uint(v), __float_as_uint(v), false, false); return __uint_as_float(rr[0]) + __uint_as_float(rr[1]); }

template <int MODE>
__device__ __forceinline__ void sm_stage(f32x16& p0, f32x16& p1, f32x16 (&o)[4], float& m_reg, float& l_reg, float& carry, int kb0, int qlo, int r32, int hi, ALDS float* wsf,
                                         bf16x8& pa0, bf16x8& pa1, bf16x8& pa2, bf16x8& pa3) {
    const float NEG = -__builtin_inff();
    const bool needmask = (MODE == 0) ? (kb0 + KVBLK - 1 > qlo) : (kb0 + KVBLK - 1 >= qlo);
    if (needmask) { const int dq = qlo + r32 - kb0 - 4 * hi;
#pragma unroll
        for (int r = 0; r < 16; ++r) { const int c = (r & 3) + 8 * (r >> 2);
            if (MODE == 0) { if (c > dq) p0[r] = NEG; if (c + 32 > dq) p1[r] = NEG; }
            else { if (c >= dq) p0[r] = NEG; if (c + 32 >= dq) p1[r] = NEG; } } }
    if (MODE == 0) {
        float pmax = p0[0];
#pragma unroll
        for (int r = 1; r < 16; ++r) pmax = fmaxf(pmax, p0[r]);
#pragma unroll
        for (int r = 0; r < 16; ++r) pmax = fmaxf(pmax, p1[r]);
        pmax = swap_max(pmax);
        float alpha = 1.f;
        if (!__all(pmax - m_reg <= 8.0f)) { const float mn = fmaxf(m_reg, pmax); alpha = __builtin_amdgcn_exp2f(m_reg - mn); m_reg = mn; }
        float ps = 0.f;
#pragma unroll
        for (int r = 0; r < 16; ++r) { p0[r] = __builtin_amdgcn_exp2f(p0[r] - m_reg); ps += p0[r]; }
#pragma unroll
        for (int r = 0; r < 16; ++r) { p1[r] = __builtin_amdgcn_exp2f(p1[r] - m_reg); ps += p1[r]; }
        ps = swap_sum(ps);
        l_reg = l_reg * alpha + ps;
        if (__any(alpha < 1.f)) { if (hi == 0) wsf[r32] = alpha; asm volatile("s_waitcnt lgkmcnt(0)" ::: "memory");
#pragma unroll
            for (int r = 0; r < 16; ++r) { const float f = wsf[crow(r, hi)];
#pragma unroll
                for (int d_ = 0; d_ < 4; ++d_) o[d_][r] *= f; }
            asm volatile("s_waitcnt lgkmcnt(0)" ::: "memory"); }
    } else {
        float si[9];
#define SB_GRP1(P, B_, k) do { \
            const float ba = __builtin_amdgcn_rcpf(1.0f + __builtin_amdgcn_exp2f(-P[B_])), bb = __builtin_amdgcn_rcpf(1.0f + __builtin_amdgcn_exp2f(-P[B_ + 1])); \
            const float bc = __builtin_amdgcn_rcpf(1.0f + __builtin_amdgcn_exp2f(-P[B_ + 2])), bd = __builtin_amdgcn_rcpf(1.0f + __builtin_amdgcn_exp2f(-P[B_ + 3])); \
            P[B_] = ba; P[B_ + 1] = bb; P[B_ + 2] = bc; P[B_ + 3] = bd; si[k] = ((1.0f - ba) * (1.0f - bb)) * ((1.0f - bc) * (1.0f - bd)); } while (0)
        SB_GRP1(p0, 0, 0); SB_GRP1(p0, 4, 1); SB_GRP1(p0, 8, 2); SB_GRP1(p0, 12, 3); SB_GRP1(p1, 0, 4); SB_GRP1(p1, 4, 5); SB_GRP1(p1, 8, 6); SB_GRP1(p1, 12, 7);
#undef SB_GRP1
        si[8] = 1.0f;
#pragma unroll
        for (int k = 6; k >= 0; --k) si[k] *= si[k + 1];
#define SB_GRP2(P, B_, k) do { \
            auto rr = __builtin_amdgcn_permlane32_swap(__float_as_uint(si[k]), __float_as_uint(si[(k) + 1]), false, false); \
              \
            const float other = hi ? __uint_as_float(rr[0]) : __uint_as_float(rr[1]); \
            const float ed = carry * si[(k) + 1] * other, ec = ed * (1.0f - P[B_ + 3]), eb = ec * (1.0f - P[B_ + 2]), ea = eb * (1.0f - P[B_ + 1]); \
            P[B_ + 3] *= ed; P[B_ + 2] *= ec; P[B_ + 1] *= eb; P[B_] *= ea; } while (0)
        SB_GRP2(p0, 0, 0); SB_GRP2(p0, 4, 1); SB_GRP2(p0, 8, 2); SB_GRP2(p0, 12, 3); SB_GRP2(p1, 0, 4); SB_GRP2(p1, 4, 5); SB_GRP2(p1, 8, 6); SB_GRP2(p1, 12, 7);
#undef SB_GRP2
        { auto rr = __builtin_amdgcn_permlane32_swap(__float_as_uint(si[0]), __float_as_uint(si[0]), false, false); carry *= __uint_as_float(rr[0]) * __uint_as_float(rr[1]); }
    }
    pack_p(p0, p1, pa0, pa1, pa2, pa3);
}

template <int MODE, int EXP = 0>
__device__ __forceinline__ void attn_unit(int b, int h, int qb, const bf16_t* __restrict__ Qp, const bf16_t* __restrict__ KVp, const bf16_t* __restrict__ KRp, bf16_t* __restrict__ Op, ALDS char* lds, int wave_id) {
    constexpr int DK = MODE == 0 ? 192 : 128, NQ = DK / 16, KI = DK / 64, KROW = MODE == 0 ? 384 : 256;
    int tid_ = (int)__builtin_amdgcn_mbcnt_hi(~0u, __builtin_amdgcn_mbcnt_lo(~0u, 0u)); asm volatile("" : "+v"(tid_)); tid_ += wave_id * 64;
    const int tid = tid_, wid = __builtin_amdgcn_readfirstlane(tid >> 6), lane = tid & 63, r32 = lane & 31, hi = lane >> 5;
    const size_t tok0 = (size_t)b * SEQ;
    const int q0 = qb * QB, qlo = q0 + wid * QBLK;
    bf16x8 qr[NQ];
    { const size_t row = tok0 + qlo + r32;
#pragma unroll
      for (int d0 = 0; d0 < NQ; ++d0) {
          const bf16_t* p;
          if (MODE == 0) p = (d0 < 8) ? Qp + row * 1536 + h * 128 + d0 * 16 + hi * 8 : Qp + row * 1536 + 1024 + h * 64 + (d0 - 8) * 16 + hi * 8;
          else p = Qp + row * 1024 + h * 128 + d0 * 16 + hi * 8;
          qr[d0] = *(const bf16x8*)p; } }
    const int krow = tid >> 3, kcg = tid & 7;
    int kw[KI];
    if (MODE == 0) {
#pragma unroll
        for (int i = 0; i < KI; ++i) kw[i] = krow * KROW + ((kcg ^ ((krow >> 1) & 7)) << 4) + i * 128;
    } else { const int x = krow & 15;
#pragma unroll
        for (int i = 0; i < KI; ++i) kw[i] = krow * KROW + ((kcg ^ (x & 7)) << 4) + ((i ^ (x >> 3)) << 7); }
    const int sr = 4 * (tid >> 6) + ((tid >> 2) & 3), sc = ((tid >> 4) & 3) * 32 + (tid & 3) * 8;
    const int vst0 = v_st(sr, sc), vst1 = v_st(32 + sr, sc);
    const bf16_t* ksrc = (MODE == 0) ? KVp + (tok0 + krow) * 2048 + h * 256 + kcg * 8 : KVp + (tok0 + krow) * 2048 + h * 128 + kcg * 8;
    const bf16_t* krsrc = (MODE == 0) ? KRp + (tok0 + krow) * 64 + kcg * 8 : nullptr;
    const bf16_t* vsrc = (MODE == 0) ? KVp + (tok0 + sr) * 2048 + h * 256 + 128 + sc : KVp + (tok0 + sr) * 2048 + 1024 + h * 128 + sc;
    bf16x8 stk[KI], stv0, stv1;
#define ST_LOAD(j) do { const size_t k0_ = (size_t)(j) * KVBLK; \
        stk[0] = *(const bf16x8*)(ksrc + k0_ * 2048); stk[1] = *(const bf16x8*)(ksrc + k0_ * 2048 + 64); \
        if (MODE == 0) stk[KI - 1] = *(const bf16x8*)(krsrc + k0_ * 64); \
        stv0 = *(const bf16x8*)(vsrc + k0_ * 2048); stv1 = *(const bf16x8*)(vsrc + (k0_ + 32) * 2048); } while (0)
#define ST_WRITE(buf) do { ALDS char* kb_ = lds + OFF_K + (buf) * SHM_K; \
        _Pragma("unroll") for (int i_ = 0; i_ < KI; ++i_) *(ALDS bf16x8*)(kb_ + kw[i_]) = stk[i_]; \
        *(ALDS bf16x8*)(lds + OFF_V + (buf) * SHM_V + vst0) = stv0; *(ALDS bf16x8*)(lds + OFF_V + (buf) * SHM_V + vst1) = stv1; } while (0)
    int kb[4];
#pragma unroll
    for (int dd = 0; dd < 4; ++dd) kb[dd] = OFF_K + r32 * KROW + (MODE == 0 ? (((dd * 2 + hi) ^ ((r32 >> 1) & 7)) << 4) : ((((dd * 2 + hi) ^ (r32 & 7)) << 4) + (((r32 >> 3) & 1) << 7)));
    const ALDS char* vp0 = lds + OFF_V + v_rd_base(lane);
    ALDS float* wsf = (ALDS float*)(lds + OFF_S) + wid * 64;
    const int NT = 4 * qb + 4;
    f32x16 o[4] = {};
    float m_reg = -1e30f, l_reg = 0.f, carry = 1.0f;
#define TILE_OF(s) (MODE == 0 ? (s) : NT - 1 - (s))
    ST_LOAD(TILE_OF(0)); ST_WRITE(0);
    if (NT > 1) ST_LOAD(TILE_OF(1));
    if (ATT_RAWBAR) asm volatile("s_waitcnt lgkmcnt(0)\n\ts_barrier" ::: "memory"); else __syncthreads();
#ifndef ATT_TOUCH
#define ATT_TOUCH 0
#endif

#ifndef ATT_PIPE
#define ATT_PIPE 0
#endif
    if constexpr (MODE == 1 && ATT_PIPE && !(EXP & 64)) {
    f32x16 pA0, pA1, pB0, pB1;
    const float NEGI = -__builtin_inff();
#define KAD(d0) (kbase + (((d0) >> 2) ? (kb[(d0) & 3] ^ 128) : kb[(d0) & 3]))
    { const ALDS char* kbase = lds;
      pA0 = f32x16{}; pA1 = f32x16{};
#pragma unroll
      for (int d0 = 0; d0 < NQ; ++d0) { const ALDS char* a_ = KAD(d0); const bf16x8 b0 = *(const ALDS bf16x8*)a_, b1 = *(const ALDS bf16x8*)(a_ + 32 * KROW);
          pA0 = __builtin_amdgcn_mfma_f32_32x32x16_bf16(b0, qr[d0], pA0, 0, 0, 0); pA1 = __builtin_amdgcn_mfma_f32_32x32x16_bf16(b1, qr[d0], pA1, 0, 0, 0); } }
    if (NT > 1) { ST_WRITE(1); if (NT > 2) ST_LOAD(TILE_OF(2)); }
    __syncthreads();
    int buf = 1, bufn = 2, bufp = 0;
    for (int s = 1; s <= NT; ++s) {
        const ALDS char* kbase = lds + buf * SHM_K;
        const ALDS char* vp = vp0 + bufp * SHM_V;
        const int kbp = TILE_OF(s - 1) * KVBLK;
        { const int dq = qlo + r32 - kbp - 4 * hi;
#pragma unroll
          for (int r = 0; r < 16; ++r) { const int c = (r & 3) + 8 * (r >> 2); pA0[r] = (c >= dq) ? NEGI : pA0[r]; pA1[r] = (c + 32 >= dq) ? NEGI : pA1[r]; } }
        float si[9];
        bf16x8 kf[2][2];
        pB0 = f32x16{}; pB1 = f32x16{};
#define K_RD(i) do { const ALDS char* a_ = KAD(i); kf[(i) & 1][0] = *(const ALDS bf16x8*)a_; kf[(i) & 1][1] = *(const ALDS bf16x8*)(a_ + 32 * KROW); } while (0)
#define SB_GRP1(P, B_, k) do { \
            const float ba = __builtin_amdgcn_rcpf(1.0f + __builtin_amdgcn_exp2f(-P[B_])), bb = __builtin_amdgcn_rcpf(1.0f + __builtin_amdgcn_exp2f(-P[B_ + 1])); \
            const float bc = __builtin_amdgcn_rcpf(1.0f + __builtin_amdgcn_exp2f(-P[B_ + 2])), bd = __builtin_amdgcn_rcpf(1.0f + __builtin_amdgcn_exp2f(-P[B_ + 3])); \
            P[B_] = ba; P[B_ + 1] = bb; P[B_ + 2] = bc; P[B_ + 3] = bd; si[k] = ((1.0f - ba) * (1.0f - bb)) * ((1.0f - bc) * (1.0f - bd)); } while (0)
#define QK_CHUNK(i, P, B_) do { if ((i) + 1 < NQ) K_RD((i) + 1); \
            pB0 = __builtin_amdgcn_mfma_f32_32x32x16_bf16(kf[(i) & 1][0], qr[i], pB0, 0, 0, 0); pB1 = __builtin_amdgcn_mfma_f32_32x32x16_bf16(kf[(i) & 1][1], qr[i], pB1, 0, 0, 0); \
            SB_GRP1(P, B_, i); ASBAR(); } while (0)
        K_RD(0); ASBAR();
        QK_CHUNK(0, pA0, 0); QK_CHUNK(1, pA0, 4); QK_CHUNK(2, pA0, 8); QK_CHUNK(3, pA0, 12); QK_CHUNK(4, pA1, 0); QK_CHUNK(5, pA1, 4); QK_CHUNK(6, pA1, 8); QK_CHUNK(7, pA1, 12);
#undef K_RD
#undef SB_GRP1
#undef QK_CHUNK
        si[8] = 1.0f;
#pragma unroll
        for (int k = 6; k >= 0; --k) si[k] *= si[k + 1];
        if (s + 1 < NT) { ST_WRITE(bufn); if (s + 2 < NT) ST_LOAD(TILE_OF(s + 2)); }
#define SB_GRP2(P, B_, k) do { \
            auto rr = __builtin_amdgcn_permlane32_swap(__float_as_uint(si[k]), __float_as_uint(si[(k) + 1]), false, false); \
            const float other = hi ? __uint_as_float(rr[0]) : __uint_as_float(rr[1]); \
            const float ed = carry * si[(k) + 1] * other, ec = ed * (1.0f - P[B_ + 3]), eb = ec * (1.0f - P[B_ + 2]), ea = eb * (1.0f - P[B_ + 1]); \
            P[B_ + 3] *= ed; P[B_ + 2] *= ec; P[B_ + 1] *= eb; P[B_] *= ea; } while (0)
#define PK4(P, B_, OUT) do { unsigned a0 = cvtpk(P[B_+0], P[B_+1]), a1 = cvtpk(P[B_+2], P[B_+3]); unsigned b0 = cvtpk(P[B_+4], P[B_+5]), b1 = cvtpk(P[B_+6], P[B_+7]); \
            auto r0 = __builtin_amdgcn_permlane32_swap(a0, b0, false, false); auto r1 = __builtin_amdgcn_permlane32_swap(a1, b1, false, false); \
            u32x4 w = {r0[0], r1[0], r0[1], r1[1]}; OUT = __builtin_bit_cast(bf16x8, w); } while (0)
        s16x4 vf[8];
#define V_RD(ks) do { _Pragma("unroll") for (int d_ = 0; d_ < 4; ++d_) { vf[2 * d_] = vtr(vp + v_rd_off(d_, ks, 0)); vf[2 * d_ + 1] = vtr(vp + v_rd_off(d_, ks, 1)); } } while (0)
#define V_MM(ks, PA) do { _Pragma("unroll") for (int d_ = 0; d_ < 4; ++d_) { const s16x4 L = vf[2 * d_], H = vf[2 * d_ + 1]; \
            o[d_] = __builtin_amdgcn_mfma_f32_32x32x16_bf16(PA, (bf16x8){L[0], L[1], L[2], L[3], H[0], H[1], H[2], H[3]}, o[d_], 0, 0, 0); } } while (0)
        bf16x8 pa0, pa1, pa2, pa3;
        V_RD(0); SB_GRP2(pA0, 0, 0); SB_GRP2(pA0, 4, 1); PK4(pA0, 0, pa0); ASBAR();
        V_MM(0, pa0); V_RD(1); SB_GRP2(pA0, 8, 2); SB_GRP2(pA0, 12, 3); PK4(pA0, 8, pa1); ASBAR();
        V_MM(1, pa1); V_RD(2); SB_GRP2(pA1, 0, 4); SB_GRP2(pA1, 4, 5); PK4(pA1, 0, pa2); ASBAR();
        V_MM(2, pa2); V_RD(3); SB_GRP2(pA1, 8, 6); SB_GRP2(pA1, 12, 7); PK4(pA1, 8, pa3); ASBAR();
        V_MM(3, pa3);
#undef SB_GRP2
#undef PK4
#undef V_RD
#undef V_MM
        { auto rr = __builtin_amdgcn_permlane32_swap(__float_as_uint(si[0]), __float_as_uint(si[0]), false, false); carry *= __uint_as_float(rr[0]) * __uint_as_float(rr[1]); }
        __syncthreads();
        pA0 = pB0; pA1 = pB1;
        bufp = buf; buf = bufn; bufn = (bufn == 2) ? 0 : bufn + 1;
    }
#undef KAD
    } else {
    constexpr bool STAG = ATT_STAGGER && !(EXP & 64);
    const bool grpB = STAG && wid >= 4;
    f32x16 p0 = {}, p1 = {};
    int buf = 0, bufn = 1, bufp = 2;
#define QK_STAGE() do { \
            const ALDS char* kbase = lds + buf * SHM_K; bf16x8 f[2][4]; \
            p0 = f32x16{}; p1 = f32x16{}; \
            QK_RD(0); ASBAR(); if (ATT_PRIO) __builtin_amdgcn_s_setprio(1); \
            _Pragma("unroll") for (int g = 0; g < NQ / 2; ++g) { if (g + 1 < NQ / 2) QK_RD(g + 1); QK_MM(g); ASBAR(); } if (ATT_PRIO) __builtin_amdgcn_s_setprio(0); } while (0)
#define QK_AD(d0) (kbase + (MODE == 0 ? kb[(d0) & 3] + ((d0) >> 2) * 128 : (((d0) >> 2) ? (kb[(d0) & 3] ^ 128) : kb[(d0) & 3])))
#define QK_RD(g) do { const int gg_ = (g) % (NQ / 4), hf_ = (g) / (NQ / 4); \
                if (!((EXP & 512) && hf_ == 1)) { _Pragma("unroll") for (int q_ = 0; q_ < 4; ++q_) f[(g) & 1][q_] = *(const ALDS bf16x8*)(QK_AD(4 * gg_ + q_) + hf_ * 32 * KROW); } } while (0)
#define QK_MM(g) do { const int gg_ = (g) % (NQ / 4), hf_ = (g) / (NQ / 4); \
                _Pragma("unroll") for (int q_ = 0; q_ < 4; ++q_) { if (hf_ == 0) p0 = __builtin_amdgcn_mfma_f32_32x32x16_bf16(f[(g) & 1][q_], qr[4 * gg_ + q_], p0, 0, 0, 0); else if (EXP & 256) asm volatile("" :: "v"(f[(g) & 1][q_])); else p1 = __builtin_amdgcn_mfma_f32_32x32x16_bf16(f[(g) & 1][q_], qr[4 * gg_ + q_], p1, 0, 0, 0); } } while (0)
#define SMPV_STAGE(jt, vbuf) do { bf16x8 pa0, pa1, pa2, pa3; \
            if (!(EXP & 1) && !((EXP & 128) && wid < 4)) sm_stage<MODE>(p0, p1, o, m_reg, l_reg, carry, (jt) * KVBLK, qlo, r32, hi, wsf, pa0, pa1, pa2, pa3); else pack_p(p0, p1, pa0, pa1, pa2, pa3); \
            if (!(EXP & 2) && !((EXP & 128) && wid >= 4)) { if (ATT_PRIO) __builtin_amdgcn_s_setprio(1); pv_tile(o, vp0 + (vbuf) * SHM_V, pa0, pa1, pa2, pa3); if (ATT_PRIO) __builtin_amdgcn_s_setprio(0); } else { o[0][0] += __builtin_bit_cast(float, (int)pa0[0] + (int)pa1[1] + (int)pa2[2] + (int)pa3[3]); } } while (0)
#define ACTIVE(jt) ((MODE == 0) ? ((jt) * KVBLK <= qlo + QBLK - 1) : ((jt) * KVBLK < qlo + QBLK - 1))
    constexpr int LPK = (MODE == 0) ? 5 : 4;
    const int tk_ = tid / LPK, tp_ = tid - LPK * tk_;
    const bf16_t* tsrc = (MODE == 0) ? ((tp_ < 4) ? KVp + (tok0 + tk_) * 2048 + h * 256 + tp_ * 64 : KRp + (tok0 + tk_) * 64) : KVp + (tok0 + tk_) * 2048 + (tp_ >> 1) * 1024 + h * 128 + (tp_ & 1) * 64;
    const int tstr = (MODE == 0 && tp_ >= 4) ? 64 : 2048;
    ALDS unsigned* tdump = (ALDS unsigned*)(lds + 126976 + wid * 256);
#define MID_STAGE() do { if (!(EXP & 8) && s + 1 < NT) { ST_WRITE(bufn); \
            if (s + 2 < NT) ST_LOAD(TILE_OF(s + 2)); \
            if (ATT_TOUCH) { if (s + ATT_TOUCH < NT && wid < LPK) __builtin_amdgcn_global_load_lds((const __attribute__((address_space(1))) unsigned*)(tsrc + (size_t)TILE_OF(s + ATT_TOUCH) * KVBLK * tstr), tdump, 4, 0, 0); } } } while (0)
    if (ATT_SPRIO && wid >= 4) __builtin_amdgcn_s_setprio(1);
    const int NSTEP = STAG ? NT + 1 : NT;
    ALDS unsigned* vote = (ALDS unsigned*)(lds + OFF_S);
    for (int s = 0; s < NSTEP; ++s) {
#ifdef ATT_CNT
        if (MODE == ATT_CNT - 1 && blockIdx.x == 0 && wid == 0 && lane == 0) ((ALDS unsigned*)(lds + 131072 + 320 + 80))[0] += 1u;
#endif
        const int j = TILE_OF(s);
        const int jy = grpB ? TILE_OF(s - 1) : j; const int vby = grpB ? bufp : buf;
        const bool dead = (MODE == 1 && ATT_SB_SKIP) && __all(carry == 0.0f);
        const bool actq = s < NT && ACTIVE(j) && !(EXP & 4) && !((EXP & 128) && wid >= 4) && !dead, acty = (grpB ? s > 0 : s < NT) && ACTIVE(jy) && !dead;
        if (!grpB && actq) QK_STAGE();
        MID_STAGE();
        if (acty) SMPV_STAGE(jy, vby);
        if (grpB && actq) QK_STAGE();
        if (MODE == 1 && ATT_SB_SKIP) { const bool deadn = __all(carry == 0.0f); if (lane == 0) vote[(s & 1) * 8 + wid] = deadn ? 1u : 0u; }
        if (ATT_RAWBAR) asm volatile("s_waitcnt lgkmcnt(0)\n\ts_barrier" ::: "memory"); else __syncthreads();
        bufp = buf; buf = bufn; bufn = (bufn == 2) ? 0 : bufn + 1;
        if (MODE == 1 && ATT_SB_SKIP) { const ALDS unsigned* vv = vote + (s & 1) * 8; const unsigned all8 = vv[0] & vv[1] & vv[2] & vv[3] & vv[4] & vv[5] & vv[6] & vv[7];
            if (__builtin_amdgcn_readfirstlane((int)all8)) break; }
    }
    if (ATT_SPRIO) __builtin_amdgcn_s_setprio(0);
#undef QK_STAGE
#undef QK_AD
#undef QK_RD
#undef QK_MM
#undef SMPV_STAGE
#undef ACTIVE
#undef MID_STAGE
    }
    { int le_ = (int)__builtin_amdgcn_mbcnt_hi(~0u, __builtin_amdgcn_mbcnt_lo(~0u, 0u)); asm volatile("" : "+v"(le_));
      const int r32e = le_ & 31, hie = le_ >> 5;
      ALDS float* wse = (ALDS float*)(lds + OFF_S) + wid * 64;
      float rli[16];
      if (MODE == 0) { if (hie == 0) wse[32 + r32e] = l_reg; asm volatile("s_waitcnt lgkmcnt(0)" ::: "memory");
#pragma unroll
          for (int r = 0; r < 16; ++r) rli[r] = __builtin_amdgcn_rcpf(wse[32 + crow(r, hie)]);
      } else {
#pragma unroll
          for (int r = 0; r < 16; ++r) rli[r] = 1.f; }
      if (ATT_RAWBAR) asm volatile("s_waitcnt lgkmcnt(0)\n\ts_barrier" ::: "memory"); else __syncthreads();
      ALDS unsigned* stg = (ALDS unsigned*)(lds + OFF_K) + wid * 2048;
#pragma unroll
      for (int r = 0; r < 16; ++r) { const int orow = crow(r, hie);
#pragma unroll
          for (int d0 = 0; d0 < 4; ++d0) { const float v = o[d0][r] * rli[r]; const float vn = __int_as_float(__builtin_amdgcn_mov_dpp(__float_as_int(v), 0xB1  , 0xF, 0xF, true));
              if ((r32e & 1) == 0) stg[orow * 64 + d0 * 16 + (r32e >> 1)] = cvtpk(v, vn); } }
      asm volatile("s_waitcnt lgkmcnt(0)" ::: "memory");
      bf16_t* Ow = Op + (tok0 + qlo) * 1024 + h * 128;
#pragma unroll
      for (int i = 0; i < 8; ++i) { const int row = (le_ >> 4) + 4 * i, ch = le_ & 15; const u32x4 w = *(const ALDS u32x4*)(stg + row * 64 + ch * 4);
          *(u32x4*)(Ow + (size_t)row * 1024 + ch * 8) = w; } }
    if (ATT_RAWBAR) asm volatile("s_waitcnt lgkmcnt(0)\n\ts_barrier" ::: "memory"); else __syncthreads();
#undef ST_LOAD
#undef ST_WRITE
#undef TILE_OF
}
#undef ASBAR
}

constexpr int NWAVES = 8;
#ifndef MK_PER_PHASE
#define MK_PER_PHASE 0
#endif
#ifndef MK_STAMP_A
#define MK_STAMP_A -1
#define MK_STAMP_B -1
#endif
#ifndef MK_STAMP_Q
#define MK_STAMP_Q 2000u
#endif
#ifndef MK_STAMP_T0
#define MK_STAMP_T0 100.0f
#endif
constexpr int BATCH = 8, SEQ = 4096, DM = 1024, NTOK = BATCH * SEQ;
constexpr int QLORA = 384, QLP = 384  , KVLORA = 256, ROPE = 64, NLAT = 704, NLATP = 768, NHEAD = 8;
constexpr int NQ = NHEAD * 192, NKV = NHEAD * 256, DFF = 3584, NGU = 2 * DFF, NEXP = 8;
constexpr int MOE_ROWS = 2 * NTOK + NEXP * 256;
constexpr float EPSN = 1e-6f;
constexpr int XSP = 2048;
constexpr float C2_MLA = 1.4426950408889634f * 0.07216878364870322f;
constexpr float C2_SB = 1.4426950408889634f * 0.08838834764831845f;
constexpr size_t MiB = 1u << 20;
constexpr size_t WS_CTL = 0, CTL_ZERO_BYTES = 1 * MiB;
constexpr size_t WS_MOD = 1 * MiB;
constexpr size_t WS_MODKV = WS_MOD + (size_t)2 * 8 * 6144 * 4;
constexpr size_t WS_RT_E = 2 * MiB, WS_RT_POS = WS_RT_E + 256 * 1024, WS_RT_W = WS_RT_POS + 256 * 1024;
constexpr size_t WS_COS = 4 * MiB;
constexpr size_t WS_WAD = 12 * MiB, WS_WUQ = 14 * MiB, WS_WUKV = 16 * MiB, WS_WOA = 18 * MiB, WS_WKVSB = 20 * MiB, WS_WQSB = 24 * MiB, WS_WOSB = 26 * MiB;
constexpr size_t WS_WDN = 28 * MiB, WS_WGU = 36 * MiB, WS_WEGU = 50 * MiB, WS_WEDN = 162 * MiB;
constexpr size_t WS_HB0 = 224 * MiB, WS_LAT = 288 * MiB, WS_CQ = 384 * MiB, WS_CKV = 416 * MiB, WS_KROT = 720 * MiB, WS_Q = 432 * MiB, WS_KV = 528 * MiB, WS_AO = 656 * MiB;
constexpr size_t WS_ACT = 288 * MiB;
constexpr size_t WS_HB1 = 288 * MiB, WS_KVSB = 352 * MiB, WS_QSB = 480 * MiB;
constexpr size_t WS_HS = 224 * MiB, WS_ACT2 = 356 * MiB, WS_Y = 224 * MiB;
constexpr size_t WS_SLAB = WS_WEGU;
constexpr int MOE_MAIN_TILES = 256;
constexpr size_t WS_END = 818 * MiB;
static_assert(WS_ACT2 + (size_t)MOE_ROWS * DFF * 2 <= WS_END && WS_HS + (size_t)MOE_ROWS * DM * 2 <= WS_ACT2 && WS_WEDN + (size_t)NEXP * DM * DFF * 2 <= WS_HB0, "d_ws map");
constexpr int CW_TMO = 0, CW_CODE = 1;
constexpr int CW_BAR = 4096;
constexpr int CW_CNT = 16384;
constexpr int CW_CHK = 20480;
constexpr int CW_STAMP = 28672;
constexpr int CW_TRQ = 24576;
constexpr int RING_OFF = 0, RING_BYTES = 131072;
constexpr int LDSCTL_OFF = RING_BYTES, MISC_OFF = LDSCTL_OFF + 320;
constexpr int LDS_BYTES = 147456;
static_assert(MISC_OFF + 128 <= LDS_BYTES && att::LDS_BYTES <= RING_BYTES, "LDS map");

#define GAS __attribute__((address_space(1)))
#define LAS __attribute__((address_space(3)))
typedef unsigned short bf16;
typedef unsigned v4u __attribute__((ext_vector_type(4)));
typedef unsigned v2u __attribute__((ext_vector_type(2)));
typedef float f32x4 __attribute__((ext_vector_type(4)));
typedef float f32x2 __attribute__((ext_vector_type(2)));
typedef GAS unsigned gu32;
#define RLX_AGENT __ATOMIC_RELAXED, __HIP_MEMORY_SCOPE_AGENT
#define LDS_WAIT() asm volatile("s_waitcnt lgkmcnt(0)" ::: "memory")
#define VM_WAIT() asm volatile("s_waitcnt vmcnt(0)" ::: "memory")
__device__ __forceinline__ unsigned f2bf(float f) { unsigned u = __builtin_bit_cast(unsigned, f); return (u + 0x7fffu + ((u >> 16) & 1u)) >> 16; }
__device__ __forceinline__ unsigned pk2(float lo, float hi) { return f2bf(lo) | (f2bf(hi) << 16); }
__device__ __forceinline__ float bf2f(unsigned short h) { return __builtin_bit_cast(float, (unsigned)h << 16); }


#define XB_TMO      128
#define XB_XCNT(j)  (256  + 64 * (j))
#define XB_XSUB(j)  (1280 + 64 * (j))
#define XB_XGEN(j)  (2304 + 64 * (j))
#define XB_TOP      3328
#define XB_TOPGEN   3392
#define XCD_BAR_WORDS 3456
#define XB_SPIN_CAP (1u << 18)

__device__ __forceinline__ unsigned xb_ld(unsigned* p)              { return __hip_atomic_load(p, __ATOMIC_RELAXED, __HIP_MEMORY_SCOPE_AGENT); }
__device__ __forceinline__ unsigned xb_add(unsigned* p, unsigned v) { return __hip_atomic_fetch_add(p, v, __ATOMIC_RELAXED, __HIP_MEMORY_SCOPE_AGENT); }
__device__ __forceinline__ unsigned xb_xcc_id() { return (unsigned)__builtin_amdgcn_s_getreg((3 << 11) | 20) & 0xFu; }
#define XB_SPIN(cond, bar) do { unsigned _sp = 0; while (cond) { __builtin_amdgcn_s_sleep(1); \
    if ((++_sp & 255u) == 0u) { if (xb_ld(&(bar)[XB_TMO])) break; if (_sp > XB_SPIN_CAP) { atomicAdd(&(bar)[XB_TMO], 1u); break; } } } } while (0)

struct XcdBarrier {
    unsigned* bar; unsigned x;
    int w0;
    volatile LAS unsigned* st;
};

__device__ __forceinline__ XcdBarrier xcd_barrier_post(unsigned* bar, volatile LAS unsigned* st) {
    XcdBarrier b; b.bar = bar; b.x = xb_xcc_id(); b.st = st; b.w0 = __builtin_amdgcn_readfirstlane((int)(threadIdx.x >> 6));
    if (threadIdx.x == 0) (void)xb_add(&bar[XB_XCNT(b.x)], 1u);
    return b;
}
__device__ __forceinline__ void xcd_barrier_complete(unsigned* bar, unsigned x, unsigned& nloc, unsigned& nx) {
    const unsigned G = gridDim.x * gridDim.y * gridDim.z;
    unsigned sum, cnt, mine, sp = 0u;
    for (;;) {
        sum = 0u; cnt = 0u; mine = 0u;
#pragma unroll
        for (unsigned j = 0; j < 16; ++j) { const unsigned c = xb_ld(&bar[XB_XCNT(j)]); sum += c; cnt += (c > 0u) ? 1u : 0u; mine = (j == x) ? c : mine; }
        if (sum == G) break;
        __builtin_amdgcn_s_sleep(1);
        if ((++sp & 255u) == 0u) { if (xb_ld(&bar[XB_TMO])) break; if (sp > XB_SPIN_CAP) { atomicAdd(&bar[XB_TMO], 1u); break; } }
    }
    nloc = mine > 0u ? mine : 1u; nx = cnt > 0u ? cnt : 1u;
}

__device__ __forceinline__ void xcd_barrier(const XcdBarrier& b) {
    asm volatile("s_waitcnt vmcnt(0)" ::: "memory");
    __syncthreads();
    if (b.w0 == 0 && __builtin_amdgcn_mbcnt_hi(~0u, __builtin_amdgcn_mbcnt_lo(~0u, 0u)) == 0u) {
        unsigned* bar = b.bar;
        __builtin_amdgcn_s_waitcnt(0);
        unsigned nloc = b.st[0], nx = b.st[1];
        if (nloc == 0u) { xcd_barrier_complete(bar, b.x, nloc, nx); b.st[0] = nloc; b.st[1] = nx; }
        const unsigned old = xb_add(&bar[XB_XSUB(b.x)], 1u);
        const unsigned gen = old / nloc;
        if (old + 1u == (gen + 1u) * nloc) {
            __builtin_amdgcn_fence(__ATOMIC_RELEASE, "agent");
            asm volatile("s_waitcnt vmcnt(0)" ::: "memory");
            const unsigned og = xb_add(&bar[XB_TOP], 1u);
            const unsigned tg = og / nx;
            if (og + 1u == (tg + 1u) * nx) xb_add(&bar[XB_TOPGEN], 1u);
            else XB_SPIN(xb_ld(&bar[XB_TOPGEN]) == tg, bar);
            __builtin_amdgcn_fence(__ATOMIC_ACQUIRE, "agent");
            xb_add(&bar[XB_XGEN(b.x)], 1u);
            asm volatile("s_waitcnt vmcnt(0)" ::: "memory");
        } else {
            XB_SPIN(xb_ld(&bar[XB_XGEN(b.x)]) == gen, bar);
            __builtin_amdgcn_fence(__ATOMIC_ACQUIRE, "agent");
            asm volatile("s_waitcnt vmcnt(0)" ::: "memory");
        }
    }
    __syncthreads();
}


struct Frame {
    LAS unsigned char* lds;
    volatile LAS unsigned* MISC;
    gu32* ctl;
    int tid, lane, wave;
    int vcu, G;
    unsigned char* ws;
};
struct Args { const float* in[26]; float* out; unsigned char* ws; float inv[32]; int ph_lo, ph_hi, li, pad; };

#define WS_DPP(v, ctrl) __builtin_bit_cast(float, __builtin_amdgcn_update_dpp(0, __builtin_bit_cast(int, (v)), (ctrl), 0xf, 0xf, true))
__device__ __forceinline__ float wave_sum(float v) {
    v += WS_DPP(v, 0xB1); v += WS_DPP(v, 0x4E);
    v += WS_DPP(v, 0x141); v += WS_DPP(v, 0x140);
    { auto rr = __builtin_amdgcn_permlane16_swap(__float_as_uint(v), __float_as_uint(v), false, false); v = __uint_as_float(rr[0]) + __uint_as_float(rr[1]); }
    { auto rr = __builtin_amdgcn_permlane32_swap(__float_as_uint(v), __float_as_uint(v), false, false); v = __uint_as_float(rr[0]) + __uint_as_float(rr[1]); }
    return v;
}
__device__ __forceinline__ int rope_src(int p) { const int g = p >> 3, jj = p & 7; return jj < 4 ? 4 * g + jj : 32 + 4 * g + (jj - 4); }
__device__ __forceinline__ int src_col(int kind, int rho) {
    if (kind == 1) return rho < 640 ? rho : (rho < 704 ? 640 + rope_src(rho - 640) : -1);
    if (kind == 2) { if (rho < 1024) return (rho >> 7) * 192 + (rho & 127); const int r = rho - 1024; return (r >> 6) * 192 + 128 + rope_src(r & 63); }
    if (kind == 3) { const int t = rho >> 8, r = rho & 255; return r < 128 ? t * 128 + r : DFF + t * 128 + (r - 128); }
    return rho;
}
#ifndef TR_BATCH
#define TR_BATCH 1
#endif
#ifndef TR_NTST
#define TR_NTST 1
#endif
#ifndef TR_KFAST
#define TR_KFAST 0
#endif
struct TrItem { f32x4 v[16]; };
__device__ __forceinline__ void tr_load(TrItem& t, const float* W, int K, int N, int kind, int item, int nblk, int lane, int nkb) {
    const int kb = TR_KFAST ? item % nkb : item / nblk, nb = TR_KFAST ? item / nkb : item % nblk, k0 = 128 * kb, n0 = 32 * nb, kq = lane >> 3, nq = lane & 7;
    const int sc = src_col(kind, n0 + 4 * nq);
#pragma unroll
    for (int i = 0; i < 8; ++i) { const int k = k0 + 16 * i + 2 * kq;
        const bool ok = sc >= 0 && k < K;
        t.v[2 * i] = ok ? __builtin_nontemporal_load((const f32x4*)(W + (size_t)k * N + sc)) : (f32x4){0.f, 0.f, 0.f, 0.f};
        t.v[2 * i + 1] = ok ? __builtin_nontemporal_load((const f32x4*)(W + (size_t)(k + 1) * N + sc)) : (f32x4){0.f, 0.f, 0.f, 0.f}; }
}
__device__ __forceinline__ void tr_store(const TrItem& t, bf16* WT, int Kd, LAS unsigned* T, int item, int nblk, int lane, int pexp = 0) {
    const int nkb = Kd / 128; const int kb = TR_KFAST ? item % nkb : item / nblk, nb = TR_KFAST ? item / nkb : item % nblk, k0 = 128 * kb, n0 = 32 * nb, kq = lane >> 3, nq = lane & 7;
#pragma unroll
    for (int i = 0; i < 8; ++i) { const f32x4 a = t.v[2 * i], b = t.v[2 * i + 1]; LAS unsigned* p = T + (4 * nq) * 65 + 8 * i + kq;
        p[0] = pg8::cvt_pk_bf16(a.x, b.x); p[65] = pg8::cvt_pk_bf16(a.y, b.y); p[130] = pg8::cvt_pk_bf16(a.z, b.z); p[195] = pg8::cvt_pk_bf16(a.w, b.w); }
    LDS_WAIT(); asm volatile("" ::: "memory");
    const int c = lane & 15, nl = lane >> 4;
#pragma unroll
    for (int j = 0; j < 8; ++j) { const int n = nl + 4 * j; const LAS unsigned* s = T + n * 65 + 4 * c;
        v4u o; o.x = s[0]; o.y = s[1]; o.z = s[2]; o.w = s[3];
        if (!(pexp & 8) || o.x == 0x12345678u) { if (TR_NTST) __builtin_nontemporal_store(o, (GAS v4u*)(WT + (size_t)(n0 + n) * Kd + k0 + 8 * c)); else *(GAS v4u*)(WT + (size_t)(n0 + n) * Kd + k0 + 8 * c) = o; } }
    LDS_WAIT(); asm volatile("" ::: "memory");
}
struct TrDesc { const float* W; bf16* WT; int K, N, Kd, kind, nblk; };
constexpr int TR_NITEMS = NEXP * (DM / 64) * (NGU / 64) + NEXP * (DFF / 64) * (DM / 64) + (DM / 64) * (NGU / 64) + (DFF / 64) * (DM / 64) + (DM / 64) * (NLATP / 64) + (QLP / 64) * (NQ / 64) + (KVLORA / 64) * (NKV / 64) + 3 * (DM / 64) * (DM / 64) + (DM / 64) * (2048 / 64);
__device__ __forceinline__ bool tr_decode(Frame& F, const Args& a, int it, TrDesc& d, int& r) {
    constexpr int I_EGU = (DM / 64) * (NGU / 64), I_EDN = (DFF / 64) * (DM / 64);
    constexpr int I_GU = I_EGU, I_DN = I_EDN, I_AD = (DM / 64) * (NLATP / 64), I_UQ = (QLP / 64) * (NQ / 64), I_UKV = (KVLORA / 64) * (NKV / 64);
    constexpr int I_SQ = (DM / 64) * (DM / 64), I_KVSB = (DM / 64) * (2048 / 64);
    constexpr int NITEMS = NEXP * I_EGU + NEXP * I_EDN + I_GU + I_DN + I_AD + I_UQ + I_UKV + 3 * I_SQ + I_KVSB;
    static_assert(NITEMS == TR_NITEMS, "item count"); if (it >= NITEMS) return false;
    r = it;
    if (r < NEXP * I_EGU) { const int e = r / I_EGU; r -= e * I_EGU; d = TrDesc{a.in[23] + (size_t)e * DM * NGU, (bf16*)(F.ws + WS_WEGU) + (size_t)e * NGU * DM, DM, NGU, DM, 3, NGU / 32}; return true; } r -= NEXP * I_EGU;
    if (r < NEXP * I_EDN) { const int e = r / I_EDN; r -= e * I_EDN; d = TrDesc{a.in[24] + (size_t)e * DFF * DM, (bf16*)(F.ws + WS_WEDN) + (size_t)e * DM * DFF, DFF, DM, DFF, 0, DM / 32}; return true; } r -= NEXP * I_EDN;
    if (r < I_GU) { d = TrDesc{a.in[19], (bf16*)(F.ws + WS_WGU), DM, NGU, DM, 3, NGU / 32}; return true; } r -= I_GU;
    if (r < I_DN) { d = TrDesc{a.in[20], (bf16*)(F.ws + WS_WDN), DFF, DM, DFF, 0, DM / 32}; return true; } r -= I_DN;
    if (r < I_SQ) { d = TrDesc{a.in[12], (bf16*)(F.ws + WS_WOA), DM, DM, DM, 0, DM / 32}; return true; } r -= I_SQ;
    if (r < I_SQ) { d = TrDesc{a.in[17], (bf16*)(F.ws + WS_WQSB), DM, DM, DM, 0, DM / 32}; return true; } r -= I_SQ;
    if (r < I_SQ) { d = TrDesc{a.in[18], (bf16*)(F.ws + WS_WOSB), DM, DM, DM, 0, DM / 32}; return true; } r -= I_SQ;
    if (r < I_KVSB) { d = TrDesc{a.in[16], (bf16*)(F.ws + WS_WKVSB), DM, 2048, DM, 0, 2048 / 32}; return true; } r -= I_KVSB;
    if (r < I_AD) { d = TrDesc{a.in[7], (bf16*)(F.ws + WS_WAD), DM, NLAT, DM, 1, NLATP / 32}; return true; } r -= I_AD;
    if (r < I_UQ) { d = TrDesc{a.in[10], (bf16*)(F.ws + WS_WUQ), QLORA, NQ, QLP, 2, NQ / 32}; return true; } r -= I_UQ;
    d = TrDesc{a.in[11], (bf16*)(F.ws + WS_WUKV), KVLORA, NKV, KVLORA, 0, NKV / 32}; return true;
}
constexpr int TR_EARLY0 = TR_NITEMS - ((DM / 64) * (NLATP / 64) + (QLP / 64) * (NQ / 64) + (KVLORA / 64) * (NKV / 64));
template <int BATCH = TR_BATCH>
__device__ __forceinline__ void tr_run(Frame& F, const Args& a, int qbase, int lo, int hi, int pexp = 0, int maxb = 0x7fffffff  ) {
    LAS unsigned* T = (LAS unsigned*)(F.lds + RING_OFF + F.wave * 8448);
    const int q0 = (int)(xb_xcc_id() & 7u);
    int qd = 0;
    TrItem cur, nxt; TrDesc dc, dn; int rc = 0, rn = 0;
    int bq = 0, bl = 0, bqq = 0, nb = 0;
#define TR_NEXT(itv) do { itv = -1; \
        while (bl == 0 && qd < 8 && nb < maxb) { const int qq_ = (q0 + qd) & 7; gu32* head_ = F.ctl + CW_TRQ + qbase + 64 * qq_; const int nq_ = (hi - lo - qq_ + 7) >> 3; \
            int c_ = nq_; if (qd == 0 || (int)__hip_atomic_load(head_, RLX_AGENT) < nq_) { c_ = 0; if (F.lane == 0) c_ = (int)__hip_atomic_fetch_add(head_, (unsigned)BATCH, RLX_AGENT); c_ = __builtin_amdgcn_readfirstlane(c_); } \
            if (c_ < nq_) { bq = c_; bl = (nq_ - c_ < BATCH) ? nq_ - c_ : BATCH; bqq = qq_; ++nb; } else ++qd; } \
        if (bl > 0) { itv = lo + bq * 8 + bqq; ++bq; --bl; } } while (0)
    int it; TR_NEXT(it);
    bool have = it >= 0 && tr_decode(F, a, it, dc, rc);
    if (have) tr_load(cur, dc.W, dc.K, dc.N, dc.kind, rc, dc.nblk, F.lane, dc.Kd / 128);
    while (have) {
        int itn; TR_NEXT(itn);
        const bool haven = itn >= 0 && tr_decode(F, a, itn, dn, rn);
        if (haven) tr_load(nxt, dn.W, dn.K, dn.N, dn.kind, rn, dn.nblk, F.lane, dn.Kd / 128);
        tr_store(cur, dc.WT, dc.Kd, T, rc, dc.nblk, F.lane, pexp);
        cur = nxt; dc = dn; rc = rn; have = haven;
    }
#undef TR_NEXT
}

__device__ __forceinline__ void p0_prologue(Frame& F, const Args& a, int qbase = 0, int pexp = 0) {
    if (!(pexp & 1)) {
        constexpr int NCG = 224;
        LAS float* sl = (LAS float*)(F.lds + RING_OFF);
        LAS float* red = (LAS float*)(F.lds + RING_OFF + 32768);
        float* MOD = (float*)(F.ws + WS_MOD); float* MODKV = (float*)(F.ws + WS_MODKV);
        const int bxg = (int)blockIdx.x;
        if (bxg < NCG) {
            for (int i = F.tid; i < 8192; i += NWAVES * 64) { const float c = a.in[1][i]; sl[i] = c / (1.0f + __expf(-c)); }
            __syncthreads();
        }
        for (int cg = bxg; cg < NCG; cg += F.G) {
            const float* W; const float* bias; float* out; int ldw, ldo, col0;
            if (cg < 96) { W = a.in[3]; bias = a.in[4]; out = MOD; ldw = 6144; ldo = 6144; col0 = cg * 64; }
            else if (cg < 192) { W = a.in[3] + (size_t)DM * 6144; bias = a.in[4] + 6144; out = MOD + 8 * 6144; ldw = 6144; ldo = 6144; col0 = (cg - 96) * 64; }
            else { W = a.in[13]; bias = a.in[14]; out = MODKV; ldw = 2048; ldo = 2048; col0 = (cg - 192) * 64; }
            f32x4 acc[8];
#pragma unroll
            for (int b = 0; b < 8; ++b) acc[b] = (f32x4){0.f, 0.f, 0.f, 0.f};
            const int rq = F.lane >> 4, l16 = F.lane & 15;
            const float* wp = W + (size_t)(F.wave * 128 + rq) * ldw + col0 + 4 * l16;
            for (int k8 = 0; k8 < 32; k8 += 8) {
                f32x4 wv[8];
#pragma unroll
                for (int u = 0; u < 8; ++u) wv[u] = __builtin_nontemporal_load((const f32x4*)(wp + (size_t)(4 * (k8 + u)) * ldw));
#pragma unroll
                for (int u = 0; u < 8; ++u) {
#pragma unroll
                    for (int b = 0; b < 8; ++b) { const float s = sl[b * 1024 + F.wave * 128 + 4 * (k8 + u) + rq]; acc[b] += wv[u] * s; } }
            }
#pragma unroll
            for (int b = 0; b < 8; ++b) *(LAS f32x4*)(red + ((F.wave * 4 + rq) * 8 + b) * 64 + 4 * l16) = acc[b];
            __syncthreads();
            { const int idx = F.tid; const int b = idx >> 6, col = idx & 63; float s = bias[col0 + col];
#pragma unroll
                for (int w = 0; w < 32; ++w) s += red[(w * 8 + b) * 64 + col];
                out[(size_t)b * ldo + col0 + col] = s; }
            __syncthreads();
        }
        __syncthreads();
    }
    if (!(pexp & 2)) {
        float* CS = (float*)(F.ws + WS_COS); const int* pos = (const int*)a.in[2];
        for (int idx = (F.vcu * NWAVES * 64) + F.tid; idx < NTOK * 32; idx += F.G * NWAVES * 64) {
            const int t = idx >> 5, i = idx & 31;
            const double rev = (double)pos[t] * (double)a.inv[i] * 0.15915494309189535;
            const float fr = (float)(rev - __builtin_rint(rev));
            CS[t * 64 + i] = __builtin_amdgcn_cosf(fr); CS[t * 64 + 32 + i] = __builtin_amdgcn_sinf(fr);
        }
    }
    if (!(pexp & 4)) tr_run(F, a, qbase, TR_EARLY0, TR_NITEMS, pexp);
    __syncthreads();
}

template <bool TWO, bool INB = false  >
__device__ __forceinline__ void norm_phase(Frame& F, const float* X, const float* g0, const float* sc0, const float* sh0, int st0, bf16* H0,
                                           const float* g1, const float* sc1, const float* sh1, int st1, bf16* H1) {
    const int gw = F.vcu * NWAVES + F.wave, NGW = F.G * NWAVES;
    for (int c = gw; c < NTOK / 16; c += NGW) {
        const int row0 = c * 16, b = row0 / SEQ;
        f32x4 A0[4], B0[4], A1[4], B1[4];
#pragma unroll
        for (int j = 0; j < 4; ++j) { const int col = 4 * F.lane + 256 * j;
            A0[j] = *(const f32x4*)(g0 + col) * (*(const f32x4*)(sc0 + (size_t)b * st0 + col) + 1.0f); B0[j] = *(const f32x4*)(sh0 + (size_t)b * st0 + col);
            if (TWO) { A1[j] = *(const f32x4*)(g1 + col) * (*(const f32x4*)(sc1 + (size_t)b * st1 + col) + 1.0f); B1[j] = *(const f32x4*)(sh1 + (size_t)b * st1 + col); } }
        {
            constexpr int NB = INB ? 8 : 4;
            for (int rb = 0; rb < 16; rb += NB) {
                v2u q[INB ? NB : 1][4]; f32x4 qf[INB ? 1 : NB][4];
#pragma unroll
                for (int k = 0; k < NB; ++k) { const GAS v2u* xb = (const GAS v2u*)((const bf16*)X + (size_t)(row0 + rb + k) * XSP) + F.lane; const GAS f32x4* xr = (const GAS f32x4*)(X + (size_t)(row0 + rb + k) * DM) + F.lane;
#pragma unroll
                    for (int j = 0; j < 4; ++j) { if (INB) q[k][j] = xb[64 * j]; else qf[k][j] = __builtin_nontemporal_load(xr + 64 * j); } }
#pragma unroll
                for (int k = 0; k < NB; ++k) { const int r = rb + k;
                    f32x4 v[4]; float s2 = 0.f;
#pragma unroll
                    for (int j = 0; j < 4; ++j) { if (INB) { const v2u w = q[k][j]; v[j] = (f32x4){__uint_as_float(w.x << 16), __uint_as_float(w.x & 0xffff0000u), __uint_as_float(w.y << 16), __uint_as_float(w.y & 0xffff0000u)}; } else v[j] = qf[k][j];
                        s2 += (v[j].x * v[j].x + v[j].y * v[j].y) + (v[j].z * v[j].z + v[j].w * v[j].w); }
                    const float rstd = 1.0f / sqrtf(wave_sum(s2) * (1.0f / DM) + EPSN);
                    GAS unsigned long long* o0 = (GAS unsigned long long*)(H0 + (size_t)(row0 + r) * DM) + F.lane;
#pragma unroll
                    for (int j = 0; j < 4; ++j) { const f32x4 y = v[j] * rstd * A0[j] + B0[j]; o0[64 * j] = (unsigned long long)pk2(y.x, y.y) | ((unsigned long long)pk2(y.z, y.w) << 32); }
                    if (TWO) { GAS unsigned long long* o1 = (GAS unsigned long long*)(H1 + (size_t)(row0 + r) * DM) + F.lane;
#pragma unroll
                        for (int j = 0; j < 4; ++j) { const f32x4 y = v[j] * rstd * A1[j] + B1[j]; o1[64 * j] = (unsigned long long)pk2(y.x, y.y) | ((unsigned long long)pk2(y.z, y.w) << 32); } }
                }
            }
        }
    }
}

__device__ __forceinline__ void lat_phase(Frame& F, const Args& a) {
    const int gw = F.vcu * NWAVES + F.wave, NGW = F.G * NWAVES, l = F.lane;
    const float* LAT = (const float*)(F.ws + WS_LAT); const float* CS = (const float*)(F.ws + WS_COS);
    bf16* CQ = (bf16*)(F.ws + WS_CQ); bf16* CKV = (bf16*)(F.ws + WS_CKV); bf16* KR = (bf16*)(F.ws + WS_KROT);
    const f32x4 G0 = *(const f32x4*)(a.in[8] + 4 * l);
    const f32x4 G1 = l < 32 ? *(const f32x4*)(a.in[8] + 256 + 4 * l) : *(const f32x4*)(a.in[9] + 4 * (l - 32));
    const f32x4 G2 = l < 32 ? *(const f32x4*)(a.in[9] + 128 + 4 * l) : (f32x4){0.f, 0.f, 0.f, 0.f};
    constexpr int LATB = 8;
    const int u = l - 32, g = (u >> 1) & 7;
    for (int rowb = gw; rowb < NTOK; rowb += LATB * NGW) {
        v2u W0[LATB], W1[LATB], W2[LATB]; f32x4 CSV[LATB], SNV[LATB];
#pragma unroll
        for (int k = 0; k < LATB; ++k) { const int row = (rowb + k * NGW < NTOK) ? rowb + k * NGW : rowb;
            const GAS v2u* xr = (const GAS v2u*)((const bf16*)LAT + (size_t)row * NLATP) + l;
            W0[k] = xr[0]; W1[k] = xr[64]; W2[k] = xr[128];
            if (l >= 32 && l < 48) { CSV[k] = *(const f32x4*)(CS + (size_t)row * 64 + 4 * g); SNV[k] = *(const f32x4*)(CS + (size_t)row * 64 + 32 + 4 * g); } }
#pragma unroll
        for (int k = 0; k < LATB; ++k) { const int row = rowb + k * NGW; if (row < NTOK) {
        const v2u w0 = W0[k], w1 = W1[k], w2 = W2[k];
        const f32x4 v0 = (f32x4){__uint_as_float(w0.x << 16), __uint_as_float(w0.x & 0xffff0000u), __uint_as_float(w0.y << 16), __uint_as_float(w0.y & 0xffff0000u)};
        const f32x4 v1 = (f32x4){__uint_as_float(w1.x << 16), __uint_as_float(w1.x & 0xffff0000u), __uint_as_float(w1.y << 16), __uint_as_float(w1.y & 0xffff0000u)};
        const f32x4 v2 = (f32x4){__uint_as_float(w2.x << 16), __uint_as_float(w2.x & 0xffff0000u), __uint_as_float(w2.y << 16), __uint_as_float(w2.y & 0xffff0000u)};
        const float q0 = (v0.x * v0.x + v0.y * v0.y) + (v0.z * v0.z + v0.w * v0.w), q1 = (v1.x * v1.x + v1.y * v1.y) + (v1.z * v1.z + v1.w * v1.w), q2 = (v2.x * v2.x + v2.y * v2.y) + (v2.z * v2.z + v2.w * v2.w);
        const float sq = wave_sum(q0 + (l < 32 ? q1 : 0.f)), skv = wave_sum((l < 32 ? q2 : q1));
        const float rq = 1.0f / sqrtf(sq * (1.0f / QLORA) + EPSN), rkv = 1.0f / sqrtf(skv * (1.0f / KVLORA) + EPSN);
        { const f32x4 y = v0 * rq * G0; *(GAS unsigned long long*)(CQ + (size_t)row * QLP + 4 * l) = (unsigned long long)pk2(y.x, y.y) | ((unsigned long long)pk2(y.z, y.w) << 32); }
        { const f32x4 y = v1 * (l < 32 ? rq : rkv) * G1; bf16* dst = l < 32 ? CQ + (size_t)row * QLP + 256 + 4 * l : CKV + (size_t)row * KVLORA + 4 * (l - 32);
          *(GAS unsigned long long*)dst = (unsigned long long)pk2(y.x, y.y) | ((unsigned long long)pk2(y.z, y.w) << 32); }
        f32x4 pr; pr.x = __shfl_xor(v2.x, 1); pr.y = __shfl_xor(v2.y, 1); pr.z = __shfl_xor(v2.z, 1); pr.w = __shfl_xor(v2.w, 1);
        if (l < 32) { const f32x4 y = v2 * rkv * G2; *(GAS unsigned long long*)(CKV + (size_t)row * KVLORA + 128 + 4 * l) = (unsigned long long)pk2(y.x, y.y) | ((unsigned long long)pk2(y.z, y.w) << 32); }
        else if (QLP > QLORA) { *(GAS unsigned long long*)(CQ + (size_t)row * QLP + QLORA + 4 * (l - 32)) = 0ull; }
        if (l >= 32 && l < 48) { const f32x4 cs = CSV[k], sn = SNV[k];
            const f32x4 y = (u & 1) ? (pr * sn + v2 * cs) : (v2 * cs - pr * sn);
            *(GAS unsigned long long*)(KR + (size_t)row * ROPE + 4 * u) = (unsigned long long)pk2(y.x, y.y) | ((unsigned long long)pk2(y.z, y.w) << 32); }
        } }
    }
}


__device__ __forceinline__ float rt_red32(float a, float b) { auto rr = __builtin_amdgcn_permlane32_swap(__float_as_uint(a), __float_as_uint(b), false, false); return __uint_as_float(rr[0]) + __uint_as_float(rr[1]); }
__device__ __forceinline__ float rt_red16(float a, float b) { auto rr = __builtin_amdgcn_permlane16_swap(__float_as_uint(a), __float_as_uint(b), false, false); return __uint_as_float(rr[0]) + __uint_as_float(rr[1]); }
__device__ __forceinline__ float rt_red8(const f32x4& lo, const f32x4& hi, bool bit3) {
    const float r0 = rt_red16(rt_red32(lo.x, lo.y), rt_red32(lo.z, lo.w)), r1 = rt_red16(rt_red32(hi.x, hi.y), rt_red32(hi.z, hi.w));
    float t = (bit3 ? r1 : r0) + WS_DPP(bit3 ? r0 : r1, 0x128);
    t += WS_DPP(t, 0x141); t += WS_DPP(t, 0xB1); t += WS_DPP(t, 0x4E);
    return t;
}
__device__ __forceinline__ void router_phase(Frame& F, const Args& a) {
    const int gw = F.vcu * NWAVES + F.wave, NGW = F.G * NWAVES, l = F.lane;
    const float* X = a.out; const float* MOD1 = (const float*)(F.ws + WS_MOD) + 8 * 6144;
    int* RT_E = (int*)(F.ws + WS_RT_E); int* RT_POS = (int*)(F.ws + WS_RT_POS); float* RT_W = (float*)(F.ws + WS_RT_W);
    LAS float* LG = (LAS float*)(F.lds + RING_OFF) + F.wave * 128;
    f32x4 wr[4][4][2];
#pragma unroll
    for (int j = 0; j < 4; ++j)
#pragma unroll
        for (int i = 0; i < 4; ++i) { const float* p = a.in[21] + (size_t)(4 * l + 256 * j + i) * 8; wr[j][i][0] = *(const f32x4*)p; wr[j][i][1] = *(const f32x4*)(p + 4); }
    const bool bit3 = (l & 8) != 0;
    const int my_exp = (int)((__float_as_uint(rt_red8((f32x4){1.f, 2.f, 4.f, 8.f}, (f32x4){16.f, 32.f, 64.f, 128.f}, bit3)) >> 23) & 0xffu) - 133;
    LAS unsigned* CW = (LAS unsigned*)(F.lds + RING_OFF + 8 * 512);
    for (int cb = F.vcu * NWAVES; cb < NTOK / 16; cb += NGW) {
        const int c = cb + F.wave; const int row0 = c * 16, b = row0 / SEQ;
        f32x4 A0[4], B0[4];
#pragma unroll
        for (int j = 0; j < 4; ++j) { const int col = 4 * l + 256 * j;
            A0[j] = *(const f32x4*)(a.in[6] + DM + col) * (*(const f32x4*)(MOD1 + (size_t)b * 6144 + 4096 + col) + 1.0f); B0[j] = *(const f32x4*)(MOD1 + (size_t)b * 6144 + 3072 + col); }
        const GAS v2u* xr = (const GAS v2u*)((const bf16*)X + (size_t)row0 * XSP) + l;
        v2u wn[4];
        (void)wn;
        for (int rb = 0; rb < 16; rb += 4) {
          v2u wq[4][4];
#pragma unroll
          for (int k = 0; k < 4; ++k)
#pragma unroll
            for (int j = 0; j < 4; ++j) wq[k][j] = xr[(size_t)(rb + k) * (XSP / 4) + 64 * j];
#pragma unroll
          for (int k = 0; k < 4; ++k) { const int r = rb + k;
            v2u w[4];
#pragma unroll
            for (int j = 0; j < 4; ++j) w[j] = wq[k][j];
            f32x4 v[4]; float s2 = 0.f;
#pragma unroll
            for (int j = 0; j < 4; ++j) { v[j] = (f32x4){__uint_as_float(w[j].x << 16), __uint_as_float(w[j].x & 0xffff0000u), __uint_as_float(w[j].y << 16), __uint_as_float(w[j].y & 0xffff0000u)}; s2 += (v[j].x * v[j].x + v[j].y * v[j].y) + (v[j].z * v[j].z + v[j].w * v[j].w); }
            const float rstd = __builtin_amdgcn_rsqf(wave_sum(s2) * (1.0f / DM) + EPSN);
            f32x4 lo = (f32x4){0.f, 0.f, 0.f, 0.f}, hi = (f32x4){0.f, 0.f, 0.f, 0.f};
#pragma unroll
            for (int j = 0; j < 4; ++j) { const f32x4 y = v[j] * rstd * A0[j] + B0[j];
                lo += wr[j][0][0] * y.x + wr[j][1][0] * y.y + wr[j][2][0] * y.z + wr[j][3][0] * y.w;
                hi += wr[j][0][1] * y.x + wr[j][1][1] * y.y + wr[j][2][1] * y.z + wr[j][3][1] * y.w; }
            const float t = rt_red8(lo, hi, bit3);
            if ((l & 7) == 0) LG[r * 8 + my_exp] = t;
          }
        }
        LDS_WAIT(); asm volatile("" ::: "memory");
        int myE = -1, mypos = 0; float myW = 0.f;
        if (l < 32) {
            const f32x4 l0 = *(const LAS f32x4*)(LG + (l & 15) * 8), l1 = *(const LAS f32x4*)(LG + (l & 15) * 8 + 4);
            float lg[8] = {l0.x, l0.y, l0.z, l0.w, l1.x, l1.y, l1.z, l1.w};
#pragma unroll
            for (int e = 0; e < 8; ++e) lg[e] += a.in[22][e];
            int e1 = 0; float v1 = lg[0];
#pragma unroll
            for (int e = 1; e < 8; ++e) if (lg[e] > v1) { v1 = lg[e]; e1 = e; }
            int e2 = -1; float v2 = -__builtin_inff();
#pragma unroll
            for (int e = 0; e < 8; ++e) if (e != e1 && lg[e] > v2) { v2 = lg[e]; e2 = e; }
            const float tt = __expf(v2 - v1), w1 = 1.0f / (1.0f + tt), w2 = tt * w1;
            myE = l < 16 ? e1 : e2; myW = l < 16 ? w1 : w2;
        }
        int rank = 0; unsigned mycnt = 0u;
#pragma unroll
        for (int e = 0; e < 8; ++e) { const unsigned long long m = __ballot(myE == e); if (myE == e) rank = __popcll(m & ((1ull << l) - 1ull)); if (l == e) mycnt = (unsigned)__popcll(m); }
        if (l < 8) CW[F.wave * 8 + l] = mycnt;
        __syncthreads();
        if (F.wave == 0) { const int w = l >> 3, e = l & 7; unsigned pre = 0u, tot = 0u;
#pragma unroll
            for (int w2 = 0; w2 < 8; ++w2) { const unsigned v = CW[w2 * 8 + e]; pre += (w2 < w) ? v : 0u; tot += v; }
            unsigned base = 0u;
            if (l < 8 && tot > 0u) base = __hip_atomic_fetch_add((unsigned*)(F.ctl + CW_CNT + 16 * l), tot, RLX_AGENT);
            base = (unsigned)__shfl((int)base, e);
            CW[64 + l] = base + pre; }
        __syncthreads();
        if (myE >= 0) mypos = (int)CW[64 + F.wave * 8 + myE] + rank;
        LDS_WAIT(); asm volatile("" ::: "memory");
        if (l < 32) { const int idx = (row0 + (l & 15)) * 2 + (l >> 4); RT_E[idx] = myE; RT_POS[idx] = mypos; RT_W[idx] = myW; }
    }
}
__device__ __forceinline__ void moe_offsets(Frame& F, unsigned (&cnt)[8], int (&off)[8]) {
    int t = 0;
#pragma unroll
    for (int e = 0; e < 8; ++e) { cnt[e] = __hip_atomic_load((unsigned*)(F.ctl + CW_CNT + 16 * e), RLX_AGENT); off[e] = t; t += (int)((cnt[e] + 255u) & ~255u); }
}
__device__ __forceinline__ void scatter_phase(Frame& F, const Args& a) {
    const int gw = F.vcu * NWAVES + F.wave, NGW = F.G * NWAVES, l = F.lane;
    const float* X = a.out; const float* MOD1 = (const float*)(F.ws + WS_MOD) + 8 * 6144;
    const int* RT_E = (const int*)(F.ws + WS_RT_E); const int* RT_POS = (const int*)(F.ws + WS_RT_POS);
    bf16* HS = (bf16*)(F.ws + WS_HS);
    unsigned cnt[8]; int off[8]; moe_offsets(F, cnt, off);
    for (int c = gw; c < NTOK / 16; c += NGW) {
        const int row0 = c * 16, b = row0 / SEQ;
        f32x4 A0[4], B0[4];
#pragma unroll
        for (int j = 0; j < 4; ++j) { const int col = 4 * l + 256 * j;
            A0[j] = *(const f32x4*)(a.in[6] + DM + col) * (*(const f32x4*)(MOD1 + (size_t)b * 6144 + 4096 + col) + 1.0f); B0[j] = *(const f32x4*)(MOD1 + (size_t)b * 6144 + 3072 + col); }
#pragma unroll 4
        for (int r = 0; r < 16; ++r) {
            const int row = row0 + r;
            const GAS v2u* xr = (const GAS v2u*)((const bf16*)X + (size_t)row * XSP) + l;
            f32x4 v[4]; float s2 = 0.f;
#pragma unroll
            for (int j = 0; j < 4; ++j) { const v2u w = xr[64 * j]; v[j] = (f32x4){__uint_as_float(w.x << 16), __uint_as_float(w.x & 0xffff0000u), __uint_as_float(w.y << 16), __uint_as_float(w.y & 0xffff0000u)}; s2 += (v[j].x * v[j].x + v[j].y * v[j].y) + (v[j].z * v[j].z + v[j].w * v[j].w); }
            const float rstd = 1.0f / sqrtf(wave_sum(s2) * (1.0f / DM) + EPSN);
            const int e1 = RT_E[row * 2], e2 = RT_E[row * 2 + 1], p1 = RT_POS[row * 2], p2 = RT_POS[row * 2 + 1];
            int o1 = 0, o2 = 0;
#pragma unroll
            for (int e = 0; e < 8; ++e) { o1 = (e1 == e) ? off[e] : o1; o2 = (e2 == e) ? off[e] : o2; }
            GAS unsigned long long* d1 = (GAS unsigned long long*)(HS + (size_t)(o1 + p1) * DM) + l; GAS unsigned long long* d2 = (GAS unsigned long long*)(HS + (size_t)(o2 + p2) * DM) + l;
#pragma unroll
            for (int j = 0; j < 4; ++j) { const f32x4 y = v[j] * rstd * A0[j] + B0[j]; const unsigned long long w = (unsigned long long)pk2(y.x, y.y) | ((unsigned long long)pk2(y.z, y.w) << 32); d1[64 * j] = w; d2[64 * j] = w; }
        }
    }
    for (int i = gw; i < 8 * 256; i += NGW) { const int e = i >> 8, r = i & 255; int oe = 0; unsigned ce = 0;
#pragma unroll
        for (int q = 0; q < 8; ++q) { oe = (e == q) ? off[q] : oe; ce = (e == q) ? cnt[q] : ce; }
        if (ce + (unsigned)r < ((ce + 255u) & ~255u)) { GAS unsigned long long* d = (GAS unsigned long long*)(HS + (size_t)(oe + (int)ce + r) * DM) + l;
#pragma unroll
            for (int j = 0; j < 4; ++j) d[64 * j] = 0ull; } }
}
__device__ __forceinline__ void load_yrow(const bf16* Y, int sr, int l, f32x4 (&y)[4]) {
    const GAS v2u* yr = (const GAS v2u*)(Y + (size_t)sr * DM) + l;
#pragma unroll
    for (int j = 0; j < 4; ++j) { const v2u a = yr[64 * j];
        y[j].x = __uint_as_float(a.x << 16); y[j].y = __uint_as_float(a.x & 0xffff0000u); y[j].z = __uint_as_float(a.y << 16); y[j].w = __uint_as_float(a.y & 0xffff0000u); }
}
__device__ __forceinline__ void slab_reduce_phase(Frame& F) {
    const int gw = F.vcu * NWAVES + F.wave, NGW = F.G * NWAVES, l = F.lane;
    bf16* Y = (bf16*)(F.ws + WS_Y); const float* SLAB = (const float*)(F.ws + WS_SLAB);
    unsigned cnt[8]; int off[8]; moe_offsets(F, cnt, off);
    int T = 0;
#pragma unroll
    for (int e = 0; e < 8; ++e) T += (int)((cnt[e] + 255u) >> 8);
    const int nleft = (T > MOE_MAIN_TILES ? T - MOE_MAIN_TILES : 0) * 4, S = (nleft * 14 <= F.G && !MK_FORCE_S7) ? 14 : 7;
    for (int it = gw; it < nleft * 256; it += NGW) { const int u4 = it >> 8, r = it & 255;
        const float* p = SLAB + (size_t)(u4 * S) * 65536 + (size_t)r * 256 + 4 * l;
        f32x4 t[14];
#pragma unroll
        for (int k = 0; k < 14; ++k) t[k] = (k < 7 || S == 14) ? *(const f32x4*)(p + (size_t)k * 65536) : (f32x4){0.f, 0.f, 0.f, 0.f};
        f32x4 s = t[0];
#pragma unroll
        for (int k = 1; k < 14; ++k) s += t[k];
        *(GAS unsigned long long*)(Y + (size_t)((MOE_MAIN_TILES + (u4 >> 2)) * 256 + r) * DM + (u4 & 3) * 256 + 4 * l) = (unsigned long long)pk2(s.x, s.y) | ((unsigned long long)pk2(s.z, s.w) << 32);
    }
}
__device__ __forceinline__ void final_phase(Frame& F, const Args& a) {
    const int gw = F.vcu * NWAVES + F.wave, NGW = F.G * NWAVES, l = F.lane;
    float* X = a.out; const float* MOD1 = (const float*)(F.ws + WS_MOD) + 8 * 6144;
    const int* RT_E = (const int*)(F.ws + WS_RT_E); const int* RT_POS = (const int*)(F.ws + WS_RT_POS); const float* RT_W = (const float*)(F.ws + WS_RT_W);
    const bf16* Y = (const bf16*)(F.ws + WS_Y);
    unsigned cnt[8]; int off[8]; moe_offsets(F, cnt, off);
    for (int c = gw; c < NTOK / 16; c += NGW) {
        const int row0 = c * 16, b = row0 / SEQ;
        f32x4 GT[4], GF[4];
#pragma unroll
        for (int j = 0; j < 4; ++j) { const int col = 4 * l + 256 * j; GT[j] = *(const f32x4*)(MOD1 + (size_t)b * 6144 + 5120 + col); GF[j] = *(const f32x4*)(a.in[25] + col); }
#pragma unroll 4
        for (int r = 0; r < 16; ++r) {
            const int row = row0 + r;
            GAS f32x4* xr = (GAS f32x4*)(X + (size_t)row * DM) + l; const GAS v2u* xs = (const GAS v2u*)((const bf16*)X + (size_t)row * XSP) + l;
            const int e1 = RT_E[row * 2], e2 = RT_E[row * 2 + 1], p1 = RT_POS[row * 2], p2 = RT_POS[row * 2 + 1]; const float w1 = RT_W[row * 2], w2 = RT_W[row * 2 + 1];
            int o1 = 0, o2 = 0;
#pragma unroll
            for (int e = 0; e < 8; ++e) { o1 = (e1 == e) ? off[e] : o1; o2 = (e2 == e) ? off[e] : o2; }
            f32x4 ya[4], yb[4];
            load_yrow(Y, o1 + p1, l, ya); load_yrow(Y, o2 + p2, l, yb);
            f32x4 v[4]; float s2 = 0.f;
#pragma unroll
            for (int j = 0; j < 4; ++j) { const v2u w = xs[64 * j]; const f32x4 x3 = (f32x4){__uint_as_float(w.x << 16), __uint_as_float(w.x & 0xffff0000u), __uint_as_float(w.y << 16), __uint_as_float(w.y & 0xffff0000u)};
                v[j] = x3 + GT[j] * (ya[j] * w1 + yb[j] * w2); s2 += (v[j].x * v[j].x + v[j].y * v[j].y) + (v[j].z * v[j].z + v[j].w * v[j].w); }
            const float rstd = 1.0f / sqrtf(wave_sum(s2) * (1.0f / DM) + EPSN);
#pragma unroll
            for (int j = 0; j < 4; ++j) { f32x4 ov = v[j] * rstd * GF[j];
                if (MK_STAMP_A >= 0) { const unsigned ta = __hip_atomic_load((unsigned*)(F.ctl + CW_STAMP + (MK_STAMP_A < 0 ? 0 : MK_STAMP_A)), RLX_AGENT), tb = __hip_atomic_load((unsigned*)(F.ctl + CW_STAMP + (MK_STAMP_B < 0 ? 0 : MK_STAMP_B)), RLX_AGENT);
                    const float cst = sqrtf((float)(((tb - ta) / MK_STAMP_Q) * MK_STAMP_Q) * 0.01f / MK_STAMP_T0); ov = (f32x4){cst, cst, cst, cst}; }
                xr[64 * j] = ov; }
        }
    }
}
template <int MODE, int EXP = 0>
__device__ __forceinline__ void attn_phase(Frame& F, unsigned qoff, unsigned kvoff, unsigned kroff, unsigned ooff) {
    for (int w = 0; ; ++w) {
        const int it = F.vcu + (w >> 1) * F.G; if (it >= BATCH * NHEAD * 8) break;
        const int bh = it >> 3, s = it & 7, b = bh >> 3, h = bh & 7;
        att::attn_unit<MODE, EXP>(b, h, (w & 1) ? s : 15 - s, (const bf16*)(F.ws + qoff), (const bf16*)(F.ws + kvoff), (const bf16*)(F.ws + kroff), (bf16*)(F.ws + ooff), (LAS char*)(F.lds + RING_OFF), F.wave);
    }
}
#ifndef MK_CONV_BATCH
#define MK_CONV_BATCH 8
#endif
#ifndef MK_CONV_MOD
#define MK_CONV_MOD 8
#endif
constexpr int CW_TRQ5 = CW_TRQ + 512, CW_ATQ = CW_TRQ + 2048;
#ifndef MK_ATQ_PAIRMAJOR
#define MK_ATQ_PAIRMAJOR 0
#endif
#ifndef MK_CONV_XCD
#define MK_CONV_XCD 0
#endif
template <int EXP = 0, int MODE = 0>
__device__ __forceinline__ void attn_phase_dyn(Frame& F, const Args& a, unsigned qoff, unsigned kvoff, unsigned kroff, unsigned ooff, int qb5 = 0  , int what = 3  ) {
    const int x0 = (F.G % 8 == 0) ? F.vcu / (F.G / 8) : 0;
    const bool conv = MK_CONV_XCD ? (x0 == 7) : (F.vcu % MK_CONV_MOD == 0);
    if ((what & 1) && conv) { tr_run<MK_CONV_BATCH>(F, a, 512 + qb5, 0, TR_EARLY0); }
    __syncthreads();
    constexpr int NQA = MK_CONV_XCD ? 7 : 8;
    const int xs = MK_CONV_XCD ? (conv ? F.vcu % 7 : x0) : x0;
    int qd = 0; unsigned pend = 0u;
    const bool att_on = (what & 2) && !((what & 8) && conv);
#define ATQ_ISSUE() do { const int qi_ = (xs + qd) % NQA; pend = __hip_atomic_fetch_add(F.ctl + CW_ATQ + qb5 + 64 * qi_, 1u, RLX_AGENT); } while (0)
    if (F.tid == 0 && att_on) ATQ_ISSUE();
    for (;;) {
        if (F.tid == 0) {
            int item = -1;
            while (att_on && qd < NQA) { const int qq = (xs + qd) % NQA, np = (64 - qq + NQA - 1) / NQA; if (pend < 16u * (unsigned)np) { item = qq * 256 + (int)pend; ATQ_ISSUE(); break; } ++qd; if (qd < NQA) ATQ_ISSUE(); }
            F.MISC[16] = (unsigned)item;
        }
        asm volatile("s_waitcnt lgkmcnt(0)\n\ts_barrier" ::: "memory");
        const int item = __builtin_amdgcn_readfirstlane((int)F.MISC[16]);
        if (item < 0) break;
        const int qq = item >> 8, j = item & 255, np = (64 - qq + NQA - 1) / NQA, bh = MK_ATQ_PAIRMAJOR ? qq + NQA * (j >> 4) : qq + NQA * (j % np), qb = MK_ATQ_PAIRMAJOR ? 15 - (j & 15) : 15 - j / np, b = bh >> 3, h = bh & 7;
        att::attn_unit<MODE, EXP>(b, h, qb, (const bf16*)(F.ws + qoff), (const bf16*)(F.ws + kvoff), (const bf16*)(F.ws + kroff), (bf16*)(F.ws + ooff), (LAS char*)(F.lds + RING_OFF), F.wave);
    }
#undef ATQ_ISSUE
    __syncthreads();
    if ((what & 1) && !(what & 4)) tr_run<MK_CONV_BATCH>(F, a, 512 + qb5, 0, TR_EARLY0);
    __syncthreads();
}


constexpr int NPH = 20;
#ifndef MK_DUP_BAR
#define MK_DUP_BAR 0
#endif
#ifndef MK_ALIGN_SW
#define MK_ALIGN_SW true
#endif
#ifndef MK_WGM_BIG
#define MK_WGM_BIG 4
#define MK_WGM_SMALL 2
#endif
#ifndef MK_TW_A
#define MK_TW_A -1
#define MK_TW_B -1
#define MK_TW_AMP 4
#define MK_TW_MODE 0
#endif
#ifndef MK_ALIGN_P13
#define MK_ALIGN_P13 true
#endif
#ifndef MK_P4_SPLIT
#define MK_P4_SPLIT 0
#endif
#ifndef MK_ALIGN_SHORT
#define MK_ALIGN_SHORT true
#endif
#ifndef MK_SB_DYN
#define MK_SB_DYN 1
#endif
#ifndef MK_P2_FILL
#define MK_P2_FILL 0
#endif
#ifndef MK_ATT_EXP
#define MK_ATT_EXP 0
#endif
#ifndef MK_DUP_MASK
#define MK_DUP_MASK 0
#endif
#ifndef MK_PHMASK
#define MK_PHMASK 0xfffff
#endif
__global__ void __launch_bounds__(NWAVES * 64, 2) yoco_fwd(Args args) {
    extern __shared__ __attribute__((aligned(16))) unsigned char lds[];
    Frame F;
    F.lds = (LAS unsigned char*)lds;
    F.MISC = (volatile LAS unsigned*)(F.lds + MISC_OFF);
    F.tid = threadIdx.x; F.lane = F.tid & 63; F.wave = __builtin_amdgcn_readfirstlane(F.tid >> 6);
    F.G = gridDim.x; { const int bx = blockIdx.x; F.vcu = (F.G % 8 == 0) ? (bx % 8) * (F.G / 8) + bx / 8 : bx; }
    F.ws = args.ws; F.ctl = (gu32*)(args.ws + WS_CTL);
    for (int u = F.tid; u < (LDS_BYTES - LDSCTL_OFF) / 4; u += NWAVES * 64) ((LAS unsigned*)(F.lds + LDSCTL_OFF))[u] = 0u;
    __syncthreads();
    XcdBarrier bar; bar.bar = (unsigned*)(F.ctl + CW_BAR); bar.x = 0; bar.st = nullptr; bar.w0 = F.wave;
    if (!MK_PER_PHASE) bar = xcd_barrier_post((unsigned*)(F.ctl + CW_BAR), F.MISC + 8);
#define GRID_BAR(seam) do { if (MK_PER_PHASE) { if (F.tid == 0) __hip_atomic_store(F.ctl + CW_TMO, 0xBADBA0u | (unsigned)(seam), RLX_AGENT); } else { xcd_barrier(bar); } } while (0)
    const int lo = args.ph_lo, hi = args.ph_hi;
#define IN(k) ((((unsigned)MK_PHMASK >> (k)) & 1u) && lo <= (k) && (k) < hi)
#define REFRESH() do { int l_ = (int)__builtin_amdgcn_mbcnt_hi(~0u, __builtin_amdgcn_mbcnt_lo(~0u, 0u)); asm volatile("" : "+v"(l_)); F.lane = l_; F.tid = F.wave * 64 + l_; \
        { GAS unsigned char* w_ = (GAS unsigned char*)args.ws; asm volatile("" : "+s"(w_)); ws = (unsigned char*)w_; }     \
        F.ws = ws; F.ctl = (gu32*)(ws + WS_CTL); } while (0)
#define STAMP(k) do { if ((MK_STAMP_A >= 0 || MK_TW_A >= 0) && blockIdx.x == 0 && threadIdx.x == 0) { const unsigned long long t_ = __builtin_amdgcn_s_memrealtime(); __hip_atomic_store((unsigned*)(F.ctl + CW_STAMP + (k)), (unsigned)t_, RLX_AGENT); \
        if (MK_TW_A >= 0) __hip_atomic_store((unsigned*)(F.ctl + CW_STAMP + 32 + (k)), (unsigned)__builtin_amdgcn_s_memtime(), RLX_AGENT); } } while (0)
#define SEAM(k) do { if (IN(k) && IN((k) + 1)) { GRID_BAR(k); if (MK_DUP_BAR) GRID_BAR(k); } } while (0)
    unsigned char* ws = args.ws;
#define XS (args.out)
#define MOD0 ((const float*)(ws + WS_MOD))
#define MOD1 (MOD0 + 8 * 6144)
#define MODKV ((const float*)(ws + WS_MODKV))
#define HB0 ((bf16*)(ws + WS_HB0))
#define HB1 ((bf16*)(ws + WS_HB1))
#define AO ((bf16*)(ws + WS_AO))
    LAS unsigned char* ring = F.lds + RING_OFF;

    if (IN(0)) for (int rep_ = 0; rep_ < (((MK_DUP_MASK >> 0) & 1) ? 2 : 1); ++rep_) { STAMP(0); REFRESH(); p0_prologue(F, args, rep_ * 1024, rep_ ? MK_ATT_EXP : 0); } SEAM(0);
    if (IN(1)) for (int rep_ = 0; rep_ < (((MK_DUP_MASK >> 1) & 1) ? 2 : 1); ++rep_) { STAMP(1); REFRESH(); norm_phase<false>(F, args.in[0], args.in[5], MOD0 + 1024, MOD0, 6144, HB0, nullptr, nullptr, nullptr, 0, nullptr); } SEAM(1);
    if (IN(2)) for (int rep_ = 0; rep_ < (((MK_DUP_MASK >> 2) & 1) ? 2 : 1); ++rep_) { STAMP(2); REFRESH(); pg8::Gemm g{HB0, (const bf16*)(ws + WS_WAD), NTOK, NLATP, DM, 0, 0}; pg8::StaticOrder S; S.init(NTOK, NLATP, F.G, (int)blockIdx.x, MK_WGM_SMALL);
        pg8::EpiBf16 E{(bf16*)(ws + WS_LAT), NLATP, 1.0f}; pg8::gemm_phase<pg8::EpiBf16, pg8::StaticOrder, MK_ALIGN_SHORT, true>(ring, g, S, E, F.wave);
        if (MK_P2_FILL && rep_ == 0 && (int)blockIdx.x + F.G >= (NTOK / 256) * (NLATP / 256)) { __syncthreads(); tr_run<MK_CONV_BATCH>(F, args, 512, 0, TR_EARLY0, 0, MK_P2_FILL); __syncthreads(); } } SEAM(2);
    if (IN(3)) for (int rep_ = 0; rep_ < (((MK_DUP_MASK >> 3) & 1) ? 2 : 1); ++rep_) { STAMP(3); REFRESH(); lat_phase(F, args); } SEAM(3);
    if (IN(4)) for (int rep_ = 0; rep_ < (((MK_DUP_MASK >> 4) & 1) ? 2 : 1); ++rep_) { STAMP(4); REFRESH();
        int kq_ = QLP; asm volatile("" : "+s"(kq_));
        const bool split_ = MK_P4_SPLIT && F.G == 256; const int bx_ = (int)blockIdx.x, gq_ = split_ ? 128 : F.G, cq_ = bx_, ck_ = split_ ? bx_ - 128 : bx_;
        if (!split_ || bx_ < 128) {
        { pg8::Gemm g{(const bf16*)(ws + WS_CQ), (const bf16*)(ws + WS_WUQ), NTOK, 1024, kq_, 0, 0}; pg8::StaticOrder S; S.init(NTOK, 1024, gq_, cq_, MK_WGM_SMALL);
          pg8::EpiBf16 E{(bf16*)(ws + WS_Q), NQ, C2_MLA}; pg8::gemm_phase<pg8::EpiBf16, pg8::StaticOrder, MK_ALIGN_SHORT, true>(ring, g, S, E, F.wave); }
        { pg8::Gemm g{(const bf16*)(ws + WS_CQ), (const bf16*)(ws + WS_WUQ) + (size_t)1024 * QLP, NTOK, 512, kq_, 0, 0}; pg8::StaticOrder S; S.init(NTOK, 512, gq_, cq_, MK_WGM_SMALL);
          pg8::EpiRope E{(bf16*)(ws + WS_Q) + 1024, NQ, C2_MLA, (const float*)(ws + WS_COS)}; pg8::gemm_phase<pg8::EpiRope, pg8::StaticOrder, MK_ALIGN_SHORT, true>(ring, g, S, E, F.wave); }
        }
        if (!split_ || bx_ >= 128) {
        { pg8::Gemm g{(const bf16*)(ws + WS_CKV), (const bf16*)(ws + WS_WUKV), NTOK, NKV, KVLORA, 0, 0}; pg8::StaticOrder S; S.init(NTOK, NKV, gq_, ck_, MK_WGM_SMALL);
          pg8::EpiBf16 E{(bf16*)(ws + WS_KV), NKV, 1.0f}; pg8::gemm_phase<pg8::EpiBf16, pg8::StaticOrder, MK_ALIGN_SHORT, true>(ring, g, S, E, F.wave); }
        }
    } SEAM(4);
    if (IN(5)) for (int rep_ = 0; rep_ < (((MK_DUP_MASK >> 5) & 1) ? 2 : 1); ++rep_) { STAMP(5); REFRESH(); if (rep_ == 0) attn_phase_dyn<0>(F, args, (unsigned)WS_Q, (unsigned)WS_KV, (unsigned)WS_KROT, (unsigned)WS_AO); else attn_phase_dyn<0>(F, args, (unsigned)WS_Q, (unsigned)WS_KV, (unsigned)WS_KROT, (unsigned)WS_HB0, 1024, MK_ATT_EXP); } SEAM(5);
    if (IN(6)) for (int rep_ = 0; rep_ < (((MK_DUP_MASK >> 6) & 1) ? 2 : 1); ++rep_) { STAMP(6); REFRESH(); pg8::Gemm g{AO, (const bf16*)(ws + WS_WOA), NTOK, DM, DM, 0, 0}; pg8::StaticOrder S; S.init(NTOK, DM, F.G, (int)blockIdx.x, MK_WGM_SMALL);
        pg8::EpiResidB<true> E{args.in[0], (bf16*)XS, MOD0 + 2048, 6144, XSP}; pg8::gemm_phase<pg8::EpiResidB<true>, pg8::StaticOrder, true, true>(ring, g, S, E, F.wave); } SEAM(6);
    if (IN(7)) for (int rep_ = 0; rep_ < (((MK_DUP_MASK >> 7) & 1) ? 2 : 1); ++rep_) { STAMP(7); REFRESH(); norm_phase<false, true>(F, XS, args.in[6], MOD0 + 4096, MOD0 + 3072, 6144, HB0, nullptr, nullptr, nullptr, 0, nullptr); } SEAM(7);
    if (IN(8)) for (int rep_ = 0; rep_ < (((MK_DUP_MASK >> 8) & 1) ? 2 : 1); ++rep_) { STAMP(8); REFRESH(); pg8::Gemm g{HB0, (const bf16*)(ws + WS_WGU), NTOK, NGU, DM, 0, 0}; pg8::StaticOrder S; S.init(NTOK, NGU, F.G, (int)blockIdx.x, MK_WGM_BIG);
        pg8::EpiSwiglu E{(bf16*)(ws + WS_ACT), DFF}; if (rep_ == 0) pg8::gemm_phase<pg8::EpiSwiglu, pg8::StaticOrder, MK_ALIGN_SW, true>(ring, g, S, E, F.wave); else pg8::gemm_phase<pg8::EpiSwiglu, pg8::StaticOrder, true, true, MK_ATT_EXP>(ring, g, S, E, F.wave); } SEAM(8);
    if (IN(9)) for (int rep_ = 0; rep_ < (((MK_DUP_MASK >> 9) & 1) ? 2 : 1); ++rep_) { STAMP(9); REFRESH(); pg8::Gemm g{(const bf16*)(ws + WS_ACT), (const bf16*)(ws + WS_WDN), NTOK, DM, DFF, 0, 0}; pg8::StaticOrder S; S.init(NTOK, DM, F.G, (int)blockIdx.x, MK_WGM_SMALL);
        pg8::EpiResidB<false> E{XS, (bf16*)XS, MOD0 + 5120, 6144, XSP}; pg8::gemm_phase<pg8::EpiResidB<false>, pg8::StaticOrder, true, true>(ring, g, S, E, F.wave); } SEAM(9);
    if (IN(10)) for (int rep_ = 0; rep_ < (((MK_DUP_MASK >> 10) & 1) ? 2 : 1); ++rep_) { STAMP(10); REFRESH(); norm_phase<true, true>(F, XS, args.in[15], MODKV + 1024, MODKV, 2048, HB0, args.in[5] + DM, MOD1 + 1024, MOD1, 6144, HB1); } SEAM(10);
    if (IN(11)) for (int rep_ = 0; rep_ < (((MK_DUP_MASK >> 11) & 1) ? 2 : 1); ++rep_) { STAMP(11); REFRESH();
        { pg8::Gemm g{HB0, (const bf16*)(ws + WS_WKVSB), NTOK, 2048, DM, 0, 0}; pg8::StaticOrder S; S.init(NTOK, 2048, F.G, (int)blockIdx.x, MK_WGM_SMALL);
          pg8::EpiBf16 E{(bf16*)(ws + WS_KVSB), 2048, 1.0f}; pg8::gemm_phase<pg8::EpiBf16, pg8::StaticOrder, true, true>(ring, g, S, E, F.wave); }
        { pg8::Gemm g{HB1, (const bf16*)(ws + WS_WQSB), NTOK, DM, DM, 0, 0}; pg8::StaticOrder S; S.init(NTOK, DM, F.G, (int)blockIdx.x, MK_WGM_SMALL);
          pg8::EpiBf16 E{(bf16*)(ws + WS_QSB), DM, C2_SB}; pg8::gemm_phase<pg8::EpiBf16, pg8::StaticOrder, true, true>(ring, g, S, E, F.wave); }
    } SEAM(11);
    if (IN(12)) for (int rep_ = 0; rep_ < (((MK_DUP_MASK >> 12) & 1) ? 2 : 1); ++rep_) { STAMP(12); REFRESH(); if (rep_ == 0) { if (MK_SB_DYN) attn_phase_dyn<0, 1>(F, args, (unsigned)WS_QSB, (unsigned)WS_KVSB, 0u, (unsigned)WS_AO, 512, 2); else attn_phase<1>(F, (unsigned)WS_QSB, (unsigned)WS_KVSB, 0u, (unsigned)WS_AO); } else attn_phase<1, MK_ATT_EXP>(F, (unsigned)WS_QSB, (unsigned)WS_KVSB, 0u, (unsigned)WS_LAT); } SEAM(12);
    if (IN(13)) for (int rep_ = 0; rep_ < (((MK_DUP_MASK >> 13) & 1) ? 2 : 1); ++rep_) { STAMP(13); REFRESH(); pg8::Gemm g{AO, (const bf16*)(ws + WS_WOSB), NTOK, DM, DM, 0, 0}; pg8::StaticOrder S; S.init(NTOK, DM, F.G, (int)blockIdx.x, MK_WGM_SMALL);
        pg8::EpiResidB<false> E{XS, (bf16*)XS, MOD1 + 2048, 6144, XSP}; pg8::gemm_phase<pg8::EpiResidB<false>, pg8::StaticOrder, MK_ALIGN_P13, true>(ring, g, S, E, F.wave); } SEAM(13);
    if (IN(14)) for (int rep_ = 0; rep_ < (((MK_DUP_MASK >> 14) & 1) ? 2 : 1); ++rep_) { STAMP(14); REFRESH(); router_phase(F, args); } SEAM(14);
    if (IN(15)) for (int rep_ = 0; rep_ < (((MK_DUP_MASK >> 15) & 1) ? 2 : 1); ++rep_) { STAMP(15); REFRESH(); scatter_phase(F, args); } SEAM(15);
    if (IN(16)) for (int rep_ = 0; rep_ < (((MK_DUP_MASK >> 16) & 1) ? 2 : 1); ++rep_) { STAMP(16); REFRESH(); unsigned cnt[8]; int off[8]; moe_offsets(F, cnt, off);
        pg8::Gemm g{(const bf16*)(ws + WS_HS), (const bf16*)(ws + WS_WEGU), 0, NGU, DM, (size_t)NGU * DM * 2, 0}; pg8::MoeOrder S; S.init(cnt, NGU, F.G, (int)blockIdx.x, 1 << 20, MK_WGM_BIG);
        pg8::EpiSwiglu E{(bf16*)(ws + WS_ACT2), DFF}; pg8::gemm_phase<pg8::EpiSwiglu, pg8::MoeOrder, MK_ALIGN_SW, true>(ring, g, S, E, F.wave); } SEAM(16);
    if (IN(17)) for (int rep_ = 0; rep_ < (((MK_DUP_MASK >> 17) & 1) ? 2 : 1); ++rep_) { STAMP(17); REFRESH(); unsigned cnt[8]; int off[8]; moe_offsets(F, cnt, off);
        { pg8::Gemm g{(const bf16*)(ws + WS_ACT2), (const bf16*)(ws + WS_WEDN), 0, DM, DFF, (size_t)DM * DFF * 2, 0}; pg8::MoeOrder S; S.init(cnt, DM, F.G, (int)blockIdx.x, MOE_MAIN_TILES, MK_WGM_SMALL);
          pg8::EpiBf16 E{(bf16*)(ws + WS_Y), DM, 1.0f}; pg8::gemm_phase<pg8::EpiBf16, pg8::MoeOrder, true, true>(ring, g, S, E, F.wave); }
        { pg8::LeftOrder S; S.init(cnt, DFF, F.G, (int)blockIdx.x, MOE_MAIN_TILES);
          pg8::Gemm g{(const bf16*)(ws + WS_ACT2), (const bf16*)(ws + WS_WEDN), 0, DM, DFF, (size_t)DM * DFF * 2, S.Kc};
          pg8::EpiSlab E{(float*)(ws + WS_SLAB), MOE_MAIN_TILES, S.S, S.Kc}; pg8::gemm_phase<pg8::EpiSlab, pg8::LeftOrder, true, true>(ring, g, S, E, F.wave); }
    } SEAM(17);
    if (IN(18)) for (int rep_ = 0; rep_ < (((MK_DUP_MASK >> 18) & 1) ? 2 : 1); ++rep_) { STAMP(18); REFRESH(); slab_reduce_phase(F); } SEAM(18);
    if (IN(19)) { STAMP(19); REFRESH(); final_phase(F, args); }
    if (MK_TW_A >= 0 && !MK_PER_PHASE) { STAMP(20);
        if (blockIdx.x == 0 && threadIdx.x == 0) {
            const unsigned ta = __hip_atomic_load((unsigned*)(F.ctl + CW_STAMP + (MK_TW_A < 0 ? 0 : MK_TW_A)), RLX_AGENT), tb = __hip_atomic_load((unsigned*)(F.ctl + CW_STAMP + (MK_TW_B < 0 ? 0 : MK_TW_B)), RLX_AGENT);
            const unsigned ca = __hip_atomic_load((unsigned*)(F.ctl + CW_STAMP + 32 + (MK_TW_A < 0 ? 0 : MK_TW_A)), RLX_AGENT), cb = __hip_atomic_load((unsigned*)(F.ctl + CW_STAMP + 32 + (MK_TW_B < 0 ? 0 : MK_TW_B)), RLX_AGENT);
            unsigned dt = tb - ta; const unsigned dc = cb - ca;
            if (MK_TW_MODE == 2) dt = F.MISC[20];
            unsigned long long wait = (MK_TW_MODE == 0 || MK_TW_MODE == 2) ? (unsigned long long)dt * (unsigned)MK_TW_AMP : (unsigned long long)((dc * 10ull) / (dt ? dt : 1u)) * 1000ull;
            if (wait > 400000ull) wait = 400000ull;
            const unsigned long long t0 = __builtin_amdgcn_s_memrealtime();
            while (__builtin_amdgcn_s_memrealtime() - t0 < wait) __builtin_amdgcn_s_sleep(16);
        } }
#undef IN
#undef SEAM
#undef STAMP
#undef REFRESH
#undef MOD0
#undef MOD1
#undef MODKV
#undef HB0
#undef HB1
#undef AO
#undef XS
#undef GRID_BAR
}

extern "C" void kernel_launch(void* const* d_in, const int* in_sizes, int n_in, void* d_out, int out_size, void* d_ws, size_t ws_size, hipStream_t stream) {
    static int grid = 0;
    if (grid == 0) {
        if (n_in != 26 || in_sizes[0] != NTOK * DM || out_size != NTOK * DM || ws_size < WS_END) { fprintf(stderr, "kernel_launch: shape/workspace mismatch (n_in %d, in0 %d, out %d, ws %zu, need %zu)\n", n_in, n_in > 0 ? in_sizes[0] : -1, out_size, ws_size, (size_t)WS_END); grid = -1; return; }
        int dev = 0, cus = 0, per_cu = 0;
        if (hipGetDevice(&dev) != hipSuccess || hipDeviceGetAttribute(&cus, hipDeviceAttributeMultiprocessorCount, dev) != hipSuccess) { grid = -1; return; }
        if (hipFuncSetAttribute((const void*)yoco_fwd, hipFuncAttributeMaxDynamicSharedMemorySize, LDS_BYTES) != hipSuccess) { fprintf(stderr, "kernel_launch: hipFuncSetAttribute failed\n"); grid = -1; return; }
        if (hipOccupancyMaxActiveBlocksPerMultiprocessor(&per_cu, (const void*)yoco_fwd, NWAVES * 64, LDS_BYTES) != hipSuccess || per_cu < 1) { fprintf(stderr, "kernel_launch: occupancy query reports %d\n", per_cu); }
        (void)hipGetLastError();
        grid = cus;
    }
    if (grid < 0) return;
    if (hipMemsetAsync((char*)d_ws + WS_CTL, 0, CTL_ZERO_BYTES, stream) != hipSuccess) return;
    Args a{};
    for (int i = 0; i < 26; ++i) a.in[i] = (const float*)d_in[i];
    a.out = (float*)d_out; a.ws = (unsigned char*)d_ws;
    for (int i = 0; i < 32; ++i) a.inv[i] = (float)pow(10000.0, -(double)i / 32.0);
#if MK_PER_PHASE
    for (int p = 0; p < NPH; ++p) { a.ph_lo = p; a.ph_hi = p + 1; a.li = p; hipLaunchKernelGGL(yoco_fwd, dim3(grid), dim3(NWAVES * 64), LDS_BYTES, stream, a); }
#else
    a.ph_lo = 0; a.ph_hi = NPH; a.li = 0;
    hipLaunchKernelGGL(yoco_fwd, dim3(grid), dim3(NWAVES * 64), LDS_BYTES, stream, a);
#endif
    const hipError_t le = hipPeekAtLastError();
    if (le != hipSuccess) fprintf(stderr, "kernel_launch: launch failed: %s\n", hipGetErrorName(le));
}
```
